# Optimizing an MI355X kernel written in HIP

```python
import jax, jax.numpy as jnp
from jax import lax
import numpy as np

D_MODEL = 1024
BATCH = 2
SEQ = 8192
DEPTH = 1

N_META = 16
GLA_HEADS = 4
GLA_DK = D_MODEL // 2
GLA_DV = D_MODEL
GLA_HEAD_DK = GLA_DK // GLA_HEADS
GLA_HEAD_DV = GLA_DV // GLA_HEADS
DECAY_RANK = 16
GATE_TEMP = 16.0
CHUNK = 64
FNET_GROUPS = 4
FNET_WIDTH = D_MODEL // 2
FNET_GROUP_DIM = FNET_WIDTH // FNET_GROUPS
D_FF = 4 * D_MODEL
EPS = 1e-6
IN_SPLITS = (GLA_DK, GLA_DK, GLA_DV, GLA_DV, DECAY_RANK, DECAY_RANK, FNET_WIDTH, D_MODEL, D_MODEL)
D_IN = 2 * GLA_DK + 2 * GLA_DV + 2 * DECAY_RANK + FNET_WIDTH + 2 * D_MODEL

kernel_name = "bidir_gla_fnet_gated_hybrid_block"


def rms_norm(x, w):
    xf = x.astype(jnp.float32)
    y = xf * lax.rsqrt(jnp.mean(xf * xf, axis=-1, keepdims=True) + EPS)
    return y.astype(x.dtype) * w


def to_heads(t, n_heads):
    B, L, W = t.shape
    return t.reshape(B, L, n_heads, W // n_heads).transpose(0, 2, 1, 3)


def gla_chunked(q, k, v, log_a):
    B, H, T, dk = q.shape
    dv = v.shape[-1]
    n = T // CHUNK
    q, k, log_a = (t.reshape(B, H, n, CHUNK, dk) for t in (q, k, log_a))
    v = v.reshape(B, H, n, CHUNK, dv)
    b = jnp.cumsum(log_a, axis=3)
    b_ref = b[:, :, :, CHUNK // 2 - 1:CHUNK // 2]
    b_last = b[:, :, :, -1:]
    scores = jnp.einsum("bhncd,bhnsd->bhncs", q * jnp.exp(b - b_ref), k * jnp.exp(b_ref - b))
    lower = jnp.tril(jnp.ones((CHUNK, CHUNK), dtype=bool))
    scores = jnp.where(lower, scores, 0.0)
    o_intra = jnp.einsum("bhncs,bhnse->bhnce", scores, v)
    d_state = jnp.einsum("bhncd,bhnce->bhnde", k * jnp.exp(b_last - b), v)
    chunk_decay = jnp.exp(b_last[:, :, :, 0])

    def step(S, inp):
        ds_n, a_n = inp
        return a_n[..., None] * S + ds_n, S

    S0 = jnp.zeros((B, H, dk, dv), q.dtype)
    _, S_prev = lax.scan(step, S0, (jnp.moveaxis(d_state, 2, 0), jnp.moveaxis(chunk_decay, 2, 0)))
    S_prev = jnp.moveaxis(S_prev, 0, 2)
    o_inter = jnp.einsum("bhncd,bhnde->bhnce", q * jnp.exp(b), S_prev)
    return (o_intra + o_inter).reshape(B, H, T, dv)


def bidirectional_gla(q, k, v, log_a_fwd, log_a_bwd):
    pad_len = CHUNK - N_META
    pad = ((0, 0), (0, 0), (pad_len, 0), (0, 0))
    q, k, v, la_f, la_b = (jnp.pad(t.astype(jnp.float32), pad) for t in (q, k, v, log_a_fwd, log_a_bwd))
    o_fwd = gla_chunked(q, k, v, la_f)
    flip = lambda t: jnp.flip(t, axis=2)
    o_bwd = flip(gla_chunked(flip(q), flip(k), flip(v), flip(la_b)))
    return (o_fwd + o_bwd)[:, :, pad_len:]


def hybrid_mixer(h, norm_w, w_in, w_dec_f, b_dec_f, w_dec_b, b_dec_b, gla_norm, w_o_gla, w_fnet, w_out):
    B, L, _ = h.shape
    u = rms_norm(h, norm_w)
    proj = u @ w_in
    split_points = [int(s) for s in np.cumsum(IN_SPLITS)[:-1]]
    q, k, v, g, r_f, r_b, f_in, gate_a_logit, gate_f_logit = jnp.split(proj, split_points, axis=-1)

    log_a_f = jax.nn.log_sigmoid(r_f @ w_dec_f + b_dec_f) / GATE_TEMP
    log_a_b = jax.nn.log_sigmoid(r_b @ w_dec_b + b_dec_b) / GATE_TEMP
    o = bidirectional_gla(to_heads(q * GLA_HEAD_DK ** -0.5, GLA_HEADS), to_heads(k, GLA_HEADS),
                          to_heads(v, GLA_HEADS), to_heads(log_a_f, GLA_HEADS),
                          to_heads(log_a_b, GLA_HEADS))
    o = rms_norm(o.astype(h.dtype), gla_norm)
    o = o.transpose(0, 2, 1, 3).reshape(B, L, GLA_DV) * jax.nn.silu(g)
    y_gla = o @ w_o_gla

    f = f_in.reshape(B, L, FNET_GROUPS, FNET_GROUP_DIM).astype(jnp.float32)
    f = jnp.fft.fft2(f, axes=(1, 3), norm="ortho").real
    y_fnet = f.astype(h.dtype).reshape(B, L, FNET_WIDTH) @ w_fnet

    merged = jax.nn.sigmoid(gate_a_logit) * y_gla + jax.nn.sigmoid(gate_f_logit) * y_fnet
    return h + merged @ w_out


def squared_relu_mlp(u, w1, w2):
    return jnp.square(jax.nn.relu(u @ w1)) @ w2


def setup_inputs(seed: int = 0) -> dict:
    key = jax.random.key(seed)
    ks = jax.random.split(key, 18)
    nrm = lambda k, shape, fan_in: jax.random.normal(k, shape, jnp.float32) * fan_in ** -0.5
    gain = lambda k, shape: 1.0 + 0.02 * jax.random.normal(k, shape, jnp.float32)
    return {
        "x": jax.random.normal(ks[0], (BATCH, SEQ, D_MODEL), jnp.float32),
        "meta_tokens": jax.random.normal(ks[1], (N_META, D_MODEL), jnp.float32),
        "norm_mix": gain(ks[2], (DEPTH, D_MODEL)),
        "w_in": nrm(ks[3], (DEPTH, D_MODEL, D_IN), D_MODEL),
        "w_decay_fwd": nrm(ks[4], (DEPTH, DECAY_RANK, GLA_DK), DECAY_RANK),
        "b_decay_fwd": 0.1 * jax.random.normal(ks[5], (DEPTH, GLA_DK), jnp.float32),
        "w_decay_bwd": nrm(ks[6], (DEPTH, DECAY_RANK, GLA_DK), DECAY_RANK),
        "b_decay_bwd": 0.1 * jax.random.normal(ks[7], (DEPTH, GLA_DK), jnp.float32),
        "gla_norm": gain(ks[8], (DEPTH, GLA_HEAD_DV)),
        "w_o_gla": nrm(ks[9], (DEPTH, GLA_DV, D_MODEL), GLA_DV),
        "w_fnet": nrm(ks[10], (DEPTH, FNET_WIDTH, D_MODEL), FNET_WIDTH),
        "w_out": nrm(ks[11], (DEPTH, D_MODEL, D_MODEL), D_MODEL),
        "norm_ffn": gain(ks[12], (DEPTH, D_MODEL)),
        "w_ff1": nrm(ks[13], (DEPTH, D_MODEL, D_FF), D_MODEL),
        "w_ff2": nrm(ks[14], (DEPTH, D_FF, D_MODEL), D_FF),
        "norm_final": gain(ks[15], (D_MODEL,)),
    }


def reference(x, meta_tokens, norm_mix, w_in, w_decay_fwd, b_decay_fwd, w_decay_bwd, b_decay_bwd,
              gla_norm, w_o_gla, w_fnet, w_out, norm_ffn, w_ff1, w_ff2, norm_final):
    B = x.shape[0]
    meta = jnp.broadcast_to(meta_tokens.astype(x.dtype)[None], (B, N_META, D_MODEL))
    h = jnp.concatenate([meta, x], axis=1)
    for layer in range(DEPTH):
        h = hybrid_mixer(h, norm_mix[layer], w_in[layer], w_decay_fwd[layer], b_decay_fwd[layer],
                         w_decay_bwd[layer], b_decay_bwd[layer], gla_norm[layer], w_o_gla[layer],
                         w_fnet[layer], w_out[layer])
        h = h + squared_relu_mlp(rms_norm(h, norm_ffn[layer]), w_ff1[layer], w_ff2[layer])
    h = rms_norm(h, norm_final)
    return h[:, N_META:]
```

```cpp
#include <hip/hip_runtime.h>
#include <hip/hip_cooperative_groups.h>
#include <cstdio>
#include <cstdint>
namespace cg = cooperative_groups;
namespace pg8 {
#define PG8_LAS __attribute__((address_space(3)))
typedef unsigned short bf16_t;
typedef short bf16x8 __attribute__((ext_vector_type(8)));
typedef float f32x4 __attribute__((ext_vector_type(4)));
typedef unsigned u32x4 __attribute__((ext_vector_type(4)));
constexpr int BM = 256, BK = 64, HALF = 128, HTB = HALF * BK * 2  , STAGE_BYTES = 8 * HTB, NXCD = 8, WGM = 8;

__host__ __device__ __forceinline__ int lds_byte(int r, int c) { const int st = (r >> 4) * 2 + (c >> 5), rr = r & 15, cc = c & 31, ob = rr * 64 + cc * 2; return st * 1024 + (ob ^ (((ob >> 9) & 1) << 5)); }
__host__ __device__ __forceinline__ void stage_rc(int b, int& R, int& C) { const int st = b / 1024, sb = b % 1024, swz = sb ^ (((sb >> 9) & 1) << 5); R = (st >> 1) * 16 + swz / 64; C = (st & 1) * 32 + (swz % 64) / 2; }
__host__ __device__ __forceinline__ int perm32(int rho) { const int n = rho >> 4, i = rho & 15; return 8 * (i >> 2) + 4 * n + (i & 3); }

struct Unit { int pm, pn; };
struct Gemm { const bf16_t* A; const bf16_t* Bt; int M, N, K; };

__device__ __forceinline__ unsigned cvt_pk_bf16(float lo, float hi) { unsigned r; asm volatile("v_cvt_pk_bf16_f32 %0, %1, %2" : "=v"(r) : "v"(lo), "v"(hi)); return r; }
__device__ __forceinline__ float bflo(unsigned w) { return __uint_as_float(w << 16); }
__device__ __forceinline__ float bfhi(unsigned w) { return __uint_as_float(w & 0xffff0000u); }

struct Sched {
    int mode, n, G, c, nN, offM, offN;
    __device__ __forceinline__ bool next(int i, Unit& u) const {
        const int L = i * G + c; if (L >= n) return false;
        if (mode == 1) {
            if (L < 585) { u.pm = L / 9; u.pn = 65 + L % 9; }
            else { const int l2 = L - 585; u.pm = 65 + 9 + (l2 & 3); u.pn = l2 >> 2; }
        } else if (mode == 2) {
            const int grp = L & 3, r = L >> 2; u.pm = grp * 16 + (r >> 2); u.pn = grp * 4 + (r & 3);
        } else { u.pm = L / nN + offM; u.pn = L % nN + offN; }
        return true;
    }
    __device__ __forceinline__ void a_ready(const Unit&) const {}
    __device__ __forceinline__ void done(const Unit&) const {}
};

struct EP {
    bf16_t *Q, *K, *V; float* R; bf16_t* GT2; bf16_t* PQ; bf16_t *SGA, *SGF, *ON, *OG, *MG, *H1B, *HF;
    const float* x; float* H; float* PART1; const float* gnorm;
};
constexpr int LDG = 8320;
template <int MODE> struct Epi {
    static constexpr bool PERM = true, AFTER_DRAIN = false;
    EP p;
    __device__ __forceinline__ void operator()(const f32x4 (&acc)[2][2][4][2], const Unit& u, int wr, int wc, int fr, int fq) const {
#pragma unroll
        for (int ai = 0; ai < 2; ++ai)
#pragma unroll
            for (int m = 0; m < 4; ++m) {
                const int r = ai * HALF + wr * 64 + m * 16 + fr;
                float ss = 0.f;
                float rstd = 1.f;
                if (MODE == 8) { const float* pp = p.PART1 + (size_t)(u.pm * BM + r) * 16; float s = 0.f;
#pragma unroll
                    for (int t = 0; t < 4; ++t) { const f32x4 q4 = *(const f32x4*)(pp + 4 * t); s += (q4[0] + q4[1]) + (q4[2] + q4[3]); }
                    rstd = 1.0f / sqrtf(s * (1.0f / 1024.0f) + 1e-6f); }
#pragma unroll
                for (int bj = 0; bj < 2; ++bj) {
                    const int c = bj * HALF + wc * 32 + 8 * fq;
                    f32x4 v0 = acc[ai][bj][m][0], v1 = acc[ai][bj][m][1];
                    if (MODE == 1) {
                        if (u.pm < 65) {
                            const int t = u.pn - 65; const size_t row = (size_t)u.pm * BM + r;
                            if (t < 8) {
                                bf16_t* dst; float sc = 1.f;
                                if (t < 2) { dst = p.Q + row * 512 + t * 256 + c; sc = 0.08838834764831845f; }
                                else if (t < 4) dst = p.K + row * 512 + (t - 2) * 256 + c;
                                else dst = p.V + row * 1024 + (t - 4) * 256 + c;
                                u32x4 w; w.x = cvt_pk_bf16(v0[0] * sc, v0[1] * sc); w.y = cvt_pk_bf16(v0[2] * sc, v0[3] * sc); w.z = cvt_pk_bf16(v1[0] * sc, v1[1] * sc); w.w = cvt_pk_bf16(v1[2] * sc, v1[3] * sc);
                                *(u32x4*)dst = w;
                            } else if (c < 32) { float* dst = p.R + row * 32 + c; *(f32x4*)dst = v0; *(f32x4*)(dst + 4) = v1; }
                        } else {
                            const int gcol = (u.pm - 74) * BM + r, cs = gcol >> 9, col = gcol & 511;
                            u32x4 w; w.x = cvt_pk_bf16(v0[0], v0[1]); w.y = cvt_pk_bf16(v0[2], v0[3]); w.z = cvt_pk_bf16(v1[0], v1[1]); w.w = cvt_pk_bf16(v1[2], v1[3]);
                            if (u.pn < 64) { const int b = u.pn >> 5, l = 16 + (u.pn & 31) * 256 + c;
                                *(u32x4*)(p.GT2 + ((size_t)(b * 512 + col) * 2 + cs) * LDG + l) = w; }
                            else if (c == 48 || c == 56) { const int l = c - 48;
                                *(u32x4*)(p.GT2 + ((size_t)(col) * 2 + cs) * LDG + l) = w; *(u32x4*)(p.GT2 + ((size_t)(512 + col) * 2 + cs) * LDG + l) = w; }
                        }
                    } else if (MODE == 2) {
                        const int grp = u.pm >> 4; const size_t idx = (size_t)(u.pm & 15) * BM + r; const int n = (u.pn & 3) * BM + c;
                        u32x4 w; w.x = cvt_pk_bf16(v0[0], v0[1]); w.y = cvt_pk_bf16(v0[2], v0[3]); w.z = cvt_pk_bf16(v1[0], v1[1]); w.w = cvt_pk_bf16(v1[2], v1[3]);
                        *(u32x4*)(p.PQ + ((size_t)grp * 4096 + idx) * 1024 + n) = w;
                    } else if (MODE == 3) {
                        const int t = u.pn - 82; const size_t row = (size_t)u.pm * BM + r;
                        bf16_t* dst = (t < 4 ? p.SGA : p.SGF) + row * 1024 + (t & 3) * 256 + c;
                        float s[8];
#pragma unroll
                        for (int e = 0; e < 4; ++e) { s[e] = 1.f / (1.f + __expf(-v0[e])); s[4 + e] = 1.f / (1.f + __expf(-v1[e])); }
                        u32x4 w; w.x = cvt_pk_bf16(s[0], s[1]); w.y = cvt_pk_bf16(s[2], s[3]); w.z = cvt_pk_bf16(s[4], s[5]); w.w = cvt_pk_bf16(s[6], s[7]);
                        *(u32x4*)dst = w;
                    } else if (MODE == 4) {
                        const int t = u.pn - 78; const size_t off = ((size_t)u.pm * BM + r) * 1024 + t * 256 + c;
                        const u32x4 o = *(const u32x4*)(p.ON + off);
                        float s[8];
#pragma unroll
                        for (int e = 0; e < 4; ++e) { s[e] = v0[e] / (1.f + __expf(-v0[e])); s[4 + e] = v1[e] / (1.f + __expf(-v1[e])); }
                        u32x4 w; w.x = cvt_pk_bf16(s[0] * bflo(o.x), s[1] * bfhi(o.x)); w.y = cvt_pk_bf16(s[2] * bflo(o.y), s[3] * bfhi(o.y));
                        w.z = cvt_pk_bf16(s[4] * bflo(o.z), s[5] * bfhi(o.z)); w.w = cvt_pk_bf16(s[6] * bflo(o.w), s[7] * bfhi(o.w));
                        *(u32x4*)(p.OG + off) = w;
                    } else if (MODE == 5 || MODE == 6) {
                        const size_t off = ((size_t)u.pm * BM + r) * 1024 + u.pn * BM + c;
                        const u32x4 gt = *(const u32x4*)((MODE == 5 ? p.SGF : p.SGA) + off);
                        float s[8] = {v0[0] * bflo(gt.x), v0[1] * bfhi(gt.x), v0[2] * bflo(gt.y), v0[3] * bfhi(gt.y), v1[0] * bflo(gt.z), v1[1] * bfhi(gt.z), v1[2] * bflo(gt.w), v1[3] * bfhi(gt.w)};
                        if (MODE == 6) { const u32x4 mg = *(const u32x4*)(p.MG + off);
                            s[0] += bflo(mg.x); s[1] += bfhi(mg.x); s[2] += bflo(mg.y); s[3] += bfhi(mg.y); s[4] += bflo(mg.z); s[5] += bfhi(mg.z); s[6] += bflo(mg.w); s[7] += bfhi(mg.w); }
                        u32x4 w; w.x = cvt_pk_bf16(s[0], s[1]); w.y = cvt_pk_bf16(s[2], s[3]); w.z = cvt_pk_bf16(s[4], s[5]); w.w = cvt_pk_bf16(s[6], s[7]);
                        *(u32x4*)(p.MG + off) = w;
                    } else if (MODE == 7) {
                        const size_t off = ((size_t)u.pm * BM + r) * 1024 + u.pn * BM + c;
                        const f32x4 x0 = *(const f32x4*)(p.x + off), x1 = *(const f32x4*)(p.x + off + 4);
                        v0 = v0 + x0; v1 = v1 + x1;
                        *(f32x4*)(p.H + off) = v0; *(f32x4*)(p.H + off + 4) = v1;
                        u32x4 w; w.x = cvt_pk_bf16(v0[0], v0[1]); w.y = cvt_pk_bf16(v0[2], v0[3]); w.z = cvt_pk_bf16(v1[0], v1[1]); w.w = cvt_pk_bf16(v1[2], v1[3]);
                        *(u32x4*)(p.H1B + off) = w;
                        ss += (v0[0] * v0[0] + v0[1] * v0[1]) + (v0[2] * v0[2] + v0[3] * v0[3]) + (v1[0] * v1[0] + v1[1] * v1[1]) + (v1[2] * v1[2] + v1[3] * v1[3]);
                    } else if (MODE == 8) {
                        const size_t off = ((size_t)u.pm * BM + r) * 4096 + u.pn * BM + c;
                        float s[8];
#pragma unroll
                        for (int e = 0; e < 4; ++e) { float a = fmaxf(v0[e] * rstd, 0.f), b = fmaxf(v1[e] * rstd, 0.f); s[e] = a * a; s[4 + e] = b * b; }
                        u32x4 w; w.x = cvt_pk_bf16(s[0], s[1]); w.y = cvt_pk_bf16(s[2], s[3]); w.z = cvt_pk_bf16(s[4], s[5]); w.w = cvt_pk_bf16(s[6], s[7]);
                        *(u32x4*)(p.HF + off) = w;
                    } else if (MODE == 9) {
                        const size_t off = ((size_t)u.pm * BM + r) * 1024 + u.pn * BM + c;
                        const f32x4 x0 = *(const f32x4*)(p.H + off), x1 = *(const f32x4*)(p.H + off + 4);
                        *(f32x4*)(p.H + off) = v0 + x0; *(f32x4*)(p.H + off + 4) = v1 + x1;
                    }
                }
                if (MODE == 7) { ss += __shfl_xor(ss, 16); ss += __shfl_xor(ss, 32);
                    if (fq == 0) p.PART1[(size_t)(u.pm * BM + r) * 16 + u.pn * 4 + wc] = ss; }
            }
    }
};
template <class Epi, class Sched, bool ALIGN_EPI = false, bool SP2 = false>
__device__ __forceinline__ void gemm_phase(PG8_LAS unsigned char* lds, const Gemm g, const Sched& S, const Epi& E) {
    const int tid = threadIdx.x, wid = __builtin_amdgcn_readfirstlane(tid >> 6), lane = tid & 63, wr = wid >> 2, wc = wid & 3, fr = lane & 15, fq = lane >> 4;
    const int K = g.K, nt = K / BK;
    unsigned voffA[2], voffB[2];
#pragma unroll
    for (int i = 0; i < 2; ++i) { int R, C; stage_rc(tid * 16 + i * 8192, R, C); const int Rb = Epi::PERM ? ((R & ~31) + perm32(R & 31)) : R;
        voffA[i] = (unsigned)(R * K + C) * 2u; voffB[i] = (unsigned)(Rb * K + C) * 2u; }
    const size_t kstep = (size_t)(BK * 2);
    const size_t hstep = (size_t)HALF * K * 2;
    const size_t tstep = 2 * hstep;
    const unsigned ldsw = (unsigned)wid * 1024u;
    const int aoff = lds_byte(wr * 64 + fr, fq * 8), boff = lds_byte(wc * 32 + fr, fq * 8);
#define PG8_SA(b, h) (((b) * 2 + (h)) * HTB)
#define PG8_SB(b, h) ((4 + (b) * 2 + (h)) * HTB)
#define PG8_STAGE(bufoff, gbase, voff) do { _Pragma("unroll") for (int _i = 0; _i < 2; ++_i) \
        __builtin_amdgcn_global_load_lds((const unsigned*)((const char*)(gbase) + (voff)[_i]), (PG8_LAS unsigned*)(lds + (bufoff) + ldsw + _i * 8192), 16, 0, 0); } while (0)
#define PG8_LDA(dst, b, h) do { _Pragma("unroll") for (int m = 0; m < 4; ++m) _Pragma("unroll") for (int k = 0; k < 2; ++k) dst[m][k] = *(const PG8_LAS bf16x8*)(lds + PG8_SA(b, h) + aoff + m * 2048 + k * 1024); } while (0)
#define PG8_LDB(dst, b, h) do { _Pragma("unroll") for (int n = 0; n < 2; ++n) _Pragma("unroll") for (int k = 0; k < 2; ++k) dst[n][k] = *(const PG8_LAS bf16x8*)(lds + PG8_SB(b, h) + boff + n * 2048 + k * 1024); } while (0)
#define PG8_MMA(ai, bj, At, Bt) do { __builtin_amdgcn_s_setprio(1); _Pragma("unroll") for (int m = 0; m < 4; ++m) _Pragma("unroll") for (int n = 0; n < 2; ++n) _Pragma("unroll") for (int k = 0; k < 2; ++k) \
        acc[ai][bj][m][n] = __builtin_amdgcn_mfma_f32_16x16x32_bf16(Bt[n][k], At[m][k], acc[ai][bj][m][n], 0, 0, 0); __builtin_amdgcn_s_setprio(0); } while (0)
#define PG8_WAIT_V(n) asm volatile("s_waitcnt vmcnt(" #n ")" ::: "memory")
#define PG8_WAIT_L(n) asm volatile("s_waitcnt lgkmcnt(" #n ")" ::: "memory")
#define PG8_BAR __builtin_amdgcn_s_barrier()
#define PG8_SCHED __builtin_amdgcn_sched_barrier(0)
    Unit cur, nxt; int ui = 0;
    if (!S.next(0, cur)) return;
    f32x4 acc[2][2][4][2];
#pragma unroll
    for (int a = 0; a < 2; ++a)
#pragma unroll
        for (int b = 0; b < 2; ++b)
#pragma unroll
            for (int m = 0; m < 4; ++m)
#pragma unroll
                for (int n = 0; n < 2; ++n) acc[a][b][m][n] = (f32x4){0.f, 0.f, 0.f, 0.f};
    bf16x8 At[4][2], B0[2][2], B1[2][2];
    const char* cA = (const char*)g.A + (size_t)cur.pm * tstep; const char* cB = (const char*)g.Bt + (size_t)cur.pn * tstep;
    S.a_ready(cur);
    if constexpr (SP2) {
        PG8_STAGE(PG8_SB(0, 0), cB, voffB); PG8_STAGE(PG8_SB(0, 1), cB + hstep, voffB); PG8_STAGE(PG8_SA(0, 0), cA, voffA); PG8_STAGE(PG8_SA(0, 1), cA + hstep, voffA);
        if (wr == 1) PG8_BAR;
        PG8_WAIT_V(2); PG8_BAR;
        PG8_STAGE(PG8_SB(1, 0), cB + kstep, voffB); PG8_STAGE(PG8_SA(1, 0), cA + kstep, voffA); PG8_STAGE(PG8_SB(1, 1), cB + hstep + kstep, voffB);
        PG8_WAIT_V(6); PG8_BAR;
    } else {
        PG8_STAGE(PG8_SB(0, 0), cB, voffB); PG8_STAGE(PG8_SA(0, 0), cA, voffA); PG8_STAGE(PG8_SB(0, 1), cB + hstep, voffB); PG8_STAGE(PG8_SA(0, 1), cA + hstep, voffA);
        if (wr == 1) PG8_BAR;
        PG8_WAIT_V(4); PG8_BAR;
        PG8_STAGE(PG8_SB(1, 0), cB + kstep, voffB); PG8_STAGE(PG8_SA(1, 0), cA + kstep, voffA); PG8_STAGE(PG8_SB(1, 1), cB + hstep + kstep, voffB);
        PG8_WAIT_V(6); PG8_BAR;
    }
    for (;;) {
        const bool has_next = S.next(ui + 1, nxt);
        const char* nA = has_next ? (const char*)g.A + (size_t)nxt.pm * tstep : cA; const char* nB = has_next ? (const char*)g.Bt + (size_t)nxt.pn * tstep : cB;
        for (int t = 0; t < nt; t += 2) {
            const bool last = (t == nt - 2);
            const char* a1 = cA + (size_t)(t + 1) * kstep;
            const char* a2 = last ? nA : cA + (size_t)(t + 2) * kstep; const char* b2 = last ? nB : cB + (size_t)(t + 2) * kstep;
            const char* a3 = a2 + kstep; const char* b3 = b2 + kstep;
            if (last && has_next) S.a_ready(nxt);
            if constexpr (SP2) {
            PG8_LDB(B0, 0, 0); PG8_LDB(B1, 0, 1); PG8_SCHED; PG8_LDA(At, 0, 0); PG8_STAGE(PG8_SA(1, 1), a1 + hstep, voffA);
            PG8_WAIT_V(8); PG8_WAIT_L(0); PG8_BAR; PG8_MMA(0, 0, At, B0); PG8_MMA(0, 1, At, B1); PG8_BAR; PG8_SCHED;
            PG8_LDA(At, 0, 1); PG8_STAGE(PG8_SB(0, 0), b2, voffB); PG8_STAGE(PG8_SB(0, 1), b2 + hstep, voffB); PG8_STAGE(PG8_SA(0, 0), a2, voffA);
            PG8_WAIT_V(8); PG8_WAIT_L(0); PG8_BAR; PG8_MMA(1, 0, At, B0); PG8_MMA(1, 1, At, B1); PG8_BAR; PG8_SCHED;
            PG8_LDB(B0, 1, 0); PG8_LDB(B1, 1, 1); PG8_SCHED; PG8_LDA(At, 1, 0); PG8_STAGE(PG8_SA(0, 1), a2 + hstep, voffA);
            PG8_WAIT_V(8); PG8_WAIT_L(0); PG8_BAR; PG8_MMA(0, 0, At, B0); PG8_MMA(0, 1, At, B1); PG8_BAR; PG8_SCHED;
            PG8_LDA(At, 1, 1); PG8_STAGE(PG8_SB(1, 0), b3, voffB); PG8_STAGE(PG8_SB(1, 1), b3 + hstep, voffB); PG8_STAGE(PG8_SA(1, 0), a3, voffA);
            PG8_WAIT_V(8); PG8_WAIT_L(0); PG8_BAR; PG8_MMA(1, 0, At, B0); PG8_MMA(1, 1, At, B1); PG8_BAR; PG8_SCHED;
            } else {
            PG8_LDB(B0, 0, 0); PG8_SCHED; PG8_LDA(At, 0, 0); PG8_STAGE(PG8_SA(1, 1), a1 + hstep, voffA);
            PG8_WAIT_L(8); PG8_BAR; PG8_WAIT_L(0); PG8_MMA(0, 0, At, B0); PG8_BAR; PG8_SCHED;
            PG8_LDB(B1, 0, 1); PG8_STAGE(PG8_SB(0, 0), b2, voffB);
            PG8_BAR; PG8_WAIT_L(0); PG8_MMA(0, 1, At, B1); PG8_BAR;
            PG8_LDA(At, 0, 1); PG8_STAGE(PG8_SA(0, 0), a2, voffA);
            PG8_BAR; PG8_WAIT_L(0); PG8_MMA(1, 0, At, B0); PG8_BAR; PG8_SCHED;
            PG8_STAGE(PG8_SB(0, 1), b2 + hstep, voffB);
            PG8_WAIT_V(6); PG8_BAR; PG8_MMA(1, 1, At, B1); PG8_BAR;
            PG8_LDB(B0, 1, 0); PG8_SCHED; PG8_LDA(At, 1, 0); PG8_STAGE(PG8_SA(0, 1), a2 + hstep, voffA);
            PG8_WAIT_L(8); PG8_BAR; PG8_WAIT_L(0); PG8_MMA(0, 0, At, B0); PG8_BAR; PG8_SCHED;
            PG8_LDB(B1, 1, 1); PG8_STAGE(PG8_SB(1, 0), b3, voffB);
            PG8_BAR; PG8_WAIT_L(0); PG8_MMA(0, 1, At, B1); PG8_BAR;
            PG8_LDA(At, 1, 1); PG8_STAGE(PG8_SA(1, 0), a3, voffA);
            PG8_BAR; PG8_WAIT_L(0); PG8_MMA(1, 0, At, B0); PG8_BAR; PG8_SCHED;
            PG8_STAGE(PG8_SB(1, 1), b3 + hstep, voffB);
            PG8_WAIT_V(6); PG8_BAR; PG8_MMA(1, 1, At, B1); PG8_BAR;
            }
        }
        if constexpr (ALIGN_EPI) { if (wr == 0) PG8_BAR; }
        if constexpr (!Epi::AFTER_DRAIN) { E(acc, cur, wr, wc, fr, fq); S.done(cur); }
        if (!has_next) break;
#pragma unroll
        for (int a = 0; a < 2; ++a)
#pragma unroll
            for (int b = 0; b < 2; ++b)
#pragma unroll
                for (int m = 0; m < 4; ++m)
#pragma unroll
                    for (int n = 0; n < 2; ++n) acc[a][b][m][n] = (f32x4){0.f, 0.f, 0.f, 0.f};
        cur = nxt; cA = nA; cB = nB; ++ui;
        if constexpr (ALIGN_EPI) { if (wr == 1) PG8_BAR; }
    }
    PG8_WAIT_V(0);
    if constexpr (!ALIGN_EPI) { if (wr == 0) PG8_BAR; }
    PG8_BAR;
    if constexpr (Epi::AFTER_DRAIN) { E.fused(acc, cur, wr, wc, fr, fq, lds, wid, lane); S.done(cur); }
#undef PG8_SA
#undef PG8_SB
#undef PG8_STAGE
#undef PG8_LDA
#undef PG8_LDB
#undef PG8_MMA
#undef PG8_WAIT_V
#undef PG8_WAIT_L
#undef PG8_BAR
#undef PG8_SCHED
}
}
#define LAS __attribute__((address_space(3)))
#define DI __device__ __forceinline__
typedef unsigned short bf16;
typedef unsigned v4u __attribute__((ext_vector_type(4)));
typedef unsigned v2u __attribute__((ext_vector_type(2)));
typedef float f32x4 __attribute__((ext_vector_type(4)));
typedef short bf16x8 __attribute__((ext_vector_type(8)));
constexpr int NTHREADS = 512, NWAVES = 8;
constexpr int D = 1024, NREAL = 16384, MROWS = 16640, LSEQ = 8208, FF = 4096, DIN = 5664, NCHUNK = 129;
constexpr int LDG = 8320, KH = 2176;
constexpr size_t MiB = 1u << 20;
constexpr size_t WS_PART1 = 0;
constexpr size_t WS_ALL = 1 * MiB;
constexpr size_t WS_WOT = 46 * MiB, WS_WFT = 48 * MiB, WS_WOUTT = 49 * MiB, WS_W1T = 51 * MiB, WS_W2T = 59 * MiB;
constexpr size_t WS_TAB = 67 * MiB;
constexpr size_t WS_CS = 68 * MiB + 512 * 1024;
constexpr size_t WS_GT2 = 136 * MiB + 512 * 1024;
constexpr size_t WS_EOT = 169 * MiB;
constexpr size_t WS_REMP = 186 * MiB;
constexpr size_t WS_PQ = 189 * MiB;
constexpr size_t WS_K = 221 * MiB;
constexpr size_t WS_R = 237 * MiB + 512 * 1024;
constexpr size_t WS_FN = 240 * MiB;
constexpr size_t DO_V = 0, DO_Q = 33 * MiB, DO_OB = 0;
constexpr size_t WS_QI = 69 * MiB;
constexpr size_t WS_KDT = 102 * MiB;
constexpr size_t WS_VT = 135 * MiB;
constexpr size_t WS_PM = 168 * MiB;
constexpr size_t WS_DEC = 184 * MiB + 512 * 1024;
constexpr size_t WS_OF = 189 * MiB;
constexpr size_t WS_ON = 69 * MiB, WS_SGA = 101 * MiB, WS_SGF = 133 * MiB, WS_OG = 165 * MiB, WS_MG = 197 * MiB;
constexpr size_t WS_H1B = 69 * MiB, WS_HF = 101 * MiB;
constexpr int LDS_BYTES = 151552;
struct Args {
    const float *x, *meta, *norm_mix, *w_in, *wdf, *bdf, *wdb, *bdb, *gla_norm, *w_o, *w_fnet, *w_out, *norm_ffn, *w_ff1, *w_ff2, *norm_final;
    float* out; unsigned char* ws; int ph_lo, ph_hi;
};
DI unsigned f2bf(float f) { unsigned u = __builtin_bit_cast(unsigned, f); return (u + 0x7fffu + ((u >> 16) & 1u)) >> 16; }
DI unsigned pk2(float lo, float hi) { return f2bf(lo) | (f2bf(hi) << 16); }
DI float bf2f(unsigned h) { return __uint_as_float(h << 16); }
DI float wave_sum(float v) {
#pragma unroll
    for (int o = 1; o < 64; o <<= 1) v += __shfl_xor(v, o);
    return v;
}
DI void transpose_item(const float* W, int pitch, int K, int ncols, bf16* WT, int row_off, LAS float* scr, int item, int lane, const float* kscale) {
    const int nblk = ncols / 32, kb = item / nblk, nb = item % nblk, k0 = 64 * kb, n0 = 32 * nb;
#pragma unroll 8
    for (int i = 0; i < 32; ++i) { const int kk = 2 * i + (lane >> 5); float v = W[(size_t)(k0 + kk) * pitch + n0 + (lane & 31)]; if (kscale) v *= kscale[k0 + kk]; scr[kk * 33 + (lane & 31)] = v; }
    asm volatile("s_waitcnt lgkmcnt(0)" ::: "memory");
    const int c = lane & 7;
#pragma unroll
    for (int j = 0; j < 4; ++j) { const int n = (lane >> 3) + 8 * j; const LAS float* s = scr + (8 * c) * 33 + n;
        v4u o; o.x = pk2(s[0 * 33], s[1 * 33]); o.y = pk2(s[2 * 33], s[3 * 33]); o.z = pk2(s[4 * 33], s[5 * 33]); o.w = pk2(s[6 * 33], s[7 * 33]);
        *(v4u*)(WT + (size_t)(row_off + n0 + n) * K + k0 + 8 * c) = o; }
    asm volatile("s_waitcnt lgkmcnt(0)" ::: "memory");
}
DI void rms_row_to_bf16(const float* xrow, const float* gain, bf16* orow, int lane) {
    const f32x4* xr = (const f32x4*)xrow + lane; const f32x4* gr = (const f32x4*)gain + lane;
    f32x4 v[4]; float s = 0.f;
#pragma unroll
    for (int j = 0; j < 4; ++j) { v[j] = xr[64 * j]; s += (v[j].x * v[j].x + v[j].y * v[j].y) + (v[j].z * v[j].z + v[j].w * v[j].w); }
    const float rstd = 1.f / sqrtf(wave_sum(s) * (1.f / 1024.f) + 1e-6f);
    unsigned long long* o8 = (unsigned long long*)orow + lane;
#pragma unroll
    for (int j = 0; j < 4; ++j) { const f32x4 g = gr[64 * j];
        o8[64 * j] = (unsigned long long)pk2(v[j].x * rstd * g.x, v[j].y * rstd * g.y) | ((unsigned long long)pk2(v[j].z * rstd * g.z, v[j].w * rstd * g.w) << 32); }
}

DI void p0_prologue(const Args& a, LAS unsigned char* lds, int tid, int lane, int wave, int bid, int G) {
    unsigned char* ws = a.ws;
    bf16* ALL = (bf16*)(ws + WS_ALL);
    const int gw = bid * NWAVES + wave, NGW = G * NWAVES;
    const int gt = bid * NTHREADS + tid, NGT = G * NTHREADS;
    LAS float* tabc = (LAS float*)lds; LAS float* tabs = tabc + LSEQ;
    for (int j = tid; j < LSEQ; j += NTHREADS) { const float ang = 6.283185307179586f * (float)j / (float)LSEQ; tabc[j] = cosf(ang); tabs[j] = sinf(ang); }
    __syncthreads();
    {
        bf16* CS = (bf16*)(ws + WS_CS);
        const int nchunk = 4 * 4096 * (KH / 8);
        for (int ch = gt; ch < nchunk; ch += NGT) {
            const int k8 = ch % (KH / 8); const int rest = ch / (KH / 8); const int idx = rest & 4095, grp = rest >> 12, cs = grp >> 1, kh = grp & 1;
            const int m = idx + 9, l0 = kh * KH + k8 * 8;
            unsigned j = ((unsigned)l0 * (unsigned)m) % (unsigned)LSEQ;
            float v[8];
#pragma unroll
            for (int e = 0; e < 8; ++e) { v[e] = (l0 + e <= 4104) ? (cs ? tabs[j] : tabc[j]) : 0.f; j += m; if (j >= (unsigned)LSEQ) j -= LSEQ; }
            v4u o; o.x = pk2(v[0], v[1]); o.y = pk2(v[2], v[3]); o.z = pk2(v[4], v[5]); o.w = pk2(v[6], v[7]);
            *(v4u*)(CS + (size_t)ch * 8) = o;
        }
        bf16* TAB = (bf16*)(ws + WS_TAB);
        const int nch2 = 32 * 2 * (LDG / 8);
        for (int ch = gt; ch < nch2; ch += NGT) {
            const int l8 = ch % (LDG / 8); const int rest = ch / (LDG / 8); const int cs = rest & 1, rho = rest >> 1;
            const int lp = 8200 + rho, l0 = l8 * 8;
            unsigned j = ((unsigned)l0 * (unsigned)lp) % (unsigned)LSEQ;
            float v[8];
#pragma unroll
            for (int e = 0; e < 8; ++e) { v[e] = (rho < 8 && l0 + e < LSEQ) ? (cs ? -tabs[j] : tabc[j]) : 0.f; j += lp; while (j >= (unsigned)LSEQ) j -= LSEQ; }
            v4u o; o.x = pk2(v[0], v[1]); o.y = pk2(v[2], v[3]); o.z = pk2(v[4], v[5]); o.w = pk2(v[6], v[7]);
            *(v4u*)(TAB + (size_t)ch * 8) = o;
        }
    }
    __syncthreads();
    {
        LAS float* Wl = (LAS float*)lds;
        LAS float* c128 = Wl + 64 * 128; LAS float* s128 = c128 + 128;
        if (tid < 128) { const float ang = 6.283185307179586f * (float)tid / 128.f; c128[tid] = cosf(ang); s128[tid] = sinf(ang); }
        for (int item = bid; item < 64; item += G) {
            const int kb = item >> 2, g = item & 3;
            __syncthreads();
            for (int idx = tid; idx < 64 * 128; idx += NTHREADS) { const int kk = idx >> 7, c = idx & 127; Wl[idx] = a.w_in[(size_t)(kb * 64 + kk) * DIN + 3104 + g * 128 + c]; }
            __syncthreads();
            const int n = tid & 127, kq = tid >> 7;
            unsigned pc[8], ps[8];
#pragma unroll 1
            for (int k2 = 0; k2 < 8; ++k2) {
                float ac0 = 0.f, as0 = 0.f, ac1 = 0.f, as1 = 0.f;
                const LAS float* w0 = Wl + (kq * 16 + 2 * k2) * 128; const LAS float* w1 = w0 + 128;
                for (int c = 0; c < 128; ++c) { const int j = (c * n) & 127; const float cc = c128[j], ss = s128[j]; ac0 += w0[c] * cc; as0 += w0[c] * ss; ac1 += w1[c] * cc; as1 += w1[c] * ss; }
                pc[k2] = pk2(ac0, ac1); ps[k2] = pk2(as0, as1);
            }
            bf16* dc = ALL + (size_t)(74 * 256 + g * 128 + n) * D + kb * 64 + kq * 16;
            bf16* ds = ALL + (size_t)(76 * 256 + g * 128 + n) * D + kb * 64 + kq * 16;
            *(v4u*)dc = (v4u){pc[0], pc[1], pc[2], pc[3]}; *(v4u*)(dc + 8) = (v4u){pc[4], pc[5], pc[6], pc[7]};
            *(v4u*)ds = (v4u){ps[0], ps[1], ps[2], ps[3]}; *(v4u*)(ds + 8) = (v4u){ps[4], ps[5], ps[6], ps[7]};
        }
        __syncthreads();
    }
    {
        LAS float* scr = (LAS float*)(lds + wave * 16384);
        bf16* WT = ALL + (size_t)65 * 256 * D;
        const int I_Q = 16 * 16, I_V = 16 * 32, I_R = 16 * 1, I_G = 16 * 32;
        const int I_O = 16 * 32, I_F = 8 * 32, I_1 = 16 * 128, I_2 = 64 * 32;
        const int NIT = 2 * I_Q + I_V + I_R + 3 * I_G + 2 * I_O + I_F + I_1 + I_2;
        for (int it = gw; it < NIT; it += NGW) {
            int r = it;
            if (r < I_Q) { transpose_item(a.w_in + 0, DIN, D, 512, WT, 0, scr, r, lane, nullptr); continue; } r -= I_Q;
            if (r < I_Q) { transpose_item(a.w_in + 512, DIN, D, 512, WT, 512, scr, r, lane, nullptr); continue; } r -= I_Q;
            if (r < I_V) { transpose_item(a.w_in + 1024, DIN, D, 1024, WT, 1024, scr, r, lane, nullptr); continue; } r -= I_V;
            if (r < I_R) { transpose_item(a.w_in + 3072, DIN, D, 32, WT, 2048, scr, r, lane, nullptr); continue; } r -= I_R;
            if (r < I_G) { transpose_item(a.w_in + 2048, DIN, D, 1024, WT, 13 * 256, scr, r, lane, nullptr); continue; } r -= I_G;
            if (r < I_G) { transpose_item(a.w_in + 3616, DIN, D, 1024, WT, 17 * 256, scr, r, lane, nullptr); continue; } r -= I_G;
            if (r < I_G) { transpose_item(a.w_in + 4640, DIN, D, 1024, WT, 21 * 256, scr, r, lane, nullptr); continue; } r -= I_G;
            if (r < I_O) { transpose_item(a.w_o, D, D, 1024, (bf16*)(ws + WS_WOT), 0, scr, r, lane, nullptr); continue; } r -= I_O;
            if (r < I_O) { transpose_item(a.w_out, D, D, 1024, (bf16*)(ws + WS_WOUTT), 0, scr, r, lane, nullptr); continue; } r -= I_O;
            if (r < I_F) { transpose_item(a.w_fnet, D, 512, 1024, (bf16*)(ws + WS_WFT), 0, scr, r, lane, nullptr); continue; } r -= I_F;
            if (r < I_1) { transpose_item(a.w_ff1, FF, D, FF, (bf16*)(ws + WS_W1T), 0, scr, r, lane, a.norm_ffn); continue; } r -= I_1;
            transpose_item(a.w_ff2, D, FF, 1024, (bf16*)(ws + WS_W2T), 0, scr, r, lane, nullptr);
        }
    }
    {
        bf16* t8 = ALL + (size_t)(73 * 256 + 32) * D;
        for (int i = gt; i < 224 * D / 8; i += NGT) *(v4u*)(t8 + (size_t)i * 8) = (v4u){0u, 0u, 0u, 0u};
        bf16* x64 = ALL + (size_t)16384 * D;
        for (int i = gt; i < 256 * D / 8; i += NGT) { const int row = i / (D / 8); if (row < 48 || row >= 64) *(v4u*)(x64 + (size_t)i * 8) = (v4u){0u, 0u, 0u, 0u}; }
        bf16* GT2 = (bf16*)(ws + WS_GT2);
        for (int i = gt; i < 2048 * 14; i += NGT) { const int row = i / 14, c = i % 14; *(v4u*)(GT2 + (size_t)row * LDG + LSEQ + c * 8) = (v4u){0u, 0u, 0u, 0u}; }
    }
    for (int m = gw; m < NREAL + 16; m += NGW) {
        if (m < NREAL) rms_row_to_bf16(a.x + (size_t)m * D, a.norm_mix, ALL + (size_t)m * D, lane);
        else rms_row_to_bf16(a.meta + (size_t)(m - NREAL) * D, a.norm_mix, ALL + (size_t)(NREAL + 48 + (m - NREAL)) * D, lane);
    }
}
DI void p2_sym_rem(const Args& a, int tid, int lane, int wave, int bid, int G) {
    unsigned char* ws = a.ws;
    const bf16* GT2 = (const bf16*)(ws + WS_GT2);
    bf16* EOT = (bf16*)(ws + WS_EOT);
    const int gt = bid * NTHREADS + tid, NGT = G * NTHREADS;
    const int nchunk = 4 * 1024 * (KH / 8);
    for (int ch = gt; ch < nchunk; ch += NGT) {
        const int k8 = ch % (KH / 8); const int rest = ch / (KH / 8); const int n = rest & 1023, grp = rest >> 10, cs = grp >> 1, kh = grp & 1;
        const int l0 = kh * KH + k8 * 8;
        const bf16* src = GT2 + ((size_t)n * 2 + cs) * LDG;
        float v[8];
        if (l0 > 4104) {
#pragma unroll
            for (int e = 0; e < 8; ++e) v[e] = 0.f;
        } else {
            const v4u f = *(const v4u*)(src + l0);
            const float fw[8] = {bf2f(f.x & 0xffffu), bf2f(f.x >> 16), bf2f(f.y & 0xffffu), bf2f(f.y >> 16), bf2f(f.z & 0xffffu), bf2f(f.z >> 16), bf2f(f.w & 0xffffu), bf2f(f.w >> 16)};
#pragma unroll
            for (int e = 0; e < 8; ++e) { const int l = l0 + e;
                if (l > 4104) v[e] = 0.f;
                else if (l == 0 || l == 4104) v[e] = cs ? 0.f : fw[e];
                else { const float mir = bf2f((unsigned)src[LSEQ - l]); v[e] = cs ? fw[e] - mir : fw[e] + mir; } }
        }
        v4u o; o.x = pk2(v[0], v[1]); o.y = pk2(v[2], v[3]); o.z = pk2(v[4], v[5]); o.w = pk2(v[6], v[7]);
        *(v4u*)(EOT + (size_t)ch * 8) = o;
    }
    typedef float f32x16 __attribute__((ext_vector_type(16)));
    const bf16* TAB = (const bf16*)(ws + WS_TAB);
    float* REMP = (float*)(ws + WS_REMP);
    const int gw = bid * NWAVES + wave, NGW = G * NWAVES;
    for (int task = gw; task < 32 * 65; task += NGW) {
        const int nt = task & 31, ks = task >> 5; const int r = lane & 31, h = lane >> 5;
        f32x16 acc; for (int i = 0; i < 16; ++i) acc[i] = 0.f;
        const bf16* ap = TAB + (size_t)r * (2 * LDG) + ks * 256 + 8 * h;
        const bf16* bp = GT2 + (size_t)(nt * 32 + r) * (2 * LDG) + ks * 256 + 8 * h;
#pragma unroll 4
        for (int kk = 0; kk < 16; ++kk) { const bf16x8 af = *(const bf16x8*)(ap + kk * 16), bfr = *(const bf16x8*)(bp + kk * 16);
            acc = __builtin_amdgcn_mfma_f32_32x32x16_bf16(af, bfr, acc, 0, 0, 0); }
#pragma unroll
        for (int i = 0; i < 4; ++i) REMP[((size_t)ks * 8 + i + 4 * h) * 1024 + nt * 32 + r] = acc[i];
    }
}

DI void p4_combine(const Args& a, int tid, int bid, int G) {
    unsigned char* ws = a.ws;
    const bf16* PQ = (const bf16*)(ws + WS_PQ); const float* REMP = (const float*)(ws + WS_REMP); bf16* FN = (bf16*)(ws + WS_FN);
    const float scale = 0.0009756003f;
    const int gt = bid * NTHREADS + tid, NGT = G * NTHREADS;
    for (int ch = gt; ch < NREAL * 64; ch += NGT) {
        const int c8 = ch & 63, row = ch >> 6, b = row >> 13, s = row & 8191, l = s + 16, n = b * 512 + c8 * 8;
        float v[8];
        if (l >= 8200) { const int rho = l - 8200;
#pragma unroll
            for (int e = 0; e < 8; ++e) v[e] = 0.f;
            for (int ks = 0; ks < 65; ++ks) { const f32x4 p0 = *(const f32x4*)(REMP + ((size_t)ks * 8 + rho) * 1024 + n), p1 = *(const f32x4*)(REMP + ((size_t)ks * 8 + rho) * 1024 + n + 4);
                v[0] += p0[0]; v[1] += p0[1]; v[2] += p0[2]; v[3] += p0[3]; v[4] += p1[0]; v[5] += p1[1]; v[6] += p1[2]; v[7] += p1[3]; }
        } else {
            const bool mir = l > 4104; const int idx = (mir ? LSEQ - l : l) - 9; const float sg = mir ? 1.f : -1.f;
            const size_t off = (size_t)idx * 1024 + n;
            const v4u p0 = *(const v4u*)(PQ + off), p1 = *(const v4u*)(PQ + (size_t)4096 * 1024 + off), q0 = *(const v4u*)(PQ + (size_t)2 * 4096 * 1024 + off), q1 = *(const v4u*)(PQ + (size_t)3 * 4096 * 1024 + off);
            const unsigned pp0[4] = {p0.x, p0.y, p0.z, p0.w}, pp1[4] = {p1.x, p1.y, p1.z, p1.w}, qq0[4] = {q0.x, q0.y, q0.z, q0.w}, qq1[4] = {q1.x, q1.y, q1.z, q1.w};
#pragma unroll
            for (int e = 0; e < 4; ++e) {
                v[2 * e] = (bf2f(pp0[e] & 0xffffu) + bf2f(pp1[e] & 0xffffu)) + sg * (bf2f(qq0[e] & 0xffffu) + bf2f(qq1[e] & 0xffffu));
                v[2 * e + 1] = (bf2f(pp0[e] >> 16) + bf2f(pp1[e] >> 16)) + sg * (bf2f(qq0[e] >> 16) + bf2f(qq1[e] >> 16)); }
        }
        v4u o; o.x = pk2(v[0] * scale, v[1] * scale); o.y = pk2(v[2] * scale, v[3] * scale); o.z = pk2(v[4] * scale, v[5] * scale); o.w = pk2(v[6] * scale, v[7] * scale);
        *(v4u*)(FN + (size_t)row * 512 + c8 * 8) = o;
    }
}

DI void p6_post(const Args& a, int lane, int wave, int bid, int G) {
    unsigned char* ws = a.ws;
    const bf16* OF = (const bf16*)(ws + WS_OF); const bf16* OB = (const bf16*)((unsigned char*)a.out + DO_OB); bf16* ON = (bf16*)(ws + WS_ON);
    const int gw = bid * NWAVES + wave, NGW = G * NWAVES;
    const int c0 = lane * 16;
    float gn[16];
#pragma unroll
    for (int e = 0; e < 16; ++e) gn[e] = a.gla_norm[(c0 & 255) + e];
    for (int row = gw; row < NREAL; row += NGW) {
        const size_t off = (size_t)row * 1024 + c0;
        const v4u f0 = *(const v4u*)(OF + off), f1 = *(const v4u*)(OF + off + 8), b0 = *(const v4u*)(OB + off), b1 = *(const v4u*)(OB + off + 8);
        const unsigned fw[8] = {f0.x, f0.y, f0.z, f0.w, f1.x, f1.y, f1.z, f1.w}, bw[8] = {b0.x, b0.y, b0.z, b0.w, b1.x, b1.y, b1.z, b1.w};
        float v[16]; float ss = 0.f;
#pragma unroll
        for (int e = 0; e < 8; ++e) { v[2 * e] = bf2f(fw[e] & 0xffffu) + bf2f(bw[e] & 0xffffu); v[2 * e + 1] = bf2f(fw[e] >> 16) + bf2f(bw[e] >> 16); ss += v[2 * e] * v[2 * e] + v[2 * e + 1] * v[2 * e + 1]; }
        ss += __shfl_xor(ss, 1); ss += __shfl_xor(ss, 2); ss += __shfl_xor(ss, 4); ss += __shfl_xor(ss, 8);
        const float rstd = 1.f / sqrtf(ss * (1.f / 256.f) + 1e-6f);
        unsigned w[8];
#pragma unroll
        for (int e = 0; e < 8; ++e) w[e] = pk2(v[2 * e] * rstd * gn[2 * e], v[2 * e + 1] * rstd * gn[2 * e + 1]);
        *(v4u*)(ON + off) = (v4u){w[0], w[1], w[2], w[3]}; *(v4u*)(ON + off + 8) = (v4u){w[4], w[5], w[6], w[7]};
    }
}

DI void p11_final(const Args& a, int lane, int wave, int bid, int G) {
    const int gw = bid * NWAVES + wave, NGW = G * NWAVES;
    for (int row = gw; row < NREAL; row += NGW) {
        f32x4* xr = (f32x4*)(a.out + (size_t)row * D) + lane; const f32x4* gr = (const f32x4*)a.norm_final + lane;
        f32x4 v[4]; float s = 0.f;
#pragma unroll
        for (int j = 0; j < 4; ++j) { v[j] = xr[64 * j]; s += (v[j].x * v[j].x + v[j].y * v[j].y) + (v[j].z * v[j].z + v[j].w * v[j].w); }
        const float rstd = 1.f / sqrtf(wave_sum(s) * (1.f / 1024.f) + 1e-6f);
#pragma unroll
        for (int j = 0; j < 4; ++j) { const f32x4 g = gr[64 * j]; xr[64 * j] = (f32x4){v[j].x * rstd * g.x, v[j].y * rstd * g.y, v[j].z * rstd * g.z, v[j].w * rstd * g.w}; }
    }
}
DI float logsig(float x) { return fminf(x, 0.f) - __logf(1.f + __expf(-fabsf(x))); }
DI size_t tile_idx(int dir, int b, int h, int c) { return (size_t)((dir * 2 + b) * 4 + h) * NCHUNK + c; }
DI void p4_gla_prep(const Args& a, LAS unsigned char* lds, int tid, int lane, int wave, int bid, int G) {
    unsigned char* ws = a.ws;
    const bf16* Qg = (const bf16*)((unsigned char*)a.out + DO_Q); const bf16* Kg = (const bf16*)(ws + WS_K); const bf16* Vg = (const bf16*)((unsigned char*)a.out + DO_V);
    const float* Rg = (const float*)(ws + WS_R);
    bf16* QI = (bf16*)(ws + WS_QI); bf16* KDT = (bf16*)(ws + WS_KDT); bf16* PM = (bf16*)(ws + WS_PM); bf16* VT = (bf16*)(ws + WS_VT); float* DEC = (float*)(ws + WS_DEC);
    LAS float* BF = (LAS float*)lds; LAS float* BB = BF + 64 * 128;
    LAS unsigned char* QF = lds + 65536; LAS unsigned char* KF = QF + 17408; LAS unsigned char* QB = KF + 17408; LAS unsigned char* KB = QB + 17408;
    LAS unsigned char* KRAW = lds + 135168;
    LAS float* RS = (LAS float*)QF; LAS float* WD = RS + 64 * 32;
    LAS unsigned char* VS = lds;
    for (int task = bid; task < 2 * NCHUNK * 4; task += G) {
        const int h = task & 3, c = (task >> 2) % NCHUNK, b = (task >> 2) / NCHUNK;
        const int row0 = (c == 0) ? NREAL : b * 8192 + 64 * (c - 1);
        for (int idx = tid; idx < 64 * 32; idx += NTHREADS) RS[idx] = Rg[(size_t)(row0 + (idx >> 5)) * 32 + (idx & 31)];
        for (int idx = tid; idx < 2 * 16 * 128; idx += NTHREADS) { const int dir = idx >> 11, j = (idx >> 7) & 15, d = idx & 127; WD[idx] = (dir ? a.wdb : a.wdf)[j * 512 + h * 128 + d]; }
        __syncthreads();
        {
            const int d = tid & 127, part = tid >> 7; const float bfw = a.bdf[h * 128 + d], bbw = a.bdb[h * 128 + d];
            for (int ii = 0; ii < 16; ++ii) { const int i = part * 16 + ii; float lf = bfw, lb = bbw;
#pragma unroll
                for (int j = 0; j < 16; ++j) { lf += RS[i * 32 + j] * WD[j * 128 + d]; lb += RS[i * 32 + 16 + j] * WD[2048 + j * 128 + d]; }
                float laf = logsig(lf) * 0.0625f, lab = logsig(lb) * 0.0625f;
                if (c == 0 && i < 48) { laf = 0.f; lab = 0.f; }
                BF[i * 128 + d] = laf; BB[i * 128 + d] = lab; }
        }
        __syncthreads();
        if (tid < 128) { float s = 0.f; for (int i = 0; i < 64; ++i) { s += BF[i * 128 + tid]; BF[i * 128 + tid] = s; } DEC[tile_idx(0, b, h, c) * 128 + tid] = __expf(s); }
        else if (tid < 256) { const int d = tid - 128; float s = 0.f; for (int i = 63; i >= 0; --i) { s += BB[i * 128 + d]; BB[i * 128 + d] = s; } DEC[tile_idx(1, b, h, c) * 128 + d] = __expf(s); }
        __syncthreads();
        for (int rep = 0; rep < 2; ++rep) {
            const int g = tid + NTHREADS * rep, i = g >> 4, d0 = (g & 15) * 8;
            const v4u q8 = *(const v4u*)(Qg + (size_t)(row0 + i) * 512 + h * 128 + d0), k8 = *(const v4u*)(Kg + (size_t)(row0 + i) * 512 + h * 128 + d0);
            const unsigned qw[4] = {q8.x, q8.y, q8.z, q8.w}, kw[4] = {k8.x, k8.y, k8.z, k8.w};
            float qf[8], kf[8], qb[8], kb[8], qif[8], qib[8];
#pragma unroll
            for (int e = 0; e < 8; ++e) {
                const int d = d0 + e; const float q = bf2f((e & 1) ? (qw[e >> 1] >> 16) : (qw[e >> 1] & 0xffffu)), k = bf2f((e & 1) ? (kw[e >> 1] >> 16) : (kw[e >> 1] & 0xffffu));
                const float ef = BF[i * 128 + d], eb = BB[i * 128 + d], f31 = BF[31 * 128 + d], b32 = BB[32 * 128 + d];
                qf[e] = q * __expf(ef - f31); kf[e] = k * __expf(f31 - ef); qb[e] = q * __expf(eb - b32); kb[e] = k * __expf(b32 - eb);
                qif[e] = q * __expf(ef); qib[e] = q * __expf(eb);
            }
            *(LAS v4u*)(QF + i * 272 + d0 * 2) = (v4u){pk2(qf[0], qf[1]), pk2(qf[2], qf[3]), pk2(qf[4], qf[5]), pk2(qf[6], qf[7])};
            *(LAS v4u*)(KF + i * 272 + d0 * 2) = (v4u){pk2(kf[0], kf[1]), pk2(kf[2], kf[3]), pk2(kf[4], kf[5]), pk2(kf[6], kf[7])};
            *(LAS v4u*)(QB + i * 272 + d0 * 2) = (v4u){pk2(qb[0], qb[1]), pk2(qb[2], qb[3]), pk2(qb[4], qb[5]), pk2(qb[6], qb[7])};
            *(LAS v4u*)(KB + i * 272 + d0 * 2) = (v4u){pk2(kb[0], kb[1]), pk2(kb[2], kb[3]), pk2(kb[4], kb[5]), pk2(kb[6], kb[7])};
            *(LAS v4u*)(KRAW + i * 256 + d0 * 2) = k8;
            const int kap = d0 >> 5, u = (d0 & 31) >> 3, pc = 32 * kap + 16 * (u & 1) + 4 * (u >> 1);
            bf16* qi_f = QI + tile_idx(0, b, h, c) * 8192 + i * 128 + pc; bf16* qi_b = QI + tile_idx(1, b, h, c) * 8192 + i * 128 + pc;
            *(v2u*)qi_f = (v2u){pk2(qif[0], qif[1]), pk2(qif[2], qif[3])}; *(v2u*)(qi_f + 8) = (v2u){pk2(qif[4], qif[5]), pk2(qif[6], qif[7])};
            *(v2u*)qi_b = (v2u){pk2(qib[0], qib[1]), pk2(qib[2], qib[3])}; *(v2u*)(qi_b + 8) = (v2u){pk2(qib[4], qib[5]), pk2(qib[6], qib[7])};
        }
        __syncthreads();
        {
            const int dir = wave >> 2, tq = wave & 3, fr = lane & 15, g = lane >> 4;
            const LAS unsigned char* QX = dir ? QB : QF; const LAS unsigned char* KX = dir ? KB : KF;
            bf16x8 bq[4];
#pragma unroll
            for (int kap = 0; kap < 4; ++kap) bq[kap] = *(const LAS bf16x8*)(QX + (16 * tq + fr) * 272 + (32 * kap + 8 * g) * 2);
            bf16* pm = PM + tile_idx(dir, b, h, c) * 4096;
            const int i = 16 * tq + fr;
#pragma unroll
            for (int tk = 0; tk < 4; ++tk) {
                f32x4 acc = {0.f, 0.f, 0.f, 0.f};
#pragma unroll
                for (int kap = 0; kap < 4; ++kap) { const bf16x8 af = *(const LAS bf16x8*)(KX + (16 * tk + fr) * 272 + (32 * kap + 8 * g) * 2);
                    acc = __builtin_amdgcn_mfma_f32_16x16x32_bf16(af, bq[kap], acc, 0, 0, 0); }
                float s[4];
#pragma unroll
                for (int e = 0; e < 4; ++e) { const int j = 16 * tk + 4 * g + e; const bool keep = dir ? (j >= i) : (j <= i); s[e] = keep ? acc[e] : 0.f; }
                *(v2u*)(pm + i * 64 + 16 * tk + 4 * g) = (v2u){pk2(s[0], s[1]), pk2(s[2], s[3])};
            }
        }
        {
            const int d = tid & 127, blk = tid >> 7, i0 = blk * 16;
            const float f63 = BF[63 * 128 + d], b0 = BB[d];
            unsigned wf[8], wb[8];
#pragma unroll
            for (int e2 = 0; e2 < 8; ++e2) {
                const int ia = i0 + 2 * e2, ib = ia + 1;
                const float ka = bf2f((unsigned)*(const LAS unsigned short*)(KRAW + ia * 256 + d * 2)), kb2 = bf2f((unsigned)*(const LAS unsigned short*)(KRAW + ib * 256 + d * 2));
                wf[e2] = pk2(ka * __expf(f63 - BF[ia * 128 + d]), kb2 * __expf(f63 - BF[ib * 128 + d]));
                wb[e2] = pk2(ka * __expf(b0 - BB[ia * 128 + d]), kb2 * __expf(b0 - BB[ib * 128 + d]));
            }
            bf16* kf_ = KDT + tile_idx(0, b, h, c) * 8192 + d * 64 + i0; bf16* kb_ = KDT + tile_idx(1, b, h, c) * 8192 + d * 64 + i0;
            *(v4u*)kf_ = (v4u){wf[0], wf[1], wf[2], wf[3]}; *(v4u*)(kf_ + 8) = (v4u){wf[4], wf[5], wf[6], wf[7]};
            *(v4u*)kb_ = (v4u){wb[0], wb[1], wb[2], wb[3]}; *(v4u*)(kb_ + 8) = (v4u){wb[4], wb[5], wb[6], wb[7]};
        }
        __syncthreads();
        for (int rep = 0; rep < 4; ++rep) { const int idx = tid + NTHREADS * rep, i = idx >> 5, u = idx & 31;
            *(LAS v4u*)(VS + i * 528 + u * 16) = *(const v4u*)(Vg + (size_t)(row0 + i) * 1024 + h * 256 + u * 8); }
        __syncthreads();
        {
            const int dv = tid & 255, half = tid >> 8; unsigned w[16];
#pragma unroll
            for (int e2 = 0; e2 < 16; ++e2) { const int ia = 32 * half + 2 * e2;
                w[e2] = (unsigned)*(const LAS unsigned short*)(VS + ia * 528 + dv * 2) | ((unsigned)*(const LAS unsigned short*)(VS + (ia + 1) * 528 + dv * 2) << 16); }
            bf16* vt = VT + ((size_t)(b * 4 + h) * NCHUNK + c) * 16384 + dv * 64 + 32 * half;
#pragma unroll
            for (int q4 = 0; q4 < 4; ++q4) *(v4u*)(vt + 8 * q4) = (v4u){w[4 * q4], w[4 * q4 + 1], w[4 * q4 + 2], w[4 * q4 + 3]};
        }
        __syncthreads();
    }
}

constexpr int SC_QI = 0, SC_KDT = 17408, SC_PM = 35840, SC_DEC = 45056, SC_BUF = 45568;
DI void scan_stage(LAS unsigned char* buf, const bf16* qi, const bf16* kdt, const bf16* pm, const float* dec, int lt) {
    v4u r[6];
#pragma unroll
    for (int it = 0; it < 6; ++it) { const int cid = lt + 448 * it;
        const unsigned char* src;
        if (cid < 1024) src = (const unsigned char*)qi + cid * 16;
        else if (cid < 2048) src = (const unsigned char*)kdt + (cid - 1024) * 16;
        else if (cid < 2560) src = (const unsigned char*)pm + (cid - 2048) * 16;
        else src = (const unsigned char*)dec + (cid - 2560) * 16;
        if (cid < 2592) r[it] = *(const v4u*)src; }
#pragma unroll
    for (int it = 0; it < 6; ++it) { const int cid = lt + 448 * it;
        int dst;
        if (cid < 1024) dst = SC_QI + (cid >> 4) * 272 + (cid & 15) * 16;
        else if (cid < 2048) { const int x = cid - 1024; dst = SC_KDT + (x >> 3) * 144 + (x & 7) * 16; }
        else if (cid < 2560) { const int x = cid - 2048; dst = SC_PM + (x >> 3) * 144 + (x & 7) * 16; }
        else dst = SC_DEC + (cid - 2560) * 16;
        if (cid < 2592) *(LAS v4u*)(buf + dst) = r[it]; }
}
DI void p5_scan(const Args& a, LAS unsigned char* lds, int tid, int lane, int wave, int bid, int G) {
    unsigned char* ws = a.ws;
    const bf16* QI = (const bf16*)(ws + WS_QI); const bf16* KDT = (const bf16*)(ws + WS_KDT); const bf16* PM = (const bf16*)(ws + WS_PM); const bf16* VT = (const bf16*)(ws + WS_VT); const float* DEC = (const float*)(ws + WS_DEC);
    for (int item = bid; item < 256; item += G) {
        const int sl = item & 15, dir = (item >> 4) & 1, h = (item >> 5) & 3, b = item >> 7;
        bf16* O = dir ? (bf16*)((unsigned char*)a.out + DO_OB) : (bf16*)(ws + WS_OF);
        const size_t t0 = tile_idx(dir, b, h, 0);
        const int fr = lane & 15, g = lane >> 4;
        __syncthreads();
        if (wave != 0) { const int c0 = dir ? 128 : 0; scan_stage(lds, QI + (t0 + c0) * 8192, KDT + (t0 + c0) * 8192, PM + (t0 + c0) * 4096, DEC + (t0 + c0) * 128, tid - 64); }
        __syncthreads();
        f32x4 S[8];
#pragma unroll
        for (int j = 0; j < 8; ++j) S[j] = (f32x4){0.f, 0.f, 0.f, 0.f};
        bf16x8 vcur[2] = {}, vnext[2] = {};
        if (wave == 0) { const int c0 = dir ? 128 : 0; const bf16* vt = VT + ((size_t)(b * 4 + h) * NCHUNK + c0) * 16384 + (16 * sl + fr) * 64 + 8 * g;
            vcur[0] = *(const bf16x8*)vt; vcur[1] = *(const bf16x8*)(vt + 32); vnext[0] = vcur[0]; vnext[1] = vcur[1]; }
        for (int s = 0; s < NCHUNK; ++s) {
            const int cs = dir ? 128 - s : s; const int cn = dir ? cs - 1 : cs + 1;
            LAS unsigned char* cur = lds + (s & 1) * SC_BUF; LAS unsigned char* nxt = lds + ((s + 1) & 1) * SC_BUF;
            if (wave != 0) {
                if (s + 1 < NCHUNK) scan_stage(nxt, QI + (t0 + cn) * 8192, KDT + (t0 + cn) * 8192, PM + (t0 + cn) * 4096, DEC + (t0 + cn) * 128, tid - 64);
            } else {
                if (s + 1 < NCHUNK) { const bf16* vt = VT + ((size_t)(b * 4 + h) * NCHUNK + cn) * 16384 + (16 * sl + fr) * 64 + 8 * g; vnext[0] = *(const bf16x8*)vt; vnext[1] = *(const bf16x8*)(vt + 32); }
                bf16x8 sa[4];
#pragma unroll
                for (int kap = 0; kap < 4; ++kap) { const f32x4 lo = S[2 * kap], hi = S[2 * kap + 1];
                    v4u pk; pk.x = pk2(lo[0], lo[1]); pk.y = pk2(lo[2], lo[3]); pk.z = pk2(hi[0], hi[1]); pk.w = pk2(hi[2], hi[3]); sa[kap] = __builtin_bit_cast(bf16x8, pk); }
#pragma unroll
                for (int t = 0; t < 4; ++t) {
                    f32x4 o = {0.f, 0.f, 0.f, 0.f};
#pragma unroll
                    for (int kap = 0; kap < 4; ++kap) { const bf16x8 qf = *(const LAS bf16x8*)(cur + SC_QI + (16 * t + fr) * 272 + (32 * kap + 8 * g) * 2);
                        o = __builtin_amdgcn_mfma_f32_16x16x32_bf16(sa[kap], qf, o, 0, 0, 0); }
#pragma unroll
                    for (int kp = 0; kp < 2; ++kp) { const bf16x8 pf = *(const LAS bf16x8*)(cur + SC_PM + (16 * t + fr) * 144 + (32 * kp + 8 * g) * 2);
                        o = __builtin_amdgcn_mfma_f32_16x16x32_bf16(vcur[kp], pf, o, 0, 0, 0); }
                    if (cs != 0) { const size_t row = (size_t)b * 8192 + 64 * (cs - 1) + 16 * t + fr;
                        *(v2u*)(O + row * 1024 + h * 256 + 16 * sl + 4 * g) = (v2u){pk2(o[0], o[1]), pk2(o[2], o[3])}; }
                }
#pragma unroll
                for (int j = 0; j < 8; ++j) { const f32x4 dc = *(const LAS f32x4*)(cur + SC_DEC + (16 * j + 4 * g) * 4); S[j] = S[j] * dc; }
#pragma unroll
                for (int j = 0; j < 8; ++j)
#pragma unroll
                    for (int kp = 0; kp < 2; ++kp) { const bf16x8 kf = *(const LAS bf16x8*)(cur + SC_KDT + (16 * j + fr) * 144 + (32 * kp + 8 * g) * 2);
                        S[j] = __builtin_amdgcn_mfma_f32_16x16x32_bf16(kf, vcur[kp], S[j], 0, 0, 0); }
                vcur[0] = vnext[0]; vcur[1] = vnext[1];
            }
            __syncthreads();
        }
    }
}
#ifndef ONE_LAUNCH
#define ONE_LAUNCH 1
#endif
constexpr int NPH = 13;
__global__ void __launch_bounds__(NTHREADS, 2) fwd_kernel(Args a) {
    extern __shared__ __attribute__((aligned(16))) unsigned char lds_raw[];
    LAS unsigned char* lds = (LAS unsigned char*)lds_raw;
    const int tid = threadIdx.x, lane = tid & 63, wave = __builtin_amdgcn_readfirstlane(tid >> 6), bid = blockIdx.x, G = gridDim.x;
    unsigned char* ws = a.ws;
    const int lo = a.ph_lo, hi = a.ph_hi;
#define IN(k) (lo <= (k) && (k) < hi)
#define SEAM(k) do { if (IN(k) && IN((k) + 1)) { cg::this_grid().sync(); } } while (0)
    pg8::EP ep;
    ep.Q = (bf16*)((unsigned char*)a.out + DO_Q); ep.K = (bf16*)(ws + WS_K); ep.V = (bf16*)((unsigned char*)a.out + DO_V); ep.R = (float*)(ws + WS_R);
    ep.GT2 = (bf16*)(ws + WS_GT2); ep.PQ = (bf16*)(ws + WS_PQ); ep.SGA = (bf16*)(ws + WS_SGA); ep.SGF = (bf16*)(ws + WS_SGF); ep.ON = (bf16*)(ws + WS_ON);
    ep.OG = (bf16*)(ws + WS_OG); ep.MG = (bf16*)(ws + WS_MG); ep.H1B = (bf16*)(ws + WS_H1B); ep.HF = (bf16*)(ws + WS_HF);
    ep.x = a.x; ep.H = a.out; ep.PART1 = (float*)(ws + WS_PART1); ep.gnorm = a.gla_norm;
    const bf16* ALL = (const bf16*)(ws + WS_ALL);

    if (IN(0)) { p0_prologue(a, lds, tid, lane, wave, bid, G); }
    SEAM(0);
    if (IN(1)) { pg8::Gemm g{ALL, ALL, 0, 0, 1024}; pg8::Sched S{1, 845, G, bid, 0, 0, 0}; pg8::Epi<1> E{ep};
        pg8::gemm_phase<pg8::Epi<1>, pg8::Sched, true, true>(lds, g, S, E); }
    SEAM(1);
    if (IN(2)) { p2_sym_rem(a, tid, lane, wave, bid, G); }
    SEAM(2);
    if (IN(3)) { pg8::Gemm g{(const bf16*)(ws + WS_CS), (const bf16*)(ws + WS_EOT), 0, 0, KH}; pg8::Sched S{2, 256, G, bid, 0, 0, 0}; pg8::Epi<2> E{ep};
        pg8::gemm_phase<pg8::Epi<2>, pg8::Sched, true, true>(lds, g, S, E); }
    SEAM(3);
    if (IN(4)) { p4_gla_prep(a, lds, tid, lane, wave, bid, G); p4_combine(a, tid, bid, G); }
    SEAM(4);
    if (IN(5)) { p5_scan(a, lds, tid, lane, wave, bid, G); }
    SEAM(5);
    if (IN(6)) { p6_post(a, lane, wave, bid, G);
        pg8::Gemm g{ALL, ALL, 0, 0, 1024}; pg8::Sched S{3, 512, G, bid, 8, 0, 82}; pg8::Epi<3> E{ep};
        pg8::gemm_phase<pg8::Epi<3>, pg8::Sched, true, true>(lds, g, S, E); }
    SEAM(6);
    if (IN(7)) {
        { pg8::Gemm g{ALL, ALL, 0, 0, 1024}; pg8::Sched S{3, 256, G, bid, 4, 0, 78}; pg8::Epi<4> E{ep};
          pg8::gemm_phase<pg8::Epi<4>, pg8::Sched, true, true>(lds, g, S, E); }
        { pg8::Gemm g{(const bf16*)(ws + WS_FN), (const bf16*)(ws + WS_WFT), 0, 0, 512}; pg8::Sched S{3, 256, G, bid, 4, 0, 0}; pg8::Epi<5> E{ep};
          pg8::gemm_phase<pg8::Epi<5>, pg8::Sched, true, true>(lds, g, S, E); }
    }
    SEAM(7);
    if (IN(8)) { pg8::Gemm g{(const bf16*)(ws + WS_OG), (const bf16*)(ws + WS_WOT), 0, 0, 1024}; pg8::Sched S{3, 256, G, bid, 4, 0, 0}; pg8::Epi<6> E{ep};
        pg8::gemm_phase<pg8::Epi<6>, pg8::Sched, true, true>(lds, g, S, E); }
    SEAM(8);
    if (IN(9)) { pg8::Gemm g{(const bf16*)(ws + WS_MG), (const bf16*)(ws + WS_WOUTT), 0, 0, 1024}; pg8::Sched S{3, 256, G, bid, 4, 0, 0}; pg8::Epi<7> E{ep};
        pg8::gemm_phase<pg8::Epi<7>, pg8::Sched, true, true>(lds, g, S, E); }
    SEAM(9);
    if (IN(10)) { pg8::Gemm g{(const bf16*)(ws + WS_H1B), (const bf16*)(ws + WS_W1T), 0, 0, 1024}; pg8::Sched S{3, 1024, G, bid, 16, 0, 0}; pg8::Epi<8> E{ep};
        pg8::gemm_phase<pg8::Epi<8>, pg8::Sched, true, true>(lds, g, S, E); }
    SEAM(10);
    if (IN(11)) { pg8::Gemm g{(const bf16*)(ws + WS_HF), (const bf16*)(ws + WS_W2T), 0, 0, 4096}; pg8::Sched S{3, 256, G, bid, 4, 0, 0}; pg8::Epi<9> E{ep};
        pg8::gemm_phase<pg8::Epi<9>, pg8::Sched, true, true>(lds, g, S, E); }
    SEAM(11);
    if (IN(12)) { p11_final(a, lane, wave, bid, G); }
#undef IN
#undef SEAM
}

extern "C" void kernel_launch(void* const* d_in, const int* in_sizes, int n_in, void* d_out, int out_size, void* d_ws, size_t ws_size, hipStream_t stream) {
    static int grid = 0;
    if (grid == 0) {
        int dev = 0, cus = 0, per_cu = 0;
        (void)hipGetDevice(&dev); (void)hipDeviceGetAttribute(&cus, hipDeviceAttributeMultiprocessorCount, dev);
        (void)hipFuncSetAttribute((const void*)fwd_kernel, hipFuncAttributeMaxDynamicSharedMemorySize, LDS_BYTES);
        (void)hipOccupancyMaxActiveBlocksPerMultiprocessor(&per_cu, (const void*)fwd_kernel, NTHREADS, LDS_BYTES);
        (void)hipGetLastError();
        if (per_cu < 1) { fprintf(stderr, "kernel_launch: occupancy query says %d blocks/CU\n", per_cu); per_cu = 1; }
        grid = cus * 1;
        if (grid > 256) grid = 256;
    }
    Args a{};
    const float* const* in = (const float* const*)d_in;
    a.x = in[0]; a.meta = in[1]; a.norm_mix = in[2]; a.w_in = in[3]; a.wdf = in[4]; a.bdf = in[5]; a.wdb = in[6]; a.bdb = in[7]; a.gla_norm = in[8];
    a.w_o = in[9]; a.w_fnet = in[10]; a.w_out = in[11]; a.norm_ffn = in[12]; a.w_ff1 = in[13]; a.w_ff2 = in[14]; a.norm_final = in[15];
    a.out = (float*)d_out; a.ws = (unsigned char*)d_ws;
#if ONE_LAUNCH
    a.ph_lo = 0; a.ph_hi = NPH;
    void* args[] = {&a};
    hipError_t e = hipLaunchCooperativeKernel((const void*)fwd_kernel, dim3(grid), dim3(NTHREADS), args, LDS_BYTES, stream);
    if (e != hipSuccess) fprintf(stderr, "cooperative launch failed: %s (grid %d)\n", hipGetErrorString(e), grid);
#else
    for (int p = 0; p < NPH; ++p) { a.ph_lo = p; a.ph_hi = p + 1; hipLaunchKernelGGL(fwd_kernel, dim3(grid), dim3(NTHREADS), LDS_BYTES, stream, a); }
#endif
}
```

```cpp
#include <hip/hip_runtime.h>
#include <hip/hip_cooperative_groups.h>
#include <cstdio>
#include <cstdint>
namespace cg = cooperative_groups;
namespace pg8 {
#define PG8_LAS __attribute__((address_space(3)))
typedef unsigned short bf16_t;
typedef short bf16x8 __attribute__((ext_vector_type(8)));
typedef float f32x4 __attribute__((ext_vector_type(4)));
typedef unsigned u32x4 __attribute__((ext_vector_type(4)));
constexpr int BM = 256, BK = 64, HALF = 128, HTB = HALF * BK * 2  , STAGE_BYTES = 8 * HTB, NXCD = 8, WGM = 8;

__host__ __device__ __forceinline__ int lds_byte(int r, int c) { const int st = (r >> 4) * 2 + (c >> 5), rr = r & 15, cc = c & 31, ob = rr * 64 + cc * 2; return st * 1024 + (ob ^ (((ob >> 9) & 1) << 5)); }
__host__ __device__ __forceinline__ void stage_rc(int b, int& R, int& C) { const int st = b / 1024, sb = b % 1024, swz = sb ^ (((sb >> 9) & 1) << 5); R = (st >> 1) * 16 + swz / 64; C = (st & 1) * 32 + (swz % 64) / 2; }
__host__ __device__ __forceinline__ int perm32(int rho) { const int n = rho >> 4, i = rho & 15; return 8 * (i >> 2) + 4 * n + (i & 3); }

struct Unit { int pm, pn; };
struct Gemm { const bf16_t* A; const bf16_t* Bt; int M, N, K; };

__device__ __forceinline__ unsigned cvt_pk_bf16(float lo, float hi) { unsigned r; asm volatile("v_cvt_pk_bf16_f32 %0, %1, %2" : "=v"(r) : "v"(lo), "v"(hi)); return r; }
__device__ __forceinline__ float bflo(unsigned w) { return __uint_as_float(w << 16); }
__device__ __forceinline__ float bfhi(unsigned w) { return __uint_as_float(w & 0xffff0000u); }

struct Sched {
    int mode, n, G, c, nN, offM, offN;
    __device__ __forceinline__ bool next(int i, Unit& u) const {
        const int L = i * G + c; if (L >= n) return false;
        if (mode == 1) {
            if (L < 585) { u.pm = L / 9; u.pn = 65 + L % 9; }
            else { const int l2 = L - 585; u.pm = 65 + 9 + (l2 & 3); u.pn = l2 >> 2; }
        } else if (mode == 2) {
            const int grp = L >> 6, r = L & 63; u.pm = grp * 16 + (r >> 2); u.pn = grp * 4 + (r & 3);
        } else {
            const int x = (L & 255) >> 5, ul = (L >> 8) * 32 + (L & 31);
            u.pm = 8 * x + (ul & 7) + offM; u.pn = (ul >> 3) + offN; }
        return true;
    }
    __device__ __forceinline__ void a_ready(const Unit&) const {}
    __device__ __forceinline__ void done(const Unit&) const {}
};

struct EP {
    bf16_t *Q, *K, *V; float* R; bf16_t* GT2; bf16_t* PQ; bf16_t *SGA, *SGF, *ON, *OG, *MG, *H1B, *HF;
    const float* x; float* H; float* PART1; const float* gnorm;
};
constexpr int LDG = 8320;
template <int MODE> struct Epi {
    static constexpr bool PERM = true, AFTER_DRAIN = false;
    EP p;
    __device__ __forceinline__ void operator()(const f32x4 (&acc)[2][2][4][2], const Unit& u, int wr, int wc, int fr, int fq) const {
#pragma unroll
        for (int ai = 0; ai < 2; ++ai)
#pragma unroll
            for (int m = 0; m < 4; ++m) {
                const int r = ai * HALF + wr * 64 + m * 16 + fr;
                float ss = 0.f;
                float rstd = 1.f;
                if (MODE == 8) { const float* pp = p.PART1 + (size_t)(u.pm * BM + r) * 16; float s = 0.f;
#pragma unroll
                    for (int t = 0; t < 4; ++t) { const f32x4 q4 = *(const f32x4*)(pp + 4 * t); s += (q4[0] + q4[1]) + (q4[2] + q4[3]); }
                    rstd = 1.0f / sqrtf(s * (1.0f / 1024.0f) + 1e-6f); }
#pragma unroll
                for (int bj = 0; bj < 2; ++bj) {
                    const int c = bj * HALF + wc * 32 + 8 * fq;
                    f32x4 v0 = acc[ai][bj][m][0], v1 = acc[ai][bj][m][1];
                    if (MODE == 1) {
                        if (u.pm < 65) {
                            const int t = u.pn - 65; const size_t row = (size_t)u.pm * BM + r;
                            if (t < 8) {
                                bf16_t* dst; float sc = 1.f;
                                if (t < 2) { dst = p.Q + row * 512 + t * 256 + c; sc = 0.08838834764831845f; }
                                else if (t < 4) dst = p.K + row * 512 + (t - 2) * 256 + c;
                                else dst = p.V + row * 1024 + (t - 4) * 256 + c;
                                u32x4 w; w.x = cvt_pk_bf16(v0[0] * sc, v0[1] * sc); w.y = cvt_pk_bf16(v0[2] * sc, v0[3] * sc); w.z = cvt_pk_bf16(v1[0] * sc, v1[1] * sc); w.w = cvt_pk_bf16(v1[2] * sc, v1[3] * sc);
                                *(u32x4*)dst = w;
                            } else if (c < 32) { float* dst = p.R + row * 32 + c; *(f32x4*)dst = v0; *(f32x4*)(dst + 4) = v1; }
                        } else {
                            const int gcol = (u.pm - 74) * BM + r, cs = gcol >> 9, col = gcol & 511;
                            u32x4 w; w.x = cvt_pk_bf16(v0[0], v0[1]); w.y = cvt_pk_bf16(v0[2], v0[3]); w.z = cvt_pk_bf16(v1[0], v1[1]); w.w = cvt_pk_bf16(v1[2], v1[3]);
                            if (u.pn < 64) { const int b = u.pn >> 5, l = 16 + (u.pn & 31) * 256 + c;
                                *(u32x4*)(p.GT2 + ((size_t)(b * 512 + col) * 2 + cs) * LDG + l) = w; }
                            else if (c == 48 || c == 56) { const int l = c - 48;
                                *(u32x4*)(p.GT2 + ((size_t)(col) * 2 + cs) * LDG + l) = w; *(u32x4*)(p.GT2 + ((size_t)(512 + col) * 2 + cs) * LDG + l) = w; }
                        }
                    } else if (MODE == 2) {
                        const int grp = u.pm >> 4; const size_t idx = (size_t)(u.pm & 15) * BM + r; const int n = (u.pn & 3) * BM + c;
                        u32x4 w; w.x = cvt_pk_bf16(v0[0], v0[1]); w.y = cvt_pk_bf16(v0[2], v0[3]); w.z = cvt_pk_bf16(v1[0], v1[1]); w.w = cvt_pk_bf16(v1[2], v1[3]);
                        *(u32x4*)(p.PQ + ((size_t)grp * 4096 + idx) * 1024 + n) = w;
                    } else if (MODE == 3) {
                        const int t = u.pn - 82; const size_t row = (size_t)u.pm * BM + r;
                        bf16_t* dst = (t < 4 ? p.SGA : p.SGF) + row * 1024 + (t & 3) * 256 + c;
                        float s[8];
#pragma unroll
                        for (int e = 0; e < 4; ++e) { s[e] = 1.f / (1.f + __expf(-v0[e])); s[4 + e] = 1.f / (1.f + __expf(-v1[e])); }
                        u32x4 w; w.x = cvt_pk_bf16(s[0], s[1]); w.y = cvt_pk_bf16(s[2], s[3]); w.z = cvt_pk_bf16(s[4], s[5]); w.w = cvt_pk_bf16(s[6], s[7]);
                        *(u32x4*)dst = w;
                    } else if (MODE == 4) {
                        const int t = u.pn - 78; const size_t off = ((size_t)u.pm * BM + r) * 1024 + t * 256 + c;
                        const u32x4 o = *(const u32x4*)(p.ON + off);
                        float s[8];
#pragma unroll
                        for (int e = 0; e < 4; ++e) { s[e] = v0[e] / (1.f + __expf(-v0[e])); s[4 + e] = v1[e] / (1.f + __expf(-v1[e])); }
                        u32x4 w; w.x = cvt_pk_bf16(s[0] * bflo(o.x), s[1] * bfhi(o.x)); w.y = cvt_pk_bf16(s[2] * bflo(o.y), s[3] * bfhi(o.y));
                        w.z = cvt_pk_bf16(s[4] * bflo(o.z), s[5] * bfhi(o.z)); w.w = cvt_pk_bf16(s[6] * bflo(o.w), s[7] * bfhi(o.w));
                        *(u32x4*)(p.OG + off) = w;
                    } else if (MODE == 5 || MODE == 6) {
                        const size_t off = ((size_t)u.pm * BM + r) * 1024 + u.pn * BM + c;
                        const u32x4 gt = *(const u32x4*)((MODE == 5 ? p.SGF : p.SGA) + off);
                        float s[8] = {v0[0] * bflo(gt.x), v0[1] * bfhi(gt.x), v0[2] * bflo(gt.y), v0[3] * bfhi(gt.y), v1[0] * bflo(gt.z), v1[1] * bfhi(gt.z), v1[2] * bflo(gt.w), v1[3] * bfhi(gt.w)};
                        if (MODE == 6) { const u32x4 mg = *(const u32x4*)(p.MG + off);
                            s[0] += bflo(mg.x); s[1] += bfhi(mg.x); s[2] += bflo(mg.y); s[3] += bfhi(mg.y); s[4] += bflo(mg.z); s[5] += bfhi(mg.z); s[6] += bflo(mg.w); s[7] += bfhi(mg.w); }
                        u32x4 w; w.x = cvt_pk_bf16(s[0], s[1]); w.y = cvt_pk_bf16(s[2], s[3]); w.z = cvt_pk_bf16(s[4], s[5]); w.w = cvt_pk_bf16(s[6], s[7]);
                        *(u32x4*)(p.MG + off) = w;
                    } else if (MODE == 7) {
                        const size_t off = ((size_t)u.pm * BM + r) * 1024 + u.pn * BM + c;
                        const f32x4 x0 = *(const f32x4*)(p.x + off), x1 = *(const f32x4*)(p.x + off + 4);
                        v0 = v0 + x0; v1 = v1 + x1;
                        *(f32x4*)(p.H + off) = v0; *(f32x4*)(p.H + off + 4) = v1;
                        u32x4 w; w.x = cvt_pk_bf16(v0[0], v0[1]); w.y = cvt_pk_bf16(v0[2], v0[3]); w.z = cvt_pk_bf16(v1[0], v1[1]); w.w = cvt_pk_bf16(v1[2], v1[3]);
                        *(u32x4*)(p.H1B + off) = w;
                        ss += (v0[0] * v0[0] + v0[1] * v0[1]) + (v0[2] * v0[2] + v0[3] * v0[3]) + (v1[0] * v1[0] + v1[1] * v1[1]) + (v1[2] * v1[2] + v1[3] * v1[3]);
                    } else if (MODE == 8) {
                        const size_t off = ((size_t)u.pm * BM + r) * 4096 + u.pn * BM + c;
                        float s[8];
#pragma unroll
                        for (int e = 0; e < 4; ++e) { float a = fmaxf(v0[e] * rstd, 0.f), b = fmaxf(v1[e] * rstd, 0.f); s[e] = a * a; s[4 + e] = b * b; }
                        u32x4 w; w.x = cvt_pk_bf16(s[0], s[1]); w.y = cvt_pk_bf16(s[2], s[3]); w.z = cvt_pk_bf16(s[4], s[5]); w.w = cvt_pk_bf16(s[6], s[7]);
                        *(u32x4*)(p.HF + off) = w;
                    } else if (MODE == 10) {
                        const size_t off = ((size_t)u.pm * BM + r) * 1024 + u.pn * BM + c;
                        const f32x4 x0 = *(const f32x4*)(p.H + off), x1 = *(const f32x4*)(p.H + off + 4);
                        if (v0[0] + x0[0] + x1[1] + v1[2] == 123456.789f) { *(f32x4*)(p.H + off) = v0 + x0; }
                    } else if (MODE == 9) {
                        const size_t off = ((size_t)u.pm * BM + r) * 1024 + u.pn * BM + c;
                        const f32x4 x0 = *(const f32x4*)(p.H + off), x1 = *(const f32x4*)(p.H + off + 4);
                        *(f32x4*)(p.H + off) = v0 + x0; *(f32x4*)(p.H + off + 4) = v1 + x1;
                    }
                }
                if (MODE == 7) { ss += __shfl_xor(ss, 16); ss += __shfl_xor(ss, 32);
                    if (fq == 0) p.PART1[(size_t)(u.pm * BM + r) * 16 + u.pn * 4 + wc] = ss; }
            }
    }
};
template <class Epi, class Sched, bool ALIGN_EPI = false, bool SP2 = false>
__device__ __forceinline__ void gemm_phase(PG8_LAS unsigned char* lds, const Gemm g, const Sched& S, const Epi& E) {
    const int tid = threadIdx.x, wid = __builtin_amdgcn_readfirstlane(tid >> 6), lane = tid & 63, wr = wid >> 2, wc = wid & 3, fr = lane & 15, fq = lane >> 4;
    const int K = g.K, nt = K / BK;
    unsigned voffA[2], voffB[2];
#pragma unroll
    for (int i = 0; i < 2; ++i) { int R, C; stage_rc(tid * 16 + i * 8192, R, C); const int Rb = Epi::PERM ? ((R & ~31) + perm32(R & 31)) : R;
        voffA[i] = (unsigned)(R * K + C) * 2u; voffB[i] = (unsigned)(Rb * K + C) * 2u; }
    const size_t kstep = (size_t)(BK * 2);
    const size_t hstep = (size_t)HALF * K * 2;
    const size_t tstep = 2 * hstep;
    const unsigned ldsw = (unsigned)wid * 1024u;
    const int aoff = lds_byte(wr * 64 + fr, fq * 8), boff = lds_byte(wc * 32 + fr, fq * 8);
#define PG8_SA(b, h) (((b) * 2 + (h)) * HTB)
#define PG8_SB(b, h) ((4 + (b) * 2 + (h)) * HTB)
#define PG8_STAGE(bufoff, gbase, voff) do { _Pragma("unroll") for (int _i = 0; _i < 2; ++_i) \
        __builtin_amdgcn_global_load_lds((const unsigned*)((const char*)(gbase) + (voff)[_i]), (PG8_LAS unsigned*)(lds + (bufoff) + ldsw + _i * 8192), 16, 0, 0); } while (0)
#define PG8_LDA(dst, b, h) do { _Pragma("unroll") for (int m = 0; m < 4; ++m) _Pragma("unroll") for (int k = 0; k < 2; ++k) dst[m][k] = *(const PG8_LAS bf16x8*)(lds + PG8_SA(b, h) + aoff + m * 2048 + k * 1024); } while (0)
#define PG8_LDB(dst, b, h) do { _Pragma("unroll") for (int n = 0; n < 2; ++n) _Pragma("unroll") for (int k = 0; k < 2; ++k) dst[n][k] = *(const PG8_LAS bf16x8*)(lds + PG8_SB(b, h) + boff + n * 2048 + k * 1024); } while (0)
#define PG8_MMA(ai, bj, At, Bt) do { __builtin_amdgcn_s_setprio(1); _Pragma("unroll") for (int m = 0; m < 4; ++m) _Pragma("unroll") for (int n = 0; n < 2; ++n) _Pragma("unroll") for (int k = 0; k < 2; ++k) \
        acc[ai][bj][m][n] = __builtin_amdgcn_mfma_f32_16x16x32_bf16(Bt[n][k], At[m][k], acc[ai][bj][m][n], 0, 0, 0); __builtin_amdgcn_s_setprio(0); } while (0)
#define PG8_WAIT_V(n) asm volatile("s_waitcnt vmcnt(" #n ")" ::: "memory")
#define PG8_WAIT_L(n) asm volatile("s_waitcnt lgkmcnt(" #n ")" ::: "memory")
#define PG8_BAR __builtin_amdgcn_s_barrier()
#define PG8_SCHED __builtin_amdgcn_sched_barrier(0)
    Unit cur, nxt; int ui = 0;
    if (!S.next(0, cur)) return;
    f32x4 acc[2][2][4][2];
#pragma unroll
    for (int a = 0; a < 2; ++a)
#pragma unroll
        for (int b = 0; b < 2; ++b)
#pragma unroll
            for (int m = 0; m < 4; ++m)
#pragma unroll
                for (int n = 0; n < 2; ++n) acc[a][b][m][n] = (f32x4){0.f, 0.f, 0.f, 0.f};
    bf16x8 At[4][2], B0[2][2], B1[2][2];
    const char* cA = (const char*)g.A + (size_t)cur.pm * tstep; const char* cB = (const char*)g.Bt + (size_t)cur.pn * tstep;
    S.a_ready(cur);
    if constexpr (SP2) {
        PG8_STAGE(PG8_SB(0, 0), cB, voffB); PG8_STAGE(PG8_SB(0, 1), cB + hstep, voffB); PG8_STAGE(PG8_SA(0, 0), cA, voffA); PG8_STAGE(PG8_SA(0, 1), cA + hstep, voffA);
        if (wr == 1) PG8_BAR;
        PG8_WAIT_V(2); PG8_BAR;
        PG8_STAGE(PG8_SB(1, 0), cB + kstep, voffB); PG8_STAGE(PG8_SA(1, 0), cA + kstep, voffA); PG8_STAGE(PG8_SB(1, 1), cB + hstep + kstep, voffB);
        PG8_WAIT_V(6); PG8_BAR;
    } else {
        PG8_STAGE(PG8_SB(0, 0), cB, voffB); PG8_STAGE(PG8_SA(0, 0), cA, voffA); PG8_STAGE(PG8_SB(0, 1), cB + hstep, voffB); PG8_STAGE(PG8_SA(0, 1), cA + hstep, voffA);
        if (wr == 1) PG8_BAR;
        PG8_WAIT_V(4); PG8_BAR;
        PG8_STAGE(PG8_SB(1, 0), cB + kstep, voffB); PG8_STAGE(PG8_SA(1, 0), cA + kstep, voffA); PG8_STAGE(PG8_SB(1, 1), cB + hstep + kstep, voffB);
        PG8_WAIT_V(6); PG8_BAR;
    }
    for (;;) {
        const bool has_next = S.next(ui + 1, nxt);
        const char* nA = has_next ? (const char*)g.A + (size_t)nxt.pm * tstep : cA; const char* nB = has_next ? (const char*)g.Bt + (size_t)nxt.pn * tstep : cB;
        for (int t = 0; t < nt; t += 2) {
            const bool last = (t == nt - 2);
            const char* a1 = cA + (size_t)(t + 1) * kstep;
            const char* a2 = last ? nA : cA + (size_t)(t + 2) * kstep; const char* b2 = last ? nB : cB + (size_t)(t + 2) * kstep;
            const char* a3 = a2 + kstep; const char* b3 = b2 + kstep;
            if (last && has_next) S.a_ready(nxt);
            if constexpr (SP2) {
            PG8_LDB(B0, 0, 0); PG8_LDB(B1, 0, 1); PG8_SCHED; PG8_LDA(At, 0, 0); PG8_STAGE(PG8_SA(1, 1), a1 + hstep, voffA);
            PG8_WAIT_V(8); PG8_WAIT_L(0); PG8_BAR; PG8_MMA(0, 0, At, B0); PG8_MMA(0, 1, At, B1); PG8_BAR; PG8_SCHED;
            PG8_LDA(At, 0, 1); PG8_STAGE(PG8_SB(0, 0), b2, voffB); PG8_STAGE(PG8_SB(0, 1), b2 + hstep, voffB); PG8_STAGE(PG8_SA(0, 0), a2, voffA);
            PG8_WAIT_V(8); PG8_WAIT_L(0); PG8_BAR; PG8_MMA(1, 0, At, B0); PG8_MMA(1, 1, At, B1); PG8_BAR; PG8_SCHED;
            PG8_LDB(B0, 1, 0); PG8_LDB(B1, 1, 1); PG8_SCHED; PG8_LDA(At, 1, 0); PG8_STAGE(PG8_SA(0, 1), a2 + hstep, voffA);
            PG8_WAIT_V(8); PG8_WAIT_L(0); PG8_BAR; PG8_MMA(0, 0, At, B0); PG8_MMA(0, 1, At, B1); PG8_BAR; PG8_SCHED;
            PG8_LDA(At, 1, 1); PG8_STAGE(PG8_SB(1, 0), b3, voffB); PG8_STAGE(PG8_SB(1, 1), b3 + hstep, voffB); PG8_STAGE(PG8_SA(1, 0), a3, voffA);
            PG8_WAIT_V(8); PG8_WAIT_L(0); PG8_BAR; PG8_MMA(1, 0, At, B0); PG8_MMA(1, 1, At, B1); PG8_BAR; PG8_SCHED;
            } else {
            PG8_LDB(B0, 0, 0); PG8_SCHED; PG8_LDA(At, 0, 0); PG8_STAGE(PG8_SA(1, 1), a1 + hstep, voffA);
            PG8_WAIT_L(8); PG8_BAR; PG8_WAIT_L(0); PG8_MMA(0, 0, At, B0); PG8_BAR; PG8_SCHED;
            PG8_LDB(B1, 0, 1); PG8_STAGE(PG8_SB(0, 0), b2, voffB);
            PG8_BAR; PG8_WAIT_L(0); PG8_MMA(0, 1, At, B1); PG8_BAR;
            PG8_LDA(At, 0, 1); PG8_STAGE(PG8_SA(0, 0), a2, voffA);
            PG8_BAR; PG8_WAIT_L(0); PG8_MMA(1, 0, At, B0); PG8_BAR; PG8_SCHED;
            PG8_STAGE(PG8_SB(0, 1), b2 + hstep, voffB);
            PG8_WAIT_V(6); PG8_BAR; PG8_MMA(1, 1, At, B1); PG8_BAR;
            PG8_LDB(B0, 1, 0); PG8_SCHED; PG8_LDA(At, 1, 0); PG8_STAGE(PG8_SA(0, 1), a2 + hstep, voffA);
            PG8_WAIT_L(8); PG8_BAR; PG8_WAIT_L(0); PG8_MMA(0, 0, At, B0); PG8_BAR; PG8_SCHED;
            PG8_LDB(B1, 1, 1); PG8_STAGE(PG8_SB(1, 0), b3, voffB);
            PG8_BAR; PG8_WAIT_L(0); PG8_MMA(0, 1, At, B1); PG8_BAR;
            PG8_LDA(At, 1, 1); PG8_STAGE(PG8_SA(1, 0), a3, voffA);
            PG8_BAR; PG8_WAIT_L(0); PG8_MMA(1, 0, At, B0); PG8_BAR; PG8_SCHED;
            PG8_STAGE(PG8_SB(1, 1), b3 + hstep, voffB);
            PG8_WAIT_V(6); PG8_BAR; PG8_MMA(1, 1, At, B1); PG8_BAR;
            }
        }
        if constexpr (ALIGN_EPI) { if (wr == 0) PG8_BAR; }
        if constexpr (!Epi::AFTER_DRAIN) { E(acc, cur, wr, wc, fr, fq); S.done(cur); }
        if (!has_next) break;
#pragma unroll
        for (int a = 0; a < 2; ++a)
#pragma unroll
            for (int b = 0; b < 2; ++b)
#pragma unroll
                for (int m = 0; m < 4; ++m)
#pragma unroll
                    for (int n = 0; n < 2; ++n) acc[a][b][m][n] = (f32x4){0.f, 0.f, 0.f, 0.f};
        cur = nxt; cA = nA; cB = nB; ++ui;
        if constexpr (ALIGN_EPI) { if (wr == 1) PG8_BAR; }
    }
    PG8_WAIT_V(0);
    if constexpr (!ALIGN_EPI) { if (wr == 0) PG8_BAR; }
    PG8_BAR;
    if constexpr (Epi::AFTER_DRAIN) { E.fused(acc, cur, wr, wc, fr, fq, lds, wid, lane); S.done(cur); }
#undef PG8_SA
#undef PG8_SB
#undef PG8_STAGE
#undef PG8_LDA
#undef PG8_LDB
#undef PG8_MMA
#undef PG8_WAIT_V
#undef PG8_WAIT_L
#undef PG8_BAR
#undef PG8_SCHED
}
}
#define LAS __attribute__((address_space(3)))
#define DI __device__ __forceinline__
typedef unsigned short bf16;
typedef unsigned v4u __attribute__((ext_vector_type(4)));
typedef unsigned v2u __attribute__((ext_vector_type(2)));
typedef float f32x4 __attribute__((ext_vector_type(4)));
typedef short bf16x8 __attribute__((ext_vector_type(8)));
constexpr int NTHREADS = 512, NWAVES = 8;
constexpr int D = 1024, NREAL = 16384, MROWS = 16640, LSEQ = 8208, FF = 4096, DIN = 5664, NCHUNK = 129;
constexpr int LDG = 8320, KH = 2176;
constexpr size_t MiB = 1u << 20;
constexpr size_t WS_PART1 = 0;
constexpr size_t WS_ALL = 1 * MiB;
constexpr size_t WS_WOT = 46 * MiB, WS_WFT = 48 * MiB, WS_WOUTT = 49 * MiB, WS_W1T = 51 * MiB, WS_W2T = 59 * MiB;
constexpr size_t WS_TAB = 67 * MiB;
constexpr size_t WS_CS = 68 * MiB + 512 * 1024;
constexpr size_t WS_GT2 = 136 * MiB + 512 * 1024;
constexpr size_t WS_EOT = 169 * MiB;
constexpr size_t WS_REMP = 186 * MiB;
constexpr size_t WS_PQ = 189 * MiB;
constexpr size_t WS_K = 221 * MiB;
constexpr size_t WS_R = 237 * MiB + 512 * 1024;
constexpr size_t WS_FN = 240 * MiB;
constexpr size_t DO_V = 0, DO_Q = 33 * MiB, DO_OB = 0;
constexpr size_t WS_REC = 69 * MiB;
constexpr size_t REC_BYTES = 43008, REC_KDT = 16384, REC_PM = 32768, REC_DEC = 40960;
constexpr size_t WS_QI_UNUSED = 69 * MiB;
constexpr size_t WS_KDT = 102 * MiB;
constexpr size_t WS_VT = 153 * MiB + 768 * 1024;
constexpr size_t WS_PM = 168 * MiB;
constexpr size_t WS_DEC = 184 * MiB + 512 * 1024;
constexpr size_t WS_OF = 189 * MiB;
constexpr size_t WS_ON = 69 * MiB, WS_SGA = 101 * MiB, WS_SGF = 133 * MiB, WS_OG = 165 * MiB, WS_MG = 197 * MiB;
constexpr size_t WS_H1B = 69 * MiB, WS_HF = 101 * MiB;
constexpr int LDS_BYTES = 155648;
struct Args {
    const float *x, *meta, *norm_mix, *w_in, *wdf, *bdf, *wdb, *bdb, *gla_norm, *w_o, *w_fnet, *w_out, *norm_ffn, *w_ff1, *w_ff2, *norm_final;
    float* out; unsigned char* ws; int ph_lo, ph_hi;
};
DI unsigned f2bf(float f) { unsigned u = __builtin_bit_cast(unsigned, f); return (u + 0x7fffu + ((u >> 16) & 1u)) >> 16; }
DI unsigned pk2(float lo, float hi) { return f2bf(lo) | (f2bf(hi) << 16); }
typedef float f32x2_t __attribute__((ext_vector_type(2)));
typedef __bf16 bf16x2_t __attribute__((ext_vector_type(2)));
DI unsigned cvtpk(float lo, float hi) { f32x2_t v = {lo, hi}; bf16x2_t b = __builtin_convertvector(v, bf16x2_t); return __builtin_bit_cast(unsigned, b); }
DI float bf2f(unsigned h) { return __uint_as_float(h << 16); }
DI float wave_sum(float v) {
#pragma unroll
    for (int o = 1; o < 64; o <<= 1) v += __shfl_xor(v, o);
    return v;
}
DI void transpose_item(const float* W, int pitch, int K, int ncols, bf16* WT, int row_off, LAS float* scr, int item, int lane, const float* kscale) {
    const int nblk = ncols / 32, kb = item / nblk, nb = item % nblk, k0 = 64 * kb, n0 = 32 * nb;
#pragma unroll 8
    for (int i = 0; i < 32; ++i) { const int kk = 2 * i + (lane >> 5); float v = W[(size_t)(k0 + kk) * pitch + n0 + (lane & 31)]; if (kscale) v *= kscale[k0 + kk]; scr[kk * 33 + (lane & 31)] = v; }
    asm volatile("s_waitcnt lgkmcnt(0)" ::: "memory");
    const int c = lane & 7;
#pragma unroll
    for (int j = 0; j < 4; ++j) { const int n = (lane >> 3) + 8 * j; const LAS float* s = scr + (8 * c) * 33 + n;
        v4u o; o.x = pk2(s[0 * 33], s[1 * 33]); o.y = pk2(s[2 * 33], s[3 * 33]); o.z = pk2(s[4 * 33], s[5 * 33]); o.w = pk2(s[6 * 33], s[7 * 33]);
        *(v4u*)(WT + (size_t)(row_off + n0 + n) * K + k0 + 8 * c) = o; }
    asm volatile("s_waitcnt lgkmcnt(0)" ::: "memory");
}
DI void rms_row_to_bf16(const float* xrow, const float* gain, bf16* orow, int lane) {
    const f32x4* xr = (const f32x4*)xrow + lane; const f32x4* gr = (const f32x4*)gain + lane;
    f32x4 v[4]; float s = 0.f;
#pragma unroll
    for (int j = 0; j < 4; ++j) { v[j] = xr[64 * j]; s += (v[j].x * v[j].x + v[j].y * v[j].y) + (v[j].z * v[j].z + v[j].w * v[j].w); }
    const float rstd = 1.f / sqrtf(wave_sum(s) * (1.f / 1024.f) + 1e-6f);
    unsigned long long* o8 = (unsigned long long*)orow + lane;
#pragma unroll
    for (int j = 0; j < 4; ++j) { const f32x4 g = gr[64 * j];
        o8[64 * j] = (unsigned long long)pk2(v[j].x * rstd * g.x, v[j].y * rstd * g.y) | ((unsigned long long)pk2(v[j].z * rstd * g.z, v[j].w * rstd * g.w) << 32); }
}

DI void p0_prologue(const Args& a, LAS unsigned char* lds, int tid, int lane, int wave, int bid, int G) {
    unsigned char* ws = a.ws;
    bf16* ALL = (bf16*)(ws + WS_ALL);
    const int gw = bid * NWAVES + wave, NGW = G * NWAVES;
    const int gt = bid * NTHREADS + tid, NGT = G * NTHREADS;
    LAS float* tabc = (LAS float*)lds; LAS float* tabs = tabc + LSEQ;
    for (int j = tid; j < LSEQ; j += NTHREADS) { const float ang = 6.283185307179586f * (float)j / (float)LSEQ; tabc[j] = cosf(ang); tabs[j] = sinf(ang); }
    __syncthreads();
    {
        bf16* CS = (bf16*)(ws + WS_CS);
        const int nchunk = 4 * 4096 * (KH / 8);
        for (int ch = gt; ch < nchunk; ch += NGT) {
            const int k8 = ch % (KH / 8); const int rest = ch / (KH / 8); const int idx = rest & 4095, grp = rest >> 12, cs = grp >> 1, kh = grp & 1;
            const int m = idx + 9, l0 = kh * KH + k8 * 8;
            unsigned j = ((unsigned)l0 * (unsigned)m) % (unsigned)LSEQ;
            float v[8];
#pragma unroll
            for (int e = 0; e < 8; ++e) { v[e] = (l0 + e <= 4104) ? (cs ? tabs[j] : tabc[j]) : 0.f; j += m; if (j >= (unsigned)LSEQ) j -= LSEQ; }
            v4u o; o.x = pk2(v[0], v[1]); o.y = pk2(v[2], v[3]); o.z = pk2(v[4], v[5]); o.w = pk2(v[6], v[7]);
            *(v4u*)(CS + (size_t)ch * 8) = o;
        }
        bf16* TAB = (bf16*)(ws + WS_TAB);
        const int nch2 = 32 * 2 * (LDG / 8);
        for (int ch = gt; ch < nch2; ch += NGT) {
            const int l8 = ch % (LDG / 8); const int rest = ch / (LDG / 8); const int cs = rest & 1, rho = rest >> 1;
            const int lp = 8200 + rho, l0 = l8 * 8;
            unsigned j = ((unsigned)l0 * (unsigned)lp) % (unsigned)LSEQ;
            float v[8];
#pragma unroll
            for (int e = 0; e < 8; ++e) { v[e] = (rho < 8 && l0 + e < LSEQ) ? (cs ? -tabs[j] : tabc[j]) : 0.f; j += lp; while (j >= (unsigned)LSEQ) j -= LSEQ; }
            v4u o; o.x = pk2(v[0], v[1]); o.y = pk2(v[2], v[3]); o.z = pk2(v[4], v[5]); o.w = pk2(v[6], v[7]);
            *(v4u*)(TAB + (size_t)ch * 8) = o;
        }
    }
    __syncthreads();
    {
        LAS float* Wl = (LAS float*)lds;
        LAS float* c128 = Wl + 64 * 128; LAS float* s128 = c128 + 128;
        if (tid < 128) { const float ang = 6.283185307179586f * (float)tid / 128.f; c128[tid] = cosf(ang); s128[tid] = sinf(ang); }
        for (int item = bid; item < 64; item += G) {
            const int kb = item >> 2, g = item & 3;
            __syncthreads();
            for (int idx = tid; idx < 64 * 128; idx += NTHREADS) { const int kk = idx >> 7, c = idx & 127; Wl[idx] = a.w_in[(size_t)(kb * 64 + kk) * DIN + 3104 + g * 128 + c]; }
            __syncthreads();
            const int n = tid & 127, kq = tid >> 7;
            unsigned pc[8], ps[8];
#pragma unroll 1
            for (int k2 = 0; k2 < 8; ++k2) {
                float ac0 = 0.f, as0 = 0.f, ac1 = 0.f, as1 = 0.f;
                const LAS float* w0 = Wl + (kq * 16 + 2 * k2) * 128; const LAS float* w1 = w0 + 128;
                for (int c = 0; c < 128; ++c) { const int j = (c * n) & 127; const float cc = c128[j], ss = s128[j]; ac0 += w0[c] * cc; as0 += w0[c] * ss; ac1 += w1[c] * cc; as1 += w1[c] * ss; }
                pc[k2] = pk2(ac0, ac1); ps[k2] = pk2(as0, as1);
            }
            bf16* dc = ALL + (size_t)(74 * 256 + g * 128 + n) * D + kb * 64 + kq * 16;
            bf16* ds = ALL + (size_t)(76 * 256 + g * 128 + n) * D + kb * 64 + kq * 16;
            *(v4u*)dc = (v4u){pc[0], pc[1], pc[2], pc[3]}; *(v4u*)(dc + 8) = (v4u){pc[4], pc[5], pc[6], pc[7]};
            *(v4u*)ds = (v4u){ps[0], ps[1], ps[2], ps[3]}; *(v4u*)(ds + 8) = (v4u){ps[4], ps[5], ps[6], ps[7]};
        }
        __syncthreads();
    }
    {
        LAS float* scr = (LAS float*)(lds + wave * 16384);
        bf16* WT = ALL + (size_t)65 * 256 * D;
        const int I_Q = 16 * 16, I_V = 16 * 32, I_R = 16 * 1, I_G = 16 * 32;
        const int I_O = 16 * 32, I_F = 8 * 32, I_1 = 16 * 128, I_2 = 64 * 32;
        const int NIT = 2 * I_Q + I_V + I_R + 3 * I_G + 2 * I_O + I_F + I_1 + I_2;
        for (int it = gw; it < NIT; it += NGW) {
            int r = it;
            if (r < I_Q) { transpose_item(a.w_in + 0, DIN, D, 512, WT, 0, scr, r, lane, nullptr); continue; } r -= I_Q;
            if (r < I_Q) { transpose_item(a.w_in + 512, DIN, D, 512, WT, 512, scr, r, lane, nullptr); continue; } r -= I_Q;
            if (r < I_V) { transpose_item(a.w_in + 1024, DIN, D, 1024, WT, 1024, scr, r, lane, nullptr); continue; } r -= I_V;
            if (r < I_R) { transpose_item(a.w_in + 3072, DIN, D, 32, WT, 2048, scr, r, lane, nullptr); continue; } r -= I_R;
            if (r < I_G) { transpose_item(a.w_in + 2048, DIN, D, 1024, WT, 13 * 256, scr, r, lane, nullptr); continue; } r -= I_G;
            if (r < I_G) { transpose_item(a.w_in + 3616, DIN, D, 1024, WT, 17 * 256, scr, r, lane, nullptr); continue; } r -= I_G;
            if (r < I_G) { transpose_item(a.w_in + 4640, DIN, D, 1024, WT, 21 * 256, scr, r, lane, nullptr); continue; } r -= I_G;
            if (r < I_O) { transpose_item(a.w_o, D, D, 1024, (bf16*)(ws + WS_WOT), 0, scr, r, lane, nullptr); continue; } r -= I_O;
            if (r < I_O) { transpose_item(a.w_out, D, D, 1024, (bf16*)(ws + WS_WOUTT), 0, scr, r, lane, nullptr); continue; } r -= I_O;
            if (r < I_F) { transpose_item(a.w_fnet, D, 512, 1024, (bf16*)(ws + WS_WFT), 0, scr, r, lane, nullptr); continue; } r -= I_F;
            if (r < I_1) { transpose_item(a.w_ff1, FF, D, FF, (bf16*)(ws + WS_W1T), 0, scr, r, lane, a.norm_ffn); continue; } r -= I_1;
            transpose_item(a.w_ff2, D, FF, 1024, (bf16*)(ws + WS_W2T), 0, scr, r, lane, nullptr);
        }
    }
    {
        bf16* t8 = ALL + (size_t)(73 * 256 + 32) * D;
        for (int i = gt; i < 224 * D / 8; i += NGT) *(v4u*)(t8 + (size_t)i * 8) = (v4u){0u, 0u, 0u, 0u};
        bf16* x64 = ALL + (size_t)16384 * D;
        for (int i = gt; i < 256 * D / 8; i += NGT) { const int row = i / (D / 8); if (row < 48 || row >= 64) *(v4u*)(x64 + (size_t)i * 8) = (v4u){0u, 0u, 0u, 0u}; }
        bf16* GT2 = (bf16*)(ws + WS_GT2);
        for (int i = gt; i < 2048 * 14; i += NGT) { const int row = i / 14, c = i % 14; *(v4u*)(GT2 + (size_t)row * LDG + LSEQ + c * 8) = (v4u){0u, 0u, 0u, 0u}; }
    }
    for (int m = gw; m < NREAL + 16; m += NGW) {
        if (m < NREAL) rms_row_to_bf16(a.x + (size_t)m * D, a.norm_mix, ALL + (size_t)m * D, lane);
        else rms_row_to_bf16(a.meta + (size_t)(m - NREAL) * D, a.norm_mix, ALL + (size_t)(NREAL + 48 + (m - NREAL)) * D, lane);
    }
}
DI void p2_sym_rem(const Args& a, int tid, int lane, int wave, int bid, int G) {
    unsigned char* ws = a.ws;
    const bf16* GT2 = (const bf16*)(ws + WS_GT2);
    bf16* EOT = (bf16*)(ws + WS_EOT);
    const int gt = bid * NTHREADS + tid, NGT = G * NTHREADS;
    const int nchunk = 4 * 1024 * (KH / 8);
    for (int ch = gt; ch < nchunk; ch += NGT) {
        const int k8 = ch % (KH / 8); const int rest = ch / (KH / 8); const int n = rest & 1023, grp = rest >> 10, cs = grp >> 1, kh = grp & 1;
        const int l0 = kh * KH + k8 * 8;
        const bf16* src = GT2 + ((size_t)n * 2 + cs) * LDG;
        float v[8];
        if (l0 > 4104) {
#pragma unroll
            for (int e = 0; e < 8; ++e) v[e] = 0.f;
        } else {
            const v4u f = *(const v4u*)(src + l0);
            const float fw[8] = {bf2f(f.x & 0xffffu), bf2f(f.x >> 16), bf2f(f.y & 0xffffu), bf2f(f.y >> 16), bf2f(f.z & 0xffffu), bf2f(f.z >> 16), bf2f(f.w & 0xffffu), bf2f(f.w >> 16)};
#pragma unroll
            for (int e = 0; e < 8; ++e) { const int l = l0 + e;
                if (l > 4104) v[e] = 0.f;
                else if (l == 0 || l == 4104) v[e] = cs ? 0.f : fw[e];
                else { const float mir = bf2f((unsigned)src[LSEQ - l]); v[e] = cs ? fw[e] - mir : fw[e] + mir; } }
        }
        v4u o; o.x = pk2(v[0], v[1]); o.y = pk2(v[2], v[3]); o.z = pk2(v[4], v[5]); o.w = pk2(v[6], v[7]);
        *(v4u*)(EOT + (size_t)ch * 8) = o;
    }
    typedef float f32x16 __attribute__((ext_vector_type(16)));
    const bf16* TAB = (const bf16*)(ws + WS_TAB);
    float* REMP = (float*)(ws + WS_REMP);
    const int gw = bid * NWAVES + wave, NGW = G * NWAVES;
    for (int task = gw; task < 32 * 65; task += NGW) {
        const int nt = task & 31, ks = task >> 5; const int r = lane & 31, h = lane >> 5;
        f32x16 acc; for (int i = 0; i < 16; ++i) acc[i] = 0.f;
        const bf16* ap = TAB + (size_t)r * (2 * LDG) + ks * 256 + 8 * h;
        const bf16* bp = GT2 + (size_t)(nt * 32 + r) * (2 * LDG) + ks * 256 + 8 * h;
#pragma unroll 4
        for (int kk = 0; kk < 16; ++kk) { const bf16x8 af = *(const bf16x8*)(ap + kk * 16), bfr = *(const bf16x8*)(bp + kk * 16);
            acc = __builtin_amdgcn_mfma_f32_32x32x16_bf16(af, bfr, acc, 0, 0, 0); }
#pragma unroll
        for (int i = 0; i < 4; ++i) REMP[((size_t)ks * 8 + i + 4 * h) * 1024 + nt * 32 + r] = acc[i];
    }
}

DI void p4_combine(const Args& a, int tid, int bid, int G) {
    unsigned char* ws = a.ws;
    const bf16* PQ = (const bf16*)(ws + WS_PQ); const float* REMP = (const float*)(ws + WS_REMP); bf16* FN = (bf16*)(ws + WS_FN);
    const float scale = 0.0009756003f;
    const int gt = bid * NTHREADS + tid, NGT = G * NTHREADS;
    for (int ch = gt; ch < NREAL * 64; ch += NGT) {
        const int c8 = ch & 63, row = ch >> 6, b = row >> 13, s = row & 8191, l = s + 16, n = b * 512 + c8 * 8;
        float v[8];
        if (l >= 8200) { const int rho = l - 8200;
#pragma unroll
            for (int e = 0; e < 8; ++e) v[e] = 0.f;
            for (int ks = 0; ks < 65; ++ks) { const f32x4 p0 = *(const f32x4*)(REMP + ((size_t)ks * 8 + rho) * 1024 + n), p1 = *(const f32x4*)(REMP + ((size_t)ks * 8 + rho) * 1024 + n + 4);
                v[0] += p0[0]; v[1] += p0[1]; v[2] += p0[2]; v[3] += p0[3]; v[4] += p1[0]; v[5] += p1[1]; v[6] += p1[2]; v[7] += p1[3]; }
        } else {
            const bool mir = l > 4104; const int idx = (mir ? LSEQ - l : l) - 9; const float sg = mir ? 1.f : -1.f;
            const size_t off = (size_t)idx * 1024 + n;
            const v4u p0 = *(const v4u*)(PQ + off), p1 = *(const v4u*)(PQ + (size_t)4096 * 1024 + off), q0 = *(const v4u*)(PQ + (size_t)2 * 4096 * 1024 + off), q1 = *(const v4u*)(PQ + (size_t)3 * 4096 * 1024 + off);
            const unsigned pp0[4] = {p0.x, p0.y, p0.z, p0.w}, pp1[4] = {p1.x, p1.y, p1.z, p1.w}, qq0[4] = {q0.x, q0.y, q0.z, q0.w}, qq1[4] = {q1.x, q1.y, q1.z, q1.w};
#pragma unroll
            for (int e = 0; e < 4; ++e) {
                v[2 * e] = (bf2f(pp0[e] & 0xffffu) + bf2f(pp1[e] & 0xffffu)) + sg * (bf2f(qq0[e] & 0xffffu) + bf2f(qq1[e] & 0xffffu));
                v[2 * e + 1] = (bf2f(pp0[e] >> 16) + bf2f(pp1[e] >> 16)) + sg * (bf2f(qq0[e] >> 16) + bf2f(qq1[e] >> 16)); }
        }
        v4u o; o.x = pk2(v[0] * scale, v[1] * scale); o.y = pk2(v[2] * scale, v[3] * scale); o.z = pk2(v[4] * scale, v[5] * scale); o.w = pk2(v[6] * scale, v[7] * scale);
        *(v4u*)(FN + (size_t)row * 512 + c8 * 8) = o;
    }
}

DI void p6_post(const Args& a, int lane, int wave, int bid, int G) {
    unsigned char* ws = a.ws;
    const bf16* OF = (const bf16*)(ws + WS_OF); const bf16* OB = (const bf16*)((unsigned char*)a.out + DO_OB); bf16* ON = (bf16*)(ws + WS_ON);
    const int gw = bid * NWAVES + wave, NGW = G * NWAVES;
    const int c0 = lane * 16;
    float gn[16];
#pragma unroll
    for (int e = 0; e < 16; ++e) gn[e] = a.gla_norm[(c0 & 255) + e];
    for (int row = gw; row < NREAL; row += NGW) {
        const size_t off = (size_t)row * 1024 + c0;
        const v4u f0 = *(const v4u*)(OF + off), f1 = *(const v4u*)(OF + off + 8), b0 = *(const v4u*)(OB + off), b1 = *(const v4u*)(OB + off + 8);
        const unsigned fw[8] = {f0.x, f0.y, f0.z, f0.w, f1.x, f1.y, f1.z, f1.w}, bw[8] = {b0.x, b0.y, b0.z, b0.w, b1.x, b1.y, b1.z, b1.w};
        float v[16]; float ss = 0.f;
#pragma unroll
        for (int e = 0; e < 8; ++e) { v[2 * e] = bf2f(fw[e] & 0xffffu) + bf2f(bw[e] & 0xffffu); v[2 * e + 1] = bf2f(fw[e] >> 16) + bf2f(bw[e] >> 16); ss += v[2 * e] * v[2 * e] + v[2 * e + 1] * v[2 * e + 1]; }
        ss += __shfl_xor(ss, 1); ss += __shfl_xor(ss, 2); ss += __shfl_xor(ss, 4); ss += __shfl_xor(ss, 8);
        const float rstd = 1.f / sqrtf(ss * (1.f / 256.f) + 1e-6f);
        unsigned w[8];
#pragma unroll
        for (int e = 0; e < 8; ++e) w[e] = pk2(v[2 * e] * rstd * gn[2 * e], v[2 * e + 1] * rstd * gn[2 * e + 1]);
        *(v4u*)(ON + off) = (v4u){w[0], w[1], w[2], w[3]}; *(v4u*)(ON + off + 8) = (v4u){w[4], w[5], w[6], w[7]};
    }
}

DI void p11_final(const Args& a, int lane, int wave, int bid, int G) {
    const int gw = bid * NWAVES + wave, NGW = G * NWAVES;
    for (int row = gw; row < NREAL; row += NGW) {
        f32x4* xr = (f32x4*)(a.out + (size_t)row * D) + lane; const f32x4* gr = (const f32x4*)a.norm_final + lane;
        f32x4 v[4]; float s = 0.f;
#pragma unroll
        for (int j = 0; j < 4; ++j) { v[j] = xr[64 * j]; s += (v[j].x * v[j].x + v[j].y * v[j].y) + (v[j].z * v[j].z + v[j].w * v[j].w); }
        const float rstd = 1.f / sqrtf(wave_sum(s) * (1.f / 1024.f) + 1e-6f);
#pragma unroll
        for (int j = 0; j < 4; ++j) { const f32x4 g = gr[64 * j]; xr[64 * j] = (f32x4){v[j].x * rstd * g.x, v[j].y * rstd * g.y, v[j].z * rstd * g.z, v[j].w * rstd * g.w}; }
    }
}
DI float logsig(float x) { return fminf(x, 0.f) - __logf(1.f + __expf(-fabsf(x))); }
DI size_t tile_idx(int dir, int b, int h, int c) { return (size_t)((dir * 2 + b) * 4 + h) * NCHUNK + c; }
DI void p4_gla_prep(const Args& a, LAS unsigned char* lds, int tid, int lane, int wave, int bid, int G) {
    unsigned char* ws = a.ws;
    const bf16* Qg = (const bf16*)((unsigned char*)a.out + DO_Q); const bf16* Kg = (const bf16*)(ws + WS_K); const bf16* Vg = (const bf16*)((unsigned char*)a.out + DO_V);
    const float* Rg = (const float*)(ws + WS_R);
    unsigned char* REC = ws + WS_REC; bf16* VT = (bf16*)(ws + WS_VT);
    LAS float* BF = (LAS float*)lds; LAS float* BB = BF + 64 * 128;
    LAS unsigned char* QF = lds + 65536; LAS unsigned char* KF = QF + 17408; LAS unsigned char* QB = KF + 17408; LAS unsigned char* KB = QB + 17408;
    LAS unsigned char* KRAW = lds + 135168;
    LAS float* RS = (LAS float*)QF; LAS float* WD = RS + 64 * 32;
    LAS unsigned char* VS = lds;
    for (int task = bid; task < 2 * NCHUNK * 4; task += G) {
        const int h = task & 3, c = (task >> 2) % NCHUNK, b = (task >> 2) / NCHUNK;
        const int row0 = (c == 0) ? NREAL : b * 8192 + 64 * (c - 1);
        for (int idx = tid; idx < 64 * 32; idx += NTHREADS) RS[idx] = Rg[(size_t)(row0 + (idx >> 5)) * 32 + (idx & 31)];
        for (int idx = tid; idx < 2 * 16 * 128; idx += NTHREADS) { const int dir = idx >> 11, j = (idx >> 7) & 15, d = idx & 127; WD[idx] = (dir ? a.wdb : a.wdf)[j * 512 + h * 128 + d]; }
        __syncthreads();
        {
            const int d = tid & 127, part = tid >> 7; const float bfw = a.bdf[h * 128 + d], bbw = a.bdb[h * 128 + d];
            for (int ii = 0; ii < 16; ++ii) { const int i = part * 16 + ii; float lf = bfw, lb = bbw;
#pragma unroll
                for (int j = 0; j < 16; ++j) { lf += RS[i * 32 + j] * WD[j * 128 + d]; lb += RS[i * 32 + 16 + j] * WD[2048 + j * 128 + d]; }
                float laf = logsig(lf) * 0.0625f, lab = logsig(lb) * 0.0625f;
                if (c == 0 && i < 48) { laf = 0.f; lab = 0.f; }
                BF[i * 128 + d] = laf; BB[i * 128 + d] = lab; }
        }
        __syncthreads();
        if (tid < 128) { float s = 0.f; for (int i = 0; i < 64; ++i) { s += BF[i * 128 + tid]; BF[i * 128 + tid] = s; } ((float*)(REC + tile_idx(0, b, h, c) * REC_BYTES + REC_DEC))[tid] = __expf(s); }
        else if (tid < 256) { const int d = tid - 128; float s = 0.f; for (int i = 63; i >= 0; --i) { s += BB[i * 128 + d]; BB[i * 128 + d] = s; } ((float*)(REC + tile_idx(1, b, h, c) * REC_BYTES + REC_DEC))[d] = __expf(s); }
        __syncthreads();
        for (int rep = 0; rep < 2; ++rep) {
            const int g = tid + NTHREADS * rep, i = g >> 4, d0 = (g & 15) * 8;
            const v4u q8 = *(const v4u*)(Qg + (size_t)(row0 + i) * 512 + h * 128 + d0), k8 = *(const v4u*)(Kg + (size_t)(row0 + i) * 512 + h * 128 + d0);
            const unsigned qw[4] = {q8.x, q8.y, q8.z, q8.w}, kw[4] = {k8.x, k8.y, k8.z, k8.w};
            float qf[8], kf[8], qb[8], kb[8], qif[8], qib[8];
#pragma unroll
            for (int e = 0; e < 8; ++e) {
                const int d = d0 + e; const float q = bf2f((e & 1) ? (qw[e >> 1] >> 16) : (qw[e >> 1] & 0xffffu)), k = bf2f((e & 1) ? (kw[e >> 1] >> 16) : (kw[e >> 1] & 0xffffu));
                const float ef = BF[i * 128 + d], eb = BB[i * 128 + d], f31 = BF[31 * 128 + d], b32 = BB[32 * 128 + d];
                qf[e] = q * __expf(ef - f31); kf[e] = k * __expf(f31 - ef); qb[e] = q * __expf(eb - b32); kb[e] = k * __expf(b32 - eb);
                qif[e] = q * __expf(ef); qib[e] = q * __expf(eb);
            }
            *(LAS v4u*)(QF + i * 272 + d0 * 2) = (v4u){pk2(qf[0], qf[1]), pk2(qf[2], qf[3]), pk2(qf[4], qf[5]), pk2(qf[6], qf[7])};
            *(LAS v4u*)(KF + i * 272 + d0 * 2) = (v4u){pk2(kf[0], kf[1]), pk2(kf[2], kf[3]), pk2(kf[4], kf[5]), pk2(kf[6], kf[7])};
            *(LAS v4u*)(QB + i * 272 + d0 * 2) = (v4u){pk2(qb[0], qb[1]), pk2(qb[2], qb[3]), pk2(qb[4], qb[5]), pk2(qb[6], qb[7])};
            *(LAS v4u*)(KB + i * 272 + d0 * 2) = (v4u){pk2(kb[0], kb[1]), pk2(kb[2], kb[3]), pk2(kb[4], kb[5]), pk2(kb[6], kb[7])};
            *(LAS v4u*)(KRAW + i * 256 + d0 * 2) = k8;
            const int kap = d0 >> 5, u = (d0 & 31) >> 3, pc = 32 * kap + 16 * (u & 1) + 4 * (u >> 1);
            bf16* qi_f = (bf16*)(REC + tile_idx(0, b, h, c) * REC_BYTES) + i * 128 + pc; bf16* qi_b = (bf16*)(REC + tile_idx(1, b, h, c) * REC_BYTES) + i * 128 + pc;
            *(v2u*)qi_f = (v2u){pk2(qif[0], qif[1]), pk2(qif[2], qif[3])}; *(v2u*)(qi_f + 8) = (v2u){pk2(qif[4], qif[5]), pk2(qif[6], qif[7])};
            *(v2u*)qi_b = (v2u){pk2(qib[0], qib[1]), pk2(qib[2], qib[3])}; *(v2u*)(qi_b + 8) = (v2u){pk2(qib[4], qib[5]), pk2(qib[6], qib[7])};
        }
        __syncthreads();
        {
            const int dir = wave >> 2, tq = wave & 3, fr = lane & 15, g = lane >> 4;
            const LAS unsigned char* QX = dir ? QB : QF; const LAS unsigned char* KX = dir ? KB : KF;
            bf16x8 bq[4];
#pragma unroll
            for (int kap = 0; kap < 4; ++kap) bq[kap] = *(const LAS bf16x8*)(QX + (16 * tq + fr) * 272 + (32 * kap + 8 * g) * 2);
            bf16* pm = (bf16*)(REC + tile_idx(dir, b, h, c) * REC_BYTES + REC_PM);
            const int i = 16 * tq + fr;
#pragma unroll
            for (int tk = 0; tk < 4; ++tk) {
                f32x4 acc = {0.f, 0.f, 0.f, 0.f};
#pragma unroll
                for (int kap = 0; kap < 4; ++kap) { const bf16x8 af = *(const LAS bf16x8*)(KX + (16 * tk + fr) * 272 + (32 * kap + 8 * g) * 2);
                    acc = __builtin_amdgcn_mfma_f32_16x16x32_bf16(af, bq[kap], acc, 0, 0, 0); }
                float s[4];
#pragma unroll
                for (int e = 0; e < 4; ++e) { const int j = 16 * tk + 4 * g + e; const bool keep = dir ? (j >= i) : (j <= i); s[e] = keep ? acc[e] : 0.f; }
                *(v2u*)(pm + i * 64 + 16 * tk + 4 * g) = (v2u){pk2(s[0], s[1]), pk2(s[2], s[3])};
            }
        }
        {
            const int d = tid & 127, blk = tid >> 7, i0 = blk * 16;
            const float f63 = BF[63 * 128 + d], b0 = BB[d];
            unsigned wf[8], wb[8];
#pragma unroll
            for (int e2 = 0; e2 < 8; ++e2) {
                const int ia = i0 + 2 * e2, ib = ia + 1;
                const float ka = bf2f((unsigned)*(const LAS unsigned short*)(KRAW + ia * 256 + d * 2)), kb2 = bf2f((unsigned)*(const LAS unsigned short*)(KRAW + ib * 256 + d * 2));
                wf[e2] = pk2(ka * __expf(f63 - BF[ia * 128 + d]), kb2 * __expf(f63 - BF[ib * 128 + d]));
                wb[e2] = pk2(ka * __expf(b0 - BB[ia * 128 + d]), kb2 * __expf(b0 - BB[ib * 128 + d]));
            }
            bf16* kf_ = (bf16*)(REC + tile_idx(0, b, h, c) * REC_BYTES + REC_KDT) + d * 64 + i0; bf16* kb_ = (bf16*)(REC + tile_idx(1, b, h, c) * REC_BYTES + REC_KDT) + d * 64 + i0;
            *(v4u*)kf_ = (v4u){wf[0], wf[1], wf[2], wf[3]}; *(v4u*)(kf_ + 8) = (v4u){wf[4], wf[5], wf[6], wf[7]};
            *(v4u*)kb_ = (v4u){wb[0], wb[1], wb[2], wb[3]}; *(v4u*)(kb_ + 8) = (v4u){wb[4], wb[5], wb[6], wb[7]};
        }
        __syncthreads();
        for (int rep = 0; rep < 4; ++rep) { const int idx = tid + NTHREADS * rep, i = idx >> 5, u = idx & 31;
            *(LAS v4u*)(VS + i * 528 + u * 16) = *(const v4u*)(Vg + (size_t)(row0 + i) * 1024 + h * 256 + u * 8); }
        __syncthreads();
        {
            const int dv = tid & 255, half = tid >> 8; unsigned w[16];
#pragma unroll
            for (int e2 = 0; e2 < 16; ++e2) { const int ia = 32 * half + 2 * e2;
                w[e2] = (unsigned)*(const LAS unsigned short*)(VS + ia * 528 + dv * 2) | ((unsigned)*(const LAS unsigned short*)(VS + (ia + 1) * 528 + dv * 2) << 16); }
            bf16* vt = VT + ((size_t)(b * 4 + h) * NCHUNK + c) * 16384 + dv * 64 + 32 * half;
#pragma unroll
            for (int q4 = 0; q4 < 4; ++q4) *(v4u*)(vt + 8 * q4) = (v4u){w[4 * q4], w[4 * q4 + 1], w[4 * q4 + 2], w[4 * q4 + 3]};
        }
        __syncthreads();
    }
}

constexpr int SC_QI = 0, SC_KDT = 17408, SC_PM = 35840, SC_DEC = 45056, SC_VT = 45568, SC_BUF = 47872, SC_SA = 3 * SC_BUF, SC_NCH = 2720, SC_IT = 22;
DI void scan_load(v4u (&r)[SC_IT], const unsigned char* rec, const unsigned char* vt, int pl) {
#pragma unroll
    for (int it = 0; it < SC_IT - 1; ++it) r[it] = *(const v4u*)(rec + pl * 16 + it * 2048);
    r[SC_IT - 1] = *(const v4u*)(vt + pl * 16);
}
DI void scan_store(LAS unsigned char* buf, const v4u (&r)[SC_IT], int pl) {
#pragma unroll
    for (int it = 0; it < SC_IT - 1; ++it) { const int cid = pl + 128 * it;
        int dst;
        if (cid < 1024) dst = SC_QI + (cid >> 4) * 272 + (cid & 15) * 16;
        else if (cid < 2048) { const int x = cid - 1024; dst = SC_KDT + (x >> 3) * 144 + (x & 7) * 16; }
        else if (cid < 2560) { const int x = cid - 2048; dst = SC_PM + (x >> 3) * 144 + (x & 7) * 16; }
        else dst = SC_DEC + (cid - 2560) * 16;
        if (cid < 2592) *(LAS v4u*)(buf + dst) = r[it]; }
    *(LAS v4u*)(buf + SC_VT + (pl >> 3) * 144 + (pl & 7) * 16) = r[SC_IT - 1];
}
DI void p5_scan(const Args& a, LAS unsigned char* lds, int tid, int lane, int wave, int bid, int G) {
    unsigned char* ws = a.ws;
    const unsigned char* REC = ws + WS_REC; const unsigned char* VT = ws + WS_VT;
    for (int item = bid; item < 256; item += G) {
        const int sl = item & 15, dir = (item >> 4) & 1, h = (item >> 5) & 3, b = item >> 7;
        bf16* O = dir ? (bf16*)((unsigned char*)a.out + DO_OB) : (bf16*)(ws + WS_OF);
        const size_t t0 = tile_idx(dir, b, h, 0); const size_t v0i = (size_t)(b * 4 + h) * NCHUNK;
        const int fr = lane & 15, g = lane >> 4;
#define SCAN_SRC(step) REC + (t0 + (dir ? 128 - (step) : (step))) * REC_BYTES, VT + (v0i + (dir ? 128 - (step) : (step))) * 32768 + sl * 2048
        const bool loader = (wave >= 1 && wave <= 6);
        const int pr = (wave - 1) >> 1, pl = ((wave - 1) & 1) * 64 + lane;
        v4u r[SC_IT];
        __syncthreads();
        if (loader) { scan_load(r, SCAN_SRC(pr), pl); scan_store(lds + pr * SC_BUF, r, pl); scan_load(r, SCAN_SRC(pr + 3), pl); }
        if (wave == 0) *(LAS v4u*)(lds + SC_SA + 4096 + lane * 16) = (v4u){0u, 0u, 0u, 0u}, *(LAS v4u*)(lds + SC_SA + 4096 + 1024 + lane * 16) = (v4u){0u, 0u, 0u, 0u},
                       *(LAS v4u*)(lds + SC_SA + 4096 + 2048 + lane * 16) = (v4u){0u, 0u, 0u, 0u}, *(LAS v4u*)(lds + SC_SA + 4096 + 3072 + lane * 16) = (v4u){0u, 0u, 0u, 0u};
        __syncthreads();
        if (wave == 0) {
#pragma unroll 1
            for (int s = 0; s < NCHUNK; ++s) {
                LAS unsigned char* cur = lds + (s % 3) * SC_BUF;
                const int cs = dir ? 128 - s : s;
                const LAS unsigned char* sap = lds + SC_SA + ((s + 1) & 1) * 4096 + lane * 16;
                bf16x8 sa[4], vf[2];
#pragma unroll
                for (int kap = 0; kap < 4; ++kap) sa[kap] = *(const LAS bf16x8*)(sap + kap * 1024);
#pragma unroll
                for (int kp = 0; kp < 2; ++kp) vf[kp] = *(const LAS bf16x8*)(cur + SC_VT + fr * 144 + (32 * kp + 8 * g) * 2);
#pragma unroll
                for (int t = 0; t < 4; ++t) {
                    f32x4 o = {0.f, 0.f, 0.f, 0.f};
#pragma unroll
                    for (int kap = 0; kap < 4; ++kap) { const bf16x8 qf = *(const LAS bf16x8*)(cur + SC_QI + (16 * t + fr) * 272 + (32 * kap + 8 * g) * 2);
                        o = __builtin_amdgcn_mfma_f32_16x16x32_bf16(sa[kap], qf, o, 0, 0, 0); }
#pragma unroll
                    for (int kp = 0; kp < 2; ++kp) { const bf16x8 pf = *(const LAS bf16x8*)(cur + SC_PM + (16 * t + fr) * 144 + (32 * kp + 8 * g) * 2);
                        o = __builtin_amdgcn_mfma_f32_16x16x32_bf16(vf[kp], pf, o, 0, 0, 0); }
                    if (cs != 0) { const size_t row = (size_t)b * 8192 + 64 * (cs - 1) + 16 * t + fr;
                        *(v2u*)(O + row * 1024 + h * 256 + 16 * sl + 4 * g) = (v2u){cvtpk(o[0], o[1]), cvtpk(o[2], o[3])}; }
                }
                __syncthreads();
            }
        } else if (wave == 7) {
            f32x4 S[8];
#pragma unroll
            for (int j = 0; j < 8; ++j) S[j] = (f32x4){0.f, 0.f, 0.f, 0.f};
#pragma unroll 1
            for (int s = 0; s < NCHUNK; ++s) {
                LAS unsigned char* cur = lds + (s % 3) * SC_BUF;
                bf16x8 vf[2];
#pragma unroll
                for (int kp = 0; kp < 2; ++kp) vf[kp] = *(const LAS bf16x8*)(cur + SC_VT + fr * 144 + (32 * kp + 8 * g) * 2);
#pragma unroll
                for (int j = 0; j < 8; ++j) { const f32x4 dc = *(const LAS f32x4*)(cur + SC_DEC + (16 * j + 4 * g) * 4); S[j] = S[j] * dc; }
#pragma unroll
                for (int j = 0; j < 8; ++j)
#pragma unroll
                    for (int kp = 0; kp < 2; ++kp) { const bf16x8 kf = *(const LAS bf16x8*)(cur + SC_KDT + (16 * j + fr) * 144 + (32 * kp + 8 * g) * 2);
                        S[j] = __builtin_amdgcn_mfma_f32_16x16x32_bf16(kf, vf[kp], S[j], 0, 0, 0); }
                LAS unsigned char* sap = lds + SC_SA + (s & 1) * 4096 + lane * 16;
#pragma unroll
                for (int kap = 0; kap < 4; ++kap) { const f32x4 lo = S[2 * kap], hi = S[2 * kap + 1];
                    *(LAS v4u*)(sap + kap * 1024) = (v4u){cvtpk(lo[0], lo[1]), cvtpk(lo[2], lo[3]), cvtpk(hi[0], hi[1]), cvtpk(hi[2], hi[3])}; }
                __syncthreads();
            }
        } else {
#pragma unroll 1
            for (int s = 0; s < NCHUNK; ++s) {
                if (s >= 1 && s + 2 < NCHUNK && (s + 2) % 3 == pr) { scan_store(lds + ((s + 2) % 3) * SC_BUF, r, pl); if (s + 5 < NCHUNK) scan_load(r, SCAN_SRC(s + 5), pl); }
                __syncthreads();
            }
        }
#undef SCAN_SRC
    }
}
#ifndef ONE_LAUNCH
#define ONE_LAUNCH 1
#endif
constexpr int NPH = 13;
__global__ void __launch_bounds__(NTHREADS, 2) fwd_kernel(Args a) {
    extern __shared__ __attribute__((aligned(16))) unsigned char lds_raw[];
    LAS unsigned char* lds = (LAS unsigned char*)lds_raw;
    const int tid = threadIdx.x, lane = tid & 63, wave = __builtin_amdgcn_readfirstlane(tid >> 6), bid = blockIdx.x, G = gridDim.x;
    unsigned char* ws = a.ws;
    const int lo = a.ph_lo, hi = a.ph_hi;
    const int vb = (G == 256) ? (bid & 7) * 32 + (bid >> 3) : bid;
#define IN(k) (lo <= (k) && (k) < hi)
#define SEAM(k) do { if (IN(k) && IN((k) + 1)) { cg::this_grid().sync(); } } while (0)
    pg8::EP ep;
    ep.Q = (bf16*)((unsigned char*)a.out + DO_Q); ep.K = (bf16*)(ws + WS_K); ep.V = (bf16*)((unsigned char*)a.out + DO_V); ep.R = (float*)(ws + WS_R);
    ep.GT2 = (bf16*)(ws + WS_GT2); ep.PQ = (bf16*)(ws + WS_PQ); ep.SGA = (bf16*)(ws + WS_SGA); ep.SGF = (bf16*)(ws + WS_SGF); ep.ON = (bf16*)(ws + WS_ON);
    ep.OG = (bf16*)(ws + WS_OG); ep.MG = (bf16*)(ws + WS_MG); ep.H1B = (bf16*)(ws + WS_H1B); ep.HF = (bf16*)(ws + WS_HF);
    ep.x = a.x; ep.H = a.out; ep.PART1 = (float*)(ws + WS_PART1); ep.gnorm = a.gla_norm;
    const bf16* ALL = (const bf16*)(ws + WS_ALL);

    if (IN(0)) { p0_prologue(a, lds, tid, lane, wave, bid, G); }
    SEAM(0);
    if (IN(1)) { pg8::Gemm g{ALL, ALL, 0, 0, 1024}; pg8::Sched S{1, 845, G, vb, 0, 0, 0}; pg8::Epi<1> E{ep};
        pg8::gemm_phase<pg8::Epi<1>, pg8::Sched, true, true>(lds, g, S, E); }
    SEAM(1);
    if (IN(2)) { p2_sym_rem(a, tid, lane, wave, bid, G); }
    SEAM(2);
    if (IN(3)) { pg8::Gemm g{(const bf16*)(ws + WS_CS), (const bf16*)(ws + WS_EOT), 0, 0, KH}; pg8::Sched S{2, 256, G, vb, 0, 0, 0}; pg8::Epi<2> E{ep};
        pg8::gemm_phase<pg8::Epi<2>, pg8::Sched, true, true>(lds, g, S, E); }
    SEAM(3);
    if (IN(4)) { p4_gla_prep(a, lds, tid, lane, wave, bid, G); p4_combine(a, tid, bid, G); }
    SEAM(4);
    if (IN(5)) { p5_scan(a, lds, tid, lane, wave, vb, G); }
    SEAM(5);
    if (IN(6)) { p6_post(a, lane, wave, bid, G);
        pg8::Gemm g{ALL, ALL, 0, 0, 1024}; pg8::Sched S{3, 512, G, vb, 8, 0, 82}; pg8::Epi<3> E{ep};
        pg8::gemm_phase<pg8::Epi<3>, pg8::Sched, true, true>(lds, g, S, E); }
    SEAM(6);
    if (IN(7)) {
        { pg8::Gemm g{ALL, ALL, 0, 0, 1024}; pg8::Sched S{3, 256, G, vb, 4, 0, 78}; pg8::Epi<4> E{ep};
          pg8::gemm_phase<pg8::Epi<4>, pg8::Sched, true, true>(lds, g, S, E); }
        { pg8::Gemm g{(const bf16*)(ws + WS_FN), (const bf16*)(ws + WS_WFT), 0, 0, 512}; pg8::Sched S{3, 256, G, vb, 4, 0, 0}; pg8::Epi<5> E{ep};
          pg8::gemm_phase<pg8::Epi<5>, pg8::Sched, true, true>(lds, g, S, E); }
    }
    SEAM(7);
    if (IN(8)) { pg8::Gemm g{(const bf16*)(ws + WS_OG), (const bf16*)(ws + WS_WOT), 0, 0, 1024}; pg8::Sched S{3, 256, G, vb, 4, 0, 0}; pg8::Epi<6> E{ep};
        pg8::gemm_phase<pg8::Epi<6>, pg8::Sched, true, true>(lds, g, S, E); }
    SEAM(8);
    if (IN(9)) { pg8::Gemm g{(const bf16*)(ws + WS_MG), (const bf16*)(ws + WS_WOUTT), 0, 0, 1024}; pg8::Sched S{3, 256, G, vb, 4, 0, 0}; pg8::Epi<7> E{ep};
        pg8::gemm_phase<pg8::Epi<7>, pg8::Sched, true, true>(lds, g, S, E); }
    SEAM(9);
    if (IN(10)) { pg8::Gemm g{(const bf16*)(ws + WS_H1B), (const bf16*)(ws + WS_W1T), 0, 0, 1024}; pg8::Sched S{3, 1024, G, vb, 16, 0, 0}; pg8::Epi<8> E{ep};
        pg8::gemm_phase<pg8::Epi<8>, pg8::Sched, true, true>(lds, g, S, E); }
    SEAM(10);
    if (IN(11)) { pg8::Gemm g{(const bf16*)(ws + WS_HF), (const bf16*)(ws + WS_W2T), 0, 0, 4096}; pg8::Sched S{3, 256, G, vb, 4, 0, 0}; pg8::Epi<9> E{ep};
        pg8::gemm_phase<pg8::Epi<9>, pg8::Sched, true, true>(lds, g, S, E); }
    SEAM(11);
    if (IN(12)) { p11_final(a, lane, wave, bid, G); }
#ifdef PROBE_REP
    if (IN(13)) { pg8::Gemm g{(const bf16*)(ws + WS_HF), (const bf16*)(ws + WS_W2T), 0, 0, 4096}; pg8::Sched S{3, 256, G, vb, 4, 0, 0}; pg8::Epi<10> E{ep};
        pg8::gemm_phase<pg8::Epi<10>, pg8::Sched, true, true>(lds, g, S, E); }
    if (IN(14)) { const int gw = bid * NWAVES + wave, NGW = G * NWAVES;
        for (int row = gw; row < NREAL; row += NGW) { f32x4* xr = (f32x4*)(a.out + (size_t)row * D) + lane; float s = 0.f;
            for (int j = 0; j < 4; ++j) { const f32x4 v = xr[64 * j]; s += v.x + v.y + v.z + v.w; }
            if (wave_sum(s) == 123456.789f) xr[0] = (f32x4){s, s, s, s}; } }
#endif
#undef IN
#undef SEAM
}

extern "C" void kernel_launch(void* const* d_in, const int* in_sizes, int n_in, void* d_out, int out_size, void* d_ws, size_t ws_size, hipStream_t stream) {
    static int grid = 0;
    if (grid == 0) {
        int dev = 0, cus = 0, per_cu = 0;
        (void)hipGetDevice(&dev); (void)hipDeviceGetAttribute(&cus, hipDeviceAttributeMultiprocessorCount, dev);
        (void)hipFuncSetAttribute((const void*)fwd_kernel, hipFuncAttributeMaxDynamicSharedMemorySize, LDS_BYTES);
        (void)hipOccupancyMaxActiveBlocksPerMultiprocessor(&per_cu, (const void*)fwd_kernel, NTHREADS, LDS_BYTES);
        (void)hipGetLastError();
        if (per_cu < 1) { fprintf(stderr, "kernel_launch: occupancy query says %d blocks/CU\n", per_cu); per_cu = 1; }
        grid = cus * 1;
        if (grid > 256) grid = 256;
    }
    Args a{};
    const float* const* in = (const float* const*)d_in;
    a.x = in[0]; a.meta = in[1]; a.norm_mix = in[2]; a.w_in = in[3]; a.wdf = in[4]; a.bdf = in[5]; a.wdb = in[6]; a.bdb = in[7]; a.gla_norm = in[8];
    a.w_o = in[9]; a.w_fnet = in[10]; a.w_out = in[11]; a.norm_ffn = in[12]; a.w_ff1 = in[13]; a.w_ff2 = in[14]; a.norm_final = in[15];
    a.out = (float*)d_out; a.ws = (unsigned char*)d_ws;
#if ONE_LAUNCH
    a.ph_lo = 0; a.ph_hi = NPH;
    void* args[] = {&a};
    hipError_t e = hipLaunchCooperativeKernel((const void*)fwd_kernel, dim3(grid), dim3(NTHREADS), args, LDS_BYTES, stream);
    if (e != hipSuccess) fprintf(stderr, "cooperative launch failed: %s (grid %d)\n", hipGetErrorString(e), grid);
#else
    for (int p = 0; p < NPH; ++p) { a.ph_lo = p; a.ph_hi = p + 1; hipLaunchKernelGGL(fwd_kernel, dim3(grid), dim3(NTHREADS), LDS_BYTES, stream, a);
#ifdef PROBE_REP
        if (p == PROBE_REP) for (int q = 0; q < PROBE_N; ++q) hipLaunchKernelGGL(fwd_kernel, dim3(grid), dim3(NTHREADS), LDS_BYTES, stream, a);
#ifdef PROBE_DRY
        if (p == PROBE_AFTER) { Args a2 = a; a2.ph_lo = PROBE_DRY; a2.ph_hi = PROBE_DRY + 1; for (int q = 0; q < PROBE_N; ++q) hipLaunchKernelGGL(fwd_kernel, dim3(grid), dim3(NTHREADS), LDS_BYTES, stream, a2); }
#endif
#endif
    }
#endif
}
```

```cpp
#include <hip/hip_runtime.h>
#include <hip/hip_cooperative_groups.h>
#include <cstdio>
#include <cstdint>
namespace cg = cooperative_groups;
namespace pg8 {
#define PG8_LAS __attribute__((address_space(3)))
typedef unsigned short bf16_t;
typedef short bf16x8 __attribute__((ext_vector_type(8)));
typedef float f32x4 __attribute__((ext_vector_type(4)));
typedef unsigned u32x4 __attribute__((ext_vector_type(4)));
constexpr int BM = 256, BK = 64, HALF = 128, HTB = HALF * BK * 2  , STAGE_BYTES = 8 * HTB, NXCD = 8, WGM = 8;

__host__ __device__ __forceinline__ int lds_byte(int r, int c) { const int st = (r >> 4) * 2 + (c >> 5), rr = r & 15, cc = c & 31, ob = rr * 64 + cc * 2; return st * 1024 + (ob ^ (((ob >> 9) & 1) << 5)); }
__host__ __device__ __forceinline__ void stage_rc(int b, int& R, int& C) { const int st = b / 1024, sb = b % 1024, swz = sb ^ (((sb >> 9) & 1) << 5); R = (st >> 1) * 16 + swz / 64; C = (st & 1) * 32 + (swz % 64) / 2; }
__host__ __device__ __forceinline__ int perm32(int rho) { const int n = rho >> 4, i = rho & 15; return 8 * (i >> 2) + 4 * n + (i & 3); }

struct Unit { int pm, pn; };
struct Gemm { const bf16_t* A; const bf16_t* Bt; int M, N, K; };

__device__ __forceinline__ unsigned cvt_pk_bf16(float lo, float hi) { unsigned r; asm volatile("v_cvt_pk_bf16_f32 %0, %1, %2" : "=v"(r) : "v"(lo), "v"(hi)); return r; }
__device__ __forceinline__ float bflo(unsigned w) { return __uint_as_float(w << 16); }
__device__ __forceinline__ float bfhi(unsigned w) { return __uint_as_float(w & 0xffff0000u); }

struct Sched {
    int mode, n, G, c, nN, offM, offN;
    __device__ __forceinline__ bool next(int i, Unit& u) const {
        const int L = i * G + c; if (L >= n) return false;
        if (mode == 1) {
            if (L < 585) { u.pm = L / 9; u.pn = 65 + L % 9; }
            else { const int l2 = L - 585; u.pm = 65 + 9 + (l2 & 3); u.pn = l2 >> 2; }
        } else if (mode == 2) {
            const int grp = L >> 6, r = L & 63; u.pm = grp * 16 + (r >> 2); u.pn = grp * 4 + (r & 3);
        } else {
            const int x = (L & 255) >> 5, ul = (L >> 8) * 32 + (L & 31);
            u.pm = 8 * x + (ul & 7) + offM; u.pn = (ul >> 3) + offN; }
        return true;
    }
    __device__ __forceinline__ void a_ready(const Unit&) const {}
    __device__ __forceinline__ void done(const Unit&) const {}
};

struct EP {
    bf16_t *Q, *K, *V; float* R; bf16_t* GT2; bf16_t* PQ; bf16_t *SGA, *SGF, *ON, *OG, *MG, *H1B, *HF;
    const float* x; float* H; float* PART1; const float* gnorm;
};
constexpr int LDG = 8320;
template <int MODE> struct Epi {
    static constexpr bool PERM = true, AFTER_DRAIN = false;
    EP p;
    __device__ __forceinline__ void operator()(const f32x4 (&acc)[2][2][4][2], const Unit& u, int wr, int wc, int fr, int fq) const {
#pragma unroll
        for (int ai = 0; ai < 2; ++ai)
#pragma unroll
            for (int m = 0; m < 4; ++m) {
                const int r = ai * HALF + wr * 64 + m * 16 + fr;
                float ss = 0.f;
                float rstd = 1.f;
                if (MODE == 8) { const float* pp = p.PART1 + (size_t)(u.pm * BM + r) * 16; float s = 0.f;
#pragma unroll
                    for (int t = 0; t < 4; ++t) { const f32x4 q4 = *(const f32x4*)(pp + 4 * t); s += (q4[0] + q4[1]) + (q4[2] + q4[3]); }
                    rstd = 1.0f / sqrtf(s * (1.0f / 1024.0f) + 1e-6f); }
#pragma unroll
                for (int bj = 0; bj < 2; ++bj) {
                    const int c = bj * HALF + wc * 32 + 8 * fq;
                    f32x4 v0 = acc[ai][bj][m][0], v1 = acc[ai][bj][m][1];
                    if (MODE == 1) {
                        if (u.pm < 65) {
                            const int t = u.pn - 65; const size_t row = (size_t)u.pm * BM + r;
                            if (t < 8) {
                                bf16_t* dst; float sc = 1.f;
                                if (t < 2) { dst = p.Q + row * 512 + t * 256 + c; sc = 0.08838834764831845f; }
                                else if (t < 4) dst = p.K + row * 512 + (t - 2) * 256 + c;
                                else dst = p.V + row * 1024 + (t - 4) * 256 + c;
                                u32x4 w; w.x = cvt_pk_bf16(v0[0] * sc, v0[1] * sc); w.y = cvt_pk_bf16(v0[2] * sc, v0[3] * sc); w.z = cvt_pk_bf16(v1[0] * sc, v1[1] * sc); w.w = cvt_pk_bf16(v1[2] * sc, v1[3] * sc);
                                *(u32x4*)dst = w;
                            } else if (c < 32) { float* dst = p.R + row * 32 + c; *(f32x4*)dst = v0; *(f32x4*)(dst + 4) = v1; }
                        } else {
                            const int gcol = (u.pm - 74) * BM + r, cs = gcol >> 9, col = gcol & 511;
                            u32x4 w; w.x = cvt_pk_bf16(v0[0], v0[1]); w.y = cvt_pk_bf16(v0[2], v0[3]); w.z = cvt_pk_bf16(v1[0], v1[1]); w.w = cvt_pk_bf16(v1[2], v1[3]);
                            if (u.pn < 64) { const int b = u.pn >> 5, l = 16 + (u.pn & 31) * 256 + c;
                                *(u32x4*)(p.GT2 + ((size_t)(b * 512 + col) * 2 + cs) * LDG + l) = w; }
                            else if (c == 48 || c == 56) { const int l = c - 48;
                                *(u32x4*)(p.GT2 + ((size_t)(col) * 2 + cs) * LDG + l) = w; *(u32x4*)(p.GT2 + ((size_t)(512 + col) * 2 + cs) * LDG + l) = w; }
                        }
                    } else if (MODE == 2) {
                        const int grp = u.pm >> 4; const size_t idx = (size_t)(u.pm & 15) * BM + r; const int n = (u.pn & 3) * BM + c;
                        u32x4 w; w.x = cvt_pk_bf16(v0[0], v0[1]); w.y = cvt_pk_bf16(v0[2], v0[3]); w.z = cvt_pk_bf16(v1[0], v1[1]); w.w = cvt_pk_bf16(v1[2], v1[3]);
                        *(u32x4*)(p.PQ + ((size_t)grp * 4096 + idx) * 1024 + n) = w;
                    } else if (MODE == 3) {
                        const int t = u.pn - 82; const size_t row = (size_t)u.pm * BM + r;
                        bf16_t* dst = (t < 4 ? p.SGA : p.SGF) + row * 1024 + (t & 3) * 256 + c;
                        float s[8];
#pragma unroll
                        for (int e = 0; e < 4; ++e) { s[e] = 1.f / (1.f + __expf(-v0[e])); s[4 + e] = 1.f / (1.f + __expf(-v1[e])); }
                        u32x4 w; w.x = cvt_pk_bf16(s[0], s[1]); w.y = cvt_pk_bf16(s[2], s[3]); w.z = cvt_pk_bf16(s[4], s[5]); w.w = cvt_pk_bf16(s[6], s[7]);
                        *(u32x4*)dst = w;
                    } else if (MODE == 4) {
                        const int t = u.pn - 78; const size_t off = ((size_t)u.pm * BM + r) * 1024 + t * 256 + c;
                        const u32x4 o = *(const u32x4*)(p.ON + off);
                        float s[8];
#pragma unroll
                        for (int e = 0; e < 4; ++e) { s[e] = v0[e] / (1.f + __expf(-v0[e])); s[4 + e] = v1[e] / (1.f + __expf(-v1[e])); }
                        u32x4 w; w.x = cvt_pk_bf16(s[0] * bflo(o.x), s[1] * bfhi(o.x)); w.y = cvt_pk_bf16(s[2] * bflo(o.y), s[3] * bfhi(o.y));
                        w.z = cvt_pk_bf16(s[4] * bflo(o.z), s[5] * bfhi(o.z)); w.w = cvt_pk_bf16(s[6] * bflo(o.w), s[7] * bfhi(o.w));
                        *(u32x4*)(p.OG + off) = w;
                    } else if (MODE == 5 || MODE == 6) {
                        const size_t off = ((size_t)u.pm * BM + r) * 1024 + u.pn * BM + c;
                        const u32x4 gt = *(const u32x4*)((MODE == 5 ? p.SGF : p.SGA) + off);
                        float s[8] = {v0[0] * bflo(gt.x), v0[1] * bfhi(gt.x), v0[2] * bflo(gt.y), v0[3] * bfhi(gt.y), v1[0] * bflo(gt.z), v1[1] * bfhi(gt.z), v1[2] * bflo(gt.w), v1[3] * bfhi(gt.w)};
                        if (MODE == 6) { const u32x4 mg = *(const u32x4*)(p.MG + off);
                            s[0] += bflo(mg.x); s[1] += bfhi(mg.x); s[2] += bflo(mg.y); s[3] += bfhi(mg.y); s[4] += bflo(mg.z); s[5] += bfhi(mg.z); s[6] += bflo(mg.w); s[7] += bfhi(mg.w); }
                        u32x4 w; w.x = cvt_pk_bf16(s[0], s[1]); w.y = cvt_pk_bf16(s[2], s[3]); w.z = cvt_pk_bf16(s[4], s[5]); w.w = cvt_pk_bf16(s[6], s[7]);
                        *(u32x4*)(p.MG + off) = w;
                    } else if (MODE == 7) {
                        const size_t off = ((size_t)u.pm * BM + r) * 1024 + u.pn * BM + c;
                        const f32x4 x0 = *(const f32x4*)(p.x + off), x1 = *(const f32x4*)(p.x + off + 4);
                        v0 = v0 + x0; v1 = v1 + x1;
                        u32x4 w; w.x = cvt_pk_bf16(v0[0], v0[1]); w.y = cvt_pk_bf16(v0[2], v0[3]); w.z = cvt_pk_bf16(v1[0], v1[1]); w.w = cvt_pk_bf16(v1[2], v1[3]);
                        *(u32x4*)(p.H1B + off) = w;
                        ss += (v0[0] * v0[0] + v0[1] * v0[1]) + (v0[2] * v0[2] + v0[3] * v0[3]) + (v1[0] * v1[0] + v1[1] * v1[1]) + (v1[2] * v1[2] + v1[3] * v1[3]);
                    } else if (MODE == 8) {
                        const size_t off = ((size_t)u.pm * BM + r) * 4096 + u.pn * BM + c;
                        float s[8];
#pragma unroll
                        for (int e = 0; e < 4; ++e) { float a = fmaxf(v0[e] * rstd, 0.f), b = fmaxf(v1[e] * rstd, 0.f); s[e] = a * a; s[4 + e] = b * b; }
                        u32x4 w; w.x = cvt_pk_bf16(s[0], s[1]); w.y = cvt_pk_bf16(s[2], s[3]); w.z = cvt_pk_bf16(s[4], s[5]); w.w = cvt_pk_bf16(s[6], s[7]);
                        *(u32x4*)(p.HF + off) = w;
                    } else if (MODE == 10) {
                        const size_t off = ((size_t)u.pm * BM + r) * 1024 + u.pn * BM + c;
                        const f32x4 x0 = *(const f32x4*)(p.H + off), x1 = *(const f32x4*)(p.H + off + 4);
                        if (v0[0] + x0[0] + x1[1] + v1[2] == 123456.789f) { *(f32x4*)(p.H + off) = v0 + x0; }
                    } else if (MODE == 9) {
                        const size_t off = ((size_t)u.pm * BM + r) * 1024 + u.pn * BM + c;
                        const u32x4 hb = *(const u32x4*)(p.H1B + off);
                        const f32x4 x0 = {bflo(hb.x), bfhi(hb.x), bflo(hb.y), bfhi(hb.y)}, x1 = {bflo(hb.z), bfhi(hb.z), bflo(hb.w), bfhi(hb.w)};
                        *(f32x4*)(p.H + off) = v0 + x0; *(f32x4*)(p.H + off + 4) = v1 + x1;
                    }
                }
                if (MODE == 7) { ss += __shfl_xor(ss, 16); ss += __shfl_xor(ss, 32);
                    if (fq == 0) p.PART1[(size_t)(u.pm * BM + r) * 16 + u.pn * 4 + wc] = ss; }
            }
    }
};
template <class Epi, class Sched, bool ALIGN_EPI = false, bool SP2 = false>
__device__ __forceinline__ void gemm_phase(PG8_LAS unsigned char* lds, const Gemm g, const Sched& S, const Epi& E) {
    const int tid = threadIdx.x, wid = __builtin_amdgcn_readfirstlane(tid >> 6), lane = tid & 63, wr = wid >> 2, wc = wid & 3, fr = lane & 15, fq = lane >> 4;
    const int K = g.K, nt = K / BK;
    unsigned voffA[2], voffB[2];
#pragma unroll
    for (int i = 0; i < 2; ++i) { int R, C; stage_rc(tid * 16 + i * 8192, R, C); const int Rb = Epi::PERM ? ((R & ~31) + perm32(R & 31)) : R;
        voffA[i] = (unsigned)(R * K + C) * 2u; voffB[i] = (unsigned)(Rb * K + C) * 2u; }
    const size_t kstep = (size_t)(BK * 2);
    const size_t hstep = (size_t)HALF * K * 2;
    const size_t tstep = 2 * hstep;
    const unsigned ldsw = (unsigned)wid * 1024u;
    const int aoff = lds_byte(wr * 64 + fr, fq * 8), boff = lds_byte(wc * 32 + fr, fq * 8);
#define PG8_SA(b, h) (((b) * 2 + (h)) * HTB)
#define PG8_SB(b, h) ((4 + (b) * 2 + (h)) * HTB)
#define PG8_STAGE(bufoff, gbase, voff) do { _Pragma("unroll") for (int _i = 0; _i < 2; ++_i) \
        __builtin_amdgcn_global_load_lds((const unsigned*)((const char*)(gbase) + (voff)[_i]), (PG8_LAS unsigned*)(lds + (bufoff) + ldsw + _i * 8192), 16, 0, 0); } while (0)
#define PG8_LDA(dst, b, h) do { _Pragma("unroll") for (int m = 0; m < 4; ++m) _Pragma("unroll") for (int k = 0; k < 2; ++k) dst[m][k] = *(const PG8_LAS bf16x8*)(lds + PG8_SA(b, h) + aoff + m * 2048 + k * 1024); } while (0)
#define PG8_LDB(dst, b, h) do { _Pragma("unroll") for (int n = 0; n < 2; ++n) _Pragma("unroll") for (int k = 0; k < 2; ++k) dst[n][k] = *(const PG8_LAS bf16x8*)(lds + PG8_SB(b, h) + boff + n * 2048 + k * 1024); } while (0)
#define PG8_MMA(ai, bj, At, Bt) do { __builtin_amdgcn_s_setprio(1); _Pragma("unroll") for (int m = 0; m < 4; ++m) _Pragma("unroll") for (int n = 0; n < 2; ++n) _Pragma("unroll") for (int k = 0; k < 2; ++k) \
        acc[ai][bj][m][n] = __builtin_amdgcn_mfma_f32_16x16x32_bf16(Bt[n][k], At[m][k], acc[ai][bj][m][n], 0, 0, 0); __builtin_amdgcn_s_setprio(0); } while (0)
#define PG8_WAIT_V(n) asm volatile("s_waitcnt vmcnt(" #n ")" ::: "memory")
#define PG8_WAIT_L(n) asm volatile("s_waitcnt lgkmcnt(" #n ")" ::: "memory")
#define PG8_BAR __builtin_amdgcn_s_barrier()
#define PG8_SCHED __builtin_amdgcn_sched_barrier(0)
    Unit cur, nxt; int ui = 0;
    if (!S.next(0, cur)) return;
    f32x4 acc[2][2][4][2];
#pragma unroll
    for (int a = 0; a < 2; ++a)
#pragma unroll
        for (int b = 0; b < 2; ++b)
#pragma unroll
            for (int m = 0; m < 4; ++m)
#pragma unroll
                for (int n = 0; n < 2; ++n) acc[a][b][m][n] = (f32x4){0.f, 0.f, 0.f, 0.f};
    bf16x8 At[4][2], B0[2][2], B1[2][2];
    const char* cA = (const char*)g.A + (size_t)cur.pm * tstep; const char* cB = (const char*)g.Bt + (size_t)cur.pn * tstep;
    S.a_ready(cur);
    if constexpr (SP2) {
        PG8_STAGE(PG8_SB(0, 0), cB, voffB); PG8_STAGE(PG8_SB(0, 1), cB + hstep, voffB); PG8_STAGE(PG8_SA(0, 0), cA, voffA); PG8_STAGE(PG8_SA(0, 1), cA + hstep, voffA);
        if (wr == 1) PG8_BAR;
        PG8_WAIT_V(2); PG8_BAR;
        PG8_STAGE(PG8_SB(1, 0), cB + kstep, voffB); PG8_STAGE(PG8_SA(1, 0), cA + kstep, voffA); PG8_STAGE(PG8_SB(1, 1), cB + hstep + kstep, voffB);
        PG8_WAIT_V(6); PG8_BAR;
    } else {
        PG8_STAGE(PG8_SB(0, 0), cB, voffB); PG8_STAGE(PG8_SA(0, 0), cA, voffA); PG8_STAGE(PG8_SB(0, 1), cB + hstep, voffB); PG8_STAGE(PG8_SA(0, 1), cA + hstep, voffA);
        if (wr == 1) PG8_BAR;
        PG8_WAIT_V(4); PG8_BAR;
        PG8_STAGE(PG8_SB(1, 0), cB + kstep, voffB); PG8_STAGE(PG8_SA(1, 0), cA + kstep, voffA); PG8_STAGE(PG8_SB(1, 1), cB + hstep + kstep, voffB);
        PG8_WAIT_V(6); PG8_BAR;
    }
    for (;;) {
        const bool has_next = S.next(ui + 1, nxt);
        const char* nA = has_next ? (const char*)g.A + (size_t)nxt.pm * tstep : cA; const char* nB = has_next ? (const char*)g.Bt + (size_t)nxt.pn * tstep : cB;
        for (int t = 0; t < nt; t += 2) {
            const bool last = (t == nt - 2);
            const char* a1 = cA + (size_t)(t + 1) * kstep;
            const char* a2 = last ? nA : cA + (size_t)(t + 2) * kstep; const char* b2 = last ? nB : cB + (size_t)(t + 2) * kstep;
            const char* a3 = a2 + kstep; const char* b3 = b2 + kstep;
            if (last && has_next) S.a_ready(nxt);
            if constexpr (SP2) {
            PG8_LDB(B0, 0, 0); PG8_LDB(B1, 0, 1); PG8_SCHED; PG8_LDA(At, 0, 0); PG8_STAGE(PG8_SA(1, 1), a1 + hstep, voffA);
            PG8_WAIT_V(8); PG8_WAIT_L(0); PG8_BAR; PG8_MMA(0, 0, At, B0); PG8_MMA(0, 1, At, B1); PG8_BAR; PG8_SCHED;
            PG8_LDA(At, 0, 1); PG8_STAGE(PG8_SB(0, 0), b2, voffB); PG8_STAGE(PG8_SB(0, 1), b2 + hstep, voffB); PG8_STAGE(PG8_SA(0, 0), a2, voffA);
            PG8_WAIT_V(8); PG8_WAIT_L(0); PG8_BAR; PG8_MMA(1, 0, At, B0); PG8_MMA(1, 1, At, B1); PG8_BAR; PG8_SCHED;
            PG8_LDB(B0, 1, 0); PG8_LDB(B1, 1, 1); PG8_SCHED; PG8_LDA(At, 1, 0); PG8_STAGE(PG8_SA(0, 1), a2 + hstep, voffA);
            PG8_WAIT_V(8); PG8_WAIT_L(0); PG8_BAR; PG8_MMA(0, 0, At, B0); PG8_MMA(0, 1, At, B1); PG8_BAR; PG8_SCHED;
            PG8_LDA(At, 1, 1); PG8_STAGE(PG8_SB(1, 0), b3, voffB); PG8_STAGE(PG8_SB(1, 1), b3 + hstep, voffB); PG8_STAGE(PG8_SA(1, 0), a3, voffA);
            PG8_WAIT_V(8); PG8_WAIT_L(0); PG8_BAR; PG8_MMA(1, 0, At, B0); PG8_MMA(1, 1, At, B1); PG8_BAR; PG8_SCHED;
            } else {
            PG8_LDB(B0, 0, 0); PG8_SCHED; PG8_LDA(At, 0, 0); PG8_STAGE(PG8_SA(1, 1), a1 + hstep, voffA);
            PG8_WAIT_L(8); PG8_BAR; PG8_WAIT_L(0); PG8_MMA(0, 0, At, B0); PG8_BAR; PG8_SCHED;
            PG8_LDB(B1, 0, 1); PG8_STAGE(PG8_SB(0, 0), b2, voffB);
            PG8_BAR; PG8_WAIT_L(0); PG8_MMA(0, 1, At, B1); PG8_BAR;
            PG8_LDA(At, 0, 1); PG8_STAGE(PG8_SA(0, 0), a2, voffA);
            PG8_BAR; PG8_WAIT_L(0); PG8_MMA(1, 0, At, B0); PG8_BAR; PG8_SCHED;
            PG8_STAGE(PG8_SB(0, 1), b2 + hstep, voffB);
            PG8_WAIT_V(6); PG8_BAR; PG8_MMA(1, 1, At, B1); PG8_BAR;
            PG8_LDB(B0, 1, 0); PG8_SCHED; PG8_LDA(At, 1, 0); PG8_STAGE(PG8_SA(0, 1), a2 + hstep, voffA);
            PG8_WAIT_L(8); PG8_BAR; PG8_WAIT_L(0); PG8_MMA(0, 0, At, B0); PG8_BAR; PG8_SCHED;
            PG8_LDB(B1, 1, 1); PG8_STAGE(PG8_SB(1, 0), b3, voffB);
            PG8_BAR; PG8_WAIT_L(0); PG8_MMA(0, 1, At, B1); PG8_BAR;
            PG8_LDA(At, 1, 1); PG8_STAGE(PG8_SA(1, 0), a3, voffA);
            PG8_BAR; PG8_WAIT_L(0); PG8_MMA(1, 0, At, B0); PG8_BAR; PG8_SCHED;
            PG8_STAGE(PG8_SB(1, 1), b3 + hstep, voffB);
            PG8_WAIT_V(6); PG8_BAR; PG8_MMA(1, 1, At, B1); PG8_BAR;
            }
        }
        if constexpr (ALIGN_EPI) { if (wr == 0) PG8_BAR; }
        if constexpr (!Epi::AFTER_DRAIN) { E(acc, cur, wr, wc, fr, fq); S.done(cur); }
        if (!has_next) break;
#pragma unroll
        for (int a = 0; a < 2; ++a)
#pragma unroll
            for (int b = 0; b < 2; ++b)
#pragma unroll
                for (int m = 0; m < 4; ++m)
#pragma unroll
                    for (int n = 0; n < 2; ++n) acc[a][b][m][n] = (f32x4){0.f, 0.f, 0.f, 0.f};
        cur = nxt; cA = nA; cB = nB; ++ui;
        if constexpr (ALIGN_EPI) { if (wr == 1) PG8_BAR; }
    }
    PG8_WAIT_V(0);
    if constexpr (!ALIGN_EPI) { if (wr == 0) PG8_BAR; }
    PG8_BAR;
    if constexpr (Epi::AFTER_DRAIN) { E.fused(acc, cur, wr, wc, fr, fq, lds, wid, lane); S.done(cur); }
#undef PG8_SA
#undef PG8_SB
#undef PG8_STAGE
#undef PG8_LDA
#undef PG8_LDB
#undef PG8_MMA
#undef PG8_WAIT_V
#undef PG8_WAIT_L
#undef PG8_BAR
#undef PG8_SCHED
}
}
#define LAS __attribute__((address_space(3)))
#define DI __device__ __forceinline__
typedef unsigned short bf16;
typedef unsigned v4u __attribute__((ext_vector_type(4)));
typedef unsigned v2u __attribute__((ext_vector_type(2)));
typedef float f32x4 __attribute__((ext_vector_type(4)));
typedef short bf16x8 __attribute__((ext_vector_type(8)));
constexpr int NTHREADS = 512, NWAVES = 8;
constexpr int D = 1024, NREAL = 16384, MROWS = 16640, LSEQ = 8208, FF = 4096, DIN = 5664, NCHUNK = 129;
constexpr int LDG = 8320, KH = 2176;
constexpr size_t MiB = 1u << 20;
constexpr size_t WS_PART1 = 0;
constexpr size_t WS_ALL = 1 * MiB;
constexpr size_t WS_WOT = 46 * MiB, WS_WFT = 48 * MiB, WS_WOUTT = 49 * MiB, WS_W1T = 51 * MiB, WS_W2T = 59 * MiB;
constexpr size_t WS_TAB = 67 * MiB;
constexpr size_t WS_CS = 68 * MiB + 512 * 1024;
constexpr size_t WS_GT2 = 136 * MiB + 512 * 1024;
constexpr size_t WS_EOT = 169 * MiB;
constexpr size_t WS_REMP = 186 * MiB;
constexpr size_t WS_PQ = 189 * MiB;
constexpr size_t WS_K = 221 * MiB;
constexpr size_t WS_R = 237 * MiB + 512 * 1024;
constexpr size_t WS_FN = 240 * MiB;
constexpr size_t DO_V = 0, DO_Q = 33 * MiB, DO_OB = 0;
constexpr size_t WS_REC = 69 * MiB;
constexpr size_t REC_BYTES = 43008, REC_KDT = 16384, REC_PM = 32768, REC_DEC = 40960;
constexpr size_t WS_QI_UNUSED = 69 * MiB;
constexpr size_t WS_KDT = 102 * MiB;
constexpr size_t WS_VT = 153 * MiB + 768 * 1024;
constexpr size_t WS_PM = 168 * MiB;
constexpr size_t WS_DEC = 184 * MiB + 512 * 1024;
constexpr size_t WS_OF = 189 * MiB;
constexpr size_t WS_ON = 69 * MiB, WS_SGA = 101 * MiB, WS_SGF = 133 * MiB, WS_OG = 165 * MiB, WS_MG = 197 * MiB;
constexpr size_t WS_H1B = 69 * MiB, WS_HF = 101 * MiB;
constexpr int LDS_BYTES = 155648;
struct Args {
    const float *x, *meta, *norm_mix, *w_in, *wdf, *bdf, *wdb, *bdb, *gla_norm, *w_o, *w_fnet, *w_out, *norm_ffn, *w_ff1, *w_ff2, *norm_final;
    float* out; unsigned char* ws; int ph_lo, ph_hi;
};
DI unsigned f2bf(float f) { unsigned u = __builtin_bit_cast(unsigned, f); return (u + 0x7fffu + ((u >> 16) & 1u)) >> 16; }
DI unsigned pk2(float lo, float hi) { return f2bf(lo) | (f2bf(hi) << 16); }
typedef float f32x2_t __attribute__((ext_vector_type(2)));
typedef __bf16 bf16x2_t __attribute__((ext_vector_type(2)));
DI unsigned cvtpk(float lo, float hi) { f32x2_t v = {lo, hi}; bf16x2_t b = __builtin_convertvector(v, bf16x2_t); return __builtin_bit_cast(unsigned, b); }
DI float bf2f(unsigned h) { return __uint_as_float(h << 16); }
DI float wave_sum(float v) {
#pragma unroll
    for (int o = 1; o < 64; o <<= 1) v += __shfl_xor(v, o);
    return v;
}
DI void transpose_item(const float* W, int pitch, int K, int ncols, bf16* WT, int row_off, LAS float* scr, int item, int lane, const float* kscale) {
    const int nblk = ncols / 32, kb = item / nblk, nb = item % nblk, k0 = 64 * kb, n0 = 32 * nb;
#pragma unroll 8
    for (int i = 0; i < 32; ++i) { const int kk = 2 * i + (lane >> 5); float v = W[(size_t)(k0 + kk) * pitch + n0 + (lane & 31)]; if (kscale) v *= kscale[k0 + kk]; scr[kk * 33 + (lane & 31)] = v; }
    asm volatile("s_waitcnt lgkmcnt(0)" ::: "memory");
    const int c = lane & 7;
#pragma unroll
    for (int j = 0; j < 4; ++j) { const int n = (lane >> 3) + 8 * j; const LAS float* s = scr + (8 * c) * 33 + n;
        v4u o; o.x = pk2(s[0 * 33], s[1 * 33]); o.y = pk2(s[2 * 33], s[3 * 33]); o.z = pk2(s[4 * 33], s[5 * 33]); o.w = pk2(s[6 * 33], s[7 * 33]);
        *(v4u*)(WT + (size_t)(row_off + n0 + n) * K + k0 + 8 * c) = o; }
    asm volatile("s_waitcnt lgkmcnt(0)" ::: "memory");
}
DI void rms_row_to_bf16(const float* xrow, const float* gain, bf16* orow, int lane) {
    const f32x4* xr = (const f32x4*)xrow + lane; const f32x4* gr = (const f32x4*)gain + lane;
    f32x4 v[4]; float s = 0.f;
#pragma unroll
    for (int j = 0; j < 4; ++j) { v[j] = xr[64 * j]; s += (v[j].x * v[j].x + v[j].y * v[j].y) + (v[j].z * v[j].z + v[j].w * v[j].w); }
    const float rstd = 1.f / sqrtf(wave_sum(s) * (1.f / 1024.f) + 1e-6f);
    unsigned long long* o8 = (unsigned long long*)orow + lane;
#pragma unroll
    for (int j = 0; j < 4; ++j) { const f32x4 g = gr[64 * j];
        o8[64 * j] = (unsigned long long)pk2(v[j].x * rstd * g.x, v[j].y * rstd * g.y) | ((unsigned long long)pk2(v[j].z * rstd * g.z, v[j].w * rstd * g.w) << 32); }
}

DI void p0_prologue(const Args& a, LAS unsigned char* lds, int tid, int lane, int wave, int bid, int G) {
    unsigned char* ws = a.ws;
    bf16* ALL = (bf16*)(ws + WS_ALL);
    const int gw = bid * NWAVES + wave, NGW = G * NWAVES;
    const int gt = bid * NTHREADS + tid, NGT = G * NTHREADS;
    LAS float* tabc = (LAS float*)lds; LAS float* tabs = tabc + LSEQ;
    for (int j = tid; j < LSEQ; j += NTHREADS) { const float ang = 6.283185307179586f * (float)j / (float)LSEQ; tabc[j] = __cosf(ang); tabs[j] = __sinf(ang); }
    __syncthreads();
    {
        bf16* CS = (bf16*)(ws + WS_CS);
        const int nchunk = 4 * 4096 * (KH / 8);
        for (int ch = gt; ch < nchunk; ch += NGT) {
            const int k8 = ch % (KH / 8); const int rest = ch / (KH / 8); const int idx = rest & 4095, grp = rest >> 12, cs = grp >> 1, kh = grp & 1;
            const int m = idx + 9, l0 = kh * KH + k8 * 8;
            unsigned j = ((unsigned)l0 * (unsigned)m) % (unsigned)LSEQ;
            float v[8];
#pragma unroll
            for (int e = 0; e < 8; ++e) { v[e] = (l0 + e <= 4104) ? (cs ? tabs[j] : tabc[j]) : 0.f; j += m; if (j >= (unsigned)LSEQ) j -= LSEQ; }
            v4u o; o.x = pk2(v[0], v[1]); o.y = pk2(v[2], v[3]); o.z = pk2(v[4], v[5]); o.w = pk2(v[6], v[7]);
            *(v4u*)(CS + (size_t)ch * 8) = o;
        }
        bf16* TAB = (bf16*)(ws + WS_TAB);
        const int nch2 = 32 * 2 * (LDG / 8);
        for (int ch = gt; ch < nch2; ch += NGT) {
            const int l8 = ch % (LDG / 8); const int rest = ch / (LDG / 8); const int cs = rest & 1, rho = rest >> 1;
            const int lp = 8200 + rho, l0 = l8 * 8;
            unsigned j = ((unsigned)l0 * (unsigned)lp) % (unsigned)LSEQ;
            float v[8];
#pragma unroll
            for (int e = 0; e < 8; ++e) { v[e] = (rho < 8 && l0 + e < LSEQ) ? (cs ? -tabs[j] : tabc[j]) : 0.f; j += lp; while (j >= (unsigned)LSEQ) j -= LSEQ; }
            v4u o; o.x = pk2(v[0], v[1]); o.y = pk2(v[2], v[3]); o.z = pk2(v[4], v[5]); o.w = pk2(v[6], v[7]);
            *(v4u*)(TAB + (size_t)ch * 8) = o;
        }
    }
    __syncthreads();
    {
        LAS float* Wl = (LAS float*)lds;
        LAS float* c128 = Wl + 64 * 128; LAS float* s128 = c128 + 128;
        if (tid < 128) { const float ang = 6.283185307179586f * (float)tid / 128.f; c128[tid] = __cosf(ang); s128[tid] = __sinf(ang); }
        for (int item = bid; item < 256; item += G) {
            const int kb = item >> 4, g = (item >> 2) & 3, nq = item & 3;
            __syncthreads();
            for (int idx = tid; idx < 64 * 128; idx += NTHREADS) { const int kk = idx >> 7, c = idx & 127; Wl[idx] = a.w_in[(size_t)(kb * 64 + kk) * DIN + 3104 + g * 128 + c]; }
            __syncthreads();
            const int n = nq * 32 + (tid & 31), kg = tid >> 5;
            float ac[4] = {0.f, 0.f, 0.f, 0.f}, as[4] = {0.f, 0.f, 0.f, 0.f};
            const LAS float* w0 = Wl + (kg * 4) * 128;
#pragma unroll 4
            for (int c = 0; c < 128; ++c) { const int j = (c * n) & 127; const float cc = c128[j], ss = s128[j];
#pragma unroll
                for (int q = 0; q < 4; ++q) { const float w = w0[q * 128 + c]; ac[q] += w * cc; as[q] += w * ss; } }
            bf16* dc = ALL + (size_t)(74 * 256 + g * 128 + n) * D + kb * 64 + kg * 4;
            bf16* ds = ALL + (size_t)(76 * 256 + g * 128 + n) * D + kb * 64 + kg * 4;
            *(v2u*)dc = (v2u){pk2(ac[0], ac[1]), pk2(ac[2], ac[3])}; *(v2u*)ds = (v2u){pk2(as[0], as[1]), pk2(as[2], as[3])};
        }
        __syncthreads();
    }
    {
        LAS float* scr = (LAS float*)(lds + wave * 16384);
        bf16* WT = ALL + (size_t)65 * 256 * D;
        const int I_Q = 16 * 16, I_V = 16 * 32, I_R = 16 * 1, I_G = 16 * 32;
        const int I_O = 16 * 32, I_F = 8 * 32, I_1 = 16 * 128, I_2 = 64 * 32;
        const int NIT = 2 * I_Q + I_V + I_R + 3 * I_G + 2 * I_O + I_F + I_1 + I_2;
        for (int it = gw; it < NIT; it += NGW) {
            int r = it;
            if (r < I_Q) { transpose_item(a.w_in + 0, DIN, D, 512, WT, 0, scr, r, lane, nullptr); continue; } r -= I_Q;
            if (r < I_Q) { transpose_item(a.w_in + 512, DIN, D, 512, WT, 512, scr, r, lane, nullptr); continue; } r -= I_Q;
            if (r < I_V) { transpose_item(a.w_in + 1024, DIN, D, 1024, WT, 1024, scr, r, lane, nullptr); continue; } r -= I_V;
            if (r < I_R) { transpose_item(a.w_in + 3072, DIN, D, 32, WT, 2048, scr, r, lane, nullptr); continue; } r -= I_R;
            if (r < I_G) { transpose_item(a.w_in + 2048, DIN, D, 1024, WT, 13 * 256, scr, r, lane, nullptr); continue; } r -= I_G;
            if (r < I_G) { transpose_item(a.w_in + 3616, DIN, D, 1024, WT, 17 * 256, scr, r, lane, nullptr); continue; } r -= I_G;
            if (r < I_G) { transpose_item(a.w_in + 4640, DIN, D, 1024, WT, 21 * 256, scr, r, lane, nullptr); continue; } r -= I_G;
            if (r < I_O) { transpose_item(a.w_o, D, D, 1024, (bf16*)(ws + WS_WOT), 0, scr, r, lane, nullptr); continue; } r -= I_O;
            if (r < I_O) { transpose_item(a.w_out, D, D, 1024, (bf16*)(ws + WS_WOUTT), 0, scr, r, lane, nullptr); continue; } r -= I_O;
            if (r < I_F) { transpose_item(a.w_fnet, D, 512, 1024, (bf16*)(ws + WS_WFT), 0, scr, r, lane, nullptr); continue; } r -= I_F;
            if (r < I_1) { transpose_item(a.w_ff1, FF, D, FF, (bf16*)(ws + WS_W1T), 0, scr, r, lane, a.norm_ffn); continue; } r -= I_1;
            transpose_item(a.w_ff2, D, FF, 1024, (bf16*)(ws + WS_W2T), 0, scr, r, lane, nullptr);
        }
    }
    {
        bf16* t8 = ALL + (size_t)(73 * 256 + 32) * D;
        for (int i = gt; i < 224 * D / 8; i += NGT) *(v4u*)(t8 + (size_t)i * 8) = (v4u){0u, 0u, 0u, 0u};
        bf16* x64 = ALL + (size_t)16384 * D;
        for (int i = gt; i < 256 * D / 8; i += NGT) { const int row = i / (D / 8); if (row < 48 || row >= 64) *(v4u*)(x64 + (size_t)i * 8) = (v4u){0u, 0u, 0u, 0u}; }
        bf16* GT2 = (bf16*)(ws + WS_GT2);
        for (int i = gt; i < 2048 * 14; i += NGT) { const int row = i / 14, c = i % 14; *(v4u*)(GT2 + (size_t)row * LDG + LSEQ + c * 8) = (v4u){0u, 0u, 0u, 0u}; }
    }
    for (int m = gw; m < NREAL + 16; m += NGW) {
        if (m < NREAL) rms_row_to_bf16(a.x + (size_t)m * D, a.norm_mix, ALL + (size_t)m * D, lane);
        else rms_row_to_bf16(a.meta + (size_t)(m - NREAL) * D, a.norm_mix, ALL + (size_t)(NREAL + 48 + (m - NREAL)) * D, lane);
    }
}
DI void p2_sym_rem(const Args& a, int tid, int lane, int wave, int bid, int G) {
    unsigned char* ws = a.ws;
    const bf16* GT2 = (const bf16*)(ws + WS_GT2);
    bf16* EOT = (bf16*)(ws + WS_EOT);
    const int gt = bid * NTHREADS + tid, NGT = G * NTHREADS;
    const int nchunk = 4 * 1024 * (KH / 8);
    for (int ch = gt; ch < nchunk; ch += NGT) {
        const int k8 = ch % (KH / 8); const int rest = ch / (KH / 8); const int n = rest & 1023, grp = rest >> 10, cs = grp >> 1, kh = grp & 1;
        const int l0 = kh * KH + k8 * 8;
        const bf16* src = GT2 + ((size_t)n * 2 + cs) * LDG;
        float v[8];
        if (l0 > 4104) {
#pragma unroll
            for (int e = 0; e < 8; ++e) v[e] = 0.f;
        } else {
            const v4u f = *(const v4u*)(src + l0);
            const float fw[8] = {bf2f(f.x & 0xffffu), bf2f(f.x >> 16), bf2f(f.y & 0xffffu), bf2f(f.y >> 16), bf2f(f.z & 0xffffu), bf2f(f.z >> 16), bf2f(f.w & 0xffffu), bf2f(f.w >> 16)};
#pragma unroll
            for (int e = 0; e < 8; ++e) { const int l = l0 + e;
                if (l > 4104) v[e] = 0.f;
                else if (l == 0 || l == 4104) v[e] = cs ? 0.f : fw[e];
                else { const float mir = bf2f((unsigned)src[LSEQ - l]); v[e] = cs ? fw[e] - mir : fw[e] + mir; } }
        }
        v4u o; o.x = pk2(v[0], v[1]); o.y = pk2(v[2], v[3]); o.z = pk2(v[4], v[5]); o.w = pk2(v[6], v[7]);
        *(v4u*)(EOT + (size_t)ch * 8) = o;
    }
    typedef float f32x16 __attribute__((ext_vector_type(16)));
    const bf16* TAB = (const bf16*)(ws + WS_TAB);
    float* REMP = (float*)(ws + WS_REMP);
    const int gw = bid * NWAVES + wave, NGW = G * NWAVES;
    for (int task = gw; task < 32 * 65; task += NGW) {
        const int nt = task & 31, ks = task >> 5; const int r = lane & 31, h = lane >> 5;
        f32x16 acc; for (int i = 0; i < 16; ++i) acc[i] = 0.f;
        const bf16* ap = TAB + (size_t)r * (2 * LDG) + ks * 256 + 8 * h;
        const bf16* bp = GT2 + (size_t)(nt * 32 + r) * (2 * LDG) + ks * 256 + 8 * h;
#pragma unroll 4
        for (int kk = 0; kk < 16; ++kk) { const bf16x8 af = *(const bf16x8*)(ap + kk * 16), bfr = *(const bf16x8*)(bp + kk * 16);
            acc = __builtin_amdgcn_mfma_f32_32x32x16_bf16(af, bfr, acc, 0, 0, 0); }
#pragma unroll
        for (int i = 0; i < 4; ++i) REMP[((size_t)ks * 8 + i + 4 * h) * 1024 + nt * 32 + r] = acc[i];
    }
}

DI void p4_combine(const Args& a, int tid, int bid, int G) {
    unsigned char* ws = a.ws;
    const bf16* PQ = (const bf16*)(ws + WS_PQ); const float* REMP = (const float*)(ws + WS_REMP); bf16* FN = (bf16*)(ws + WS_FN);
    const float scale = 0.0009756003f;
    const int gt = bid * NTHREADS + tid, NGT = G * NTHREADS;
    for (int ch = gt; ch < NREAL * 64; ch += NGT) {
        const int c8 = ch & 63, row = ch >> 6, b = row >> 13, s = row & 8191, l = s + 16, n = b * 512 + c8 * 8;
        float v[8];
        if (l >= 8200) { const int rho = l - 8200;
#pragma unroll
            for (int e = 0; e < 8; ++e) v[e] = 0.f;
            for (int ks = 0; ks < 65; ++ks) { const f32x4 p0 = *(const f32x4*)(REMP + ((size_t)ks * 8 + rho) * 1024 + n), p1 = *(const f32x4*)(REMP + ((size_t)ks * 8 + rho) * 1024 + n + 4);
                v[0] += p0[0]; v[1] += p0[1]; v[2] += p0[2]; v[3] += p0[3]; v[4] += p1[0]; v[5] += p1[1]; v[6] += p1[2]; v[7] += p1[3]; }
        } else {
            const bool mir = l > 4104; const int idx = (mir ? LSEQ - l : l) - 9; const float sg = mir ? 1.f : -1.f;
            const size_t off = (size_t)idx * 1024 + n;
            const v4u p0 = *(const v4u*)(PQ + off), p1 = *(const v4u*)(PQ + (size_t)4096 * 1024 + off), q0 = *(const v4u*)(PQ + (size_t)2 * 4096 * 1024 + off), q1 = *(const v4u*)(PQ + (size_t)3 * 4096 * 1024 + off);
            const unsigned pp0[4] = {p0.x, p0.y, p0.z, p0.w}, pp1[4] = {p1.x, p1.y, p1.z, p1.w}, qq0[4] = {q0.x, q0.y, q0.z, q0.w}, qq1[4] = {q1.x, q1.y, q1.z, q1.w};
#pragma unroll
            for (int e = 0; e < 4; ++e) {
                v[2 * e] = (bf2f(pp0[e] & 0xffffu) + bf2f(pp1[e] & 0xffffu)) + sg * (bf2f(qq0[e] & 0xffffu) + bf2f(qq1[e] & 0xffffu));
                v[2 * e + 1] = (bf2f(pp0[e] >> 16) + bf2f(pp1[e] >> 16)) + sg * (bf2f(qq0[e] >> 16) + bf2f(qq1[e] >> 16)); }
        }
        v4u o; o.x = pk2(v[0] * scale, v[1] * scale); o.y = pk2(v[2] * scale, v[3] * scale); o.z = pk2(v[4] * scale, v[5] * scale); o.w = pk2(v[6] * scale, v[7] * scale);
        *(v4u*)(FN + (size_t)row * 512 + c8 * 8) = o;
    }
}

DI void p6_post(const Args& a, int lane, int wave, int bid, int G) {
    unsigned char* ws = a.ws;
    const bf16* OF = (const bf16*)(ws + WS_OF); const bf16* OB = (const bf16*)((unsigned char*)a.out + DO_OB); bf16* ON = (bf16*)(ws + WS_ON);
    const int gw = bid * NWAVES + wave, NGW = G * NWAVES;
    const int c0 = lane * 16;
    float gn[16];
#pragma unroll
    for (int e = 0; e < 16; ++e) gn[e] = a.gla_norm[(c0 & 255) + e];
    for (int row = gw; row < NREAL; row += NGW) {
        const size_t off = (size_t)row * 1024 + c0;
        const v4u f0 = *(const v4u*)(OF + off), f1 = *(const v4u*)(OF + off + 8), b0 = *(const v4u*)(OB + off), b1 = *(const v4u*)(OB + off + 8);
        const unsigned fw[8] = {f0.x, f0.y, f0.z, f0.w, f1.x, f1.y, f1.z, f1.w}, bw[8] = {b0.x, b0.y, b0.z, b0.w, b1.x, b1.y, b1.z, b1.w};
        float v[16]; float ss = 0.f;
#pragma unroll
        for (int e = 0; e < 8; ++e) { v[2 * e] = bf2f(fw[e] & 0xffffu) + bf2f(bw[e] & 0xffffu); v[2 * e + 1] = bf2f(fw[e] >> 16) + bf2f(bw[e] >> 16); ss += v[2 * e] * v[2 * e] + v[2 * e + 1] * v[2 * e + 1]; }
        ss += __shfl_xor(ss, 1); ss += __shfl_xor(ss, 2); ss += __shfl_xor(ss, 4); ss += __shfl_xor(ss, 8);
        const float rstd = 1.f / sqrtf(ss * (1.f / 256.f) + 1e-6f);
        unsigned w[8];
#pragma unroll
        for (int e = 0; e < 8; ++e) w[e] = pk2(v[2 * e] * rstd * gn[2 * e], v[2 * e + 1] * rstd * gn[2 * e + 1]);
        *(v4u*)(ON + off) = (v4u){w[0], w[1], w[2], w[3]}; *(v4u*)(ON + off + 8) = (v4u){w[4], w[5], w[6], w[7]};
    }
}

DI void p11_final(const Args& a, int lane, int wave, int bid, int G) {
    const int gw = bid * NWAVES + wave, NGW = G * NWAVES;
    for (int row = gw; row < NREAL; row += NGW) {
        f32x4* xr = (f32x4*)(a.out + (size_t)row * D) + lane; const f32x4* gr = (const f32x4*)a.norm_final + lane;
        f32x4 v[4]; float s = 0.f;
#pragma unroll
        for (int j = 0; j < 4; ++j) { v[j] = xr[64 * j]; s += (v[j].x * v[j].x + v[j].y * v[j].y) + (v[j].z * v[j].z + v[j].w * v[j].w); }
        const float rstd = 1.f / sqrtf(wave_sum(s) * (1.f / 1024.f) + 1e-6f);
#pragma unroll
        for (int j = 0; j < 4; ++j) { const f32x4 g = gr[64 * j]; xr[64 * j] = (f32x4){v[j].x * rstd * g.x, v[j].y * rstd * g.y, v[j].z * rstd * g.z, v[j].w * rstd * g.w}; }
    }
}
DI float logsig(float x) { return fminf(x, 0.f) - __logf(1.f + __expf(-fabsf(x))); }
DI size_t tile_idx(int dir, int b, int h, int c) { return (size_t)((dir * 2 + b) * 4 + h) * NCHUNK + c; }
DI void p4_gla_prep(const Args& a, LAS unsigned char* lds, int tid, int lane, int wave, int bid, int G) {
    unsigned char* ws = a.ws;
    const bf16* Qg = (const bf16*)((unsigned char*)a.out + DO_Q); const bf16* Kg = (const bf16*)(ws + WS_K); const bf16* Vg = (const bf16*)((unsigned char*)a.out + DO_V);
    const float* Rg = (const float*)(ws + WS_R);
    unsigned char* REC = ws + WS_REC; bf16* VT = (bf16*)(ws + WS_VT);
    LAS float* BF = (LAS float*)lds; LAS float* BB = BF + 64 * 128;
    LAS unsigned char* QF = lds + 65536; LAS unsigned char* KF = QF + 17408; LAS unsigned char* QB = KF + 17408; LAS unsigned char* KB = QB + 17408;
    LAS unsigned char* KRAW = lds + 135168;
    LAS float* RS = (LAS float*)QF; LAS float* WD = RS + 64 * 32;
    LAS unsigned char* VS = lds;
    for (int task = bid; task < 2 * NCHUNK * 4; task += G) {
        const int h = task & 3, c = (task >> 2) % NCHUNK, b = (task >> 2) / NCHUNK;
        const int row0 = (c == 0) ? NREAL : b * 8192 + 64 * (c - 1);
        for (int idx = tid; idx < 64 * 32; idx += NTHREADS) RS[idx] = Rg[(size_t)(row0 + (idx >> 5)) * 32 + (idx & 31)];
        for (int idx = tid; idx < 2 * 16 * 128; idx += NTHREADS) { const int dir = idx >> 11, j = (idx >> 7) & 15, d = idx & 127; WD[idx] = (dir ? a.wdb : a.wdf)[j * 512 + h * 128 + d]; }
        __syncthreads();
        {
            const int d = tid & 127, part = tid >> 7; const float bfw = a.bdf[h * 128 + d], bbw = a.bdb[h * 128 + d];
            for (int ii = 0; ii < 16; ++ii) { const int i = part * 16 + ii; float lf = bfw, lb = bbw;
#pragma unroll
                for (int j = 0; j < 16; ++j) { lf += RS[i * 32 + j] * WD[j * 128 + d]; lb += RS[i * 32 + 16 + j] * WD[2048 + j * 128 + d]; }
                float laf = logsig(lf) * 0.0625f, lab = logsig(lb) * 0.0625f;
                if (c == 0 && i < 48) { laf = 0.f; lab = 0.f; }
                BF[i * 128 + d] = laf; BB[i * 128 + d] = lab; }
        }
        __syncthreads();
        if (tid < 128) { float s = 0.f; for (int i = 0; i < 64; ++i) { s += BF[i * 128 + tid]; BF[i * 128 + tid] = s; } ((float*)(REC + tile_idx(0, b, h, c) * REC_BYTES + REC_DEC))[tid] = __expf(s); }
        else if (tid < 256) { const int d = tid - 128; float s = 0.f; for (int i = 63; i >= 0; --i) { s += BB[i * 128 + d]; BB[i * 128 + d] = s; } ((float*)(REC + tile_idx(1, b, h, c) * REC_BYTES + REC_DEC))[d] = __expf(s); }
        __syncthreads();
        for (int rep = 0; rep < 2; ++rep) {
            const int g = tid + NTHREADS * rep, i = g >> 4, d0 = (g & 15) * 8;
            const v4u q8 = *(const v4u*)(Qg + (size_t)(row0 + i) * 512 + h * 128 + d0), k8 = *(const v4u*)(Kg + (size_t)(row0 + i) * 512 + h * 128 + d0);
            const unsigned qw[4] = {q8.x, q8.y, q8.z, q8.w}, kw[4] = {k8.x, k8.y, k8.z, k8.w};
            float qf[8], kf[8], qb[8], kb[8], qif[8], qib[8];
#pragma unroll
            for (int e = 0; e < 8; ++e) {
                const int d = d0 + e; const float q = bf2f((e & 1) ? (qw[e >> 1] >> 16) : (qw[e >> 1] & 0xffffu)), k = bf2f((e & 1) ? (kw[e >> 1] >> 16) : (kw[e >> 1] & 0xffffu));
                const float ef = BF[i * 128 + d], eb = BB[i * 128 + d], f31 = BF[31 * 128 + d], b32 = BB[32 * 128 + d];
                qf[e] = q * __expf(ef - f31); kf[e] = k * __expf(f31 - ef); qb[e] = q * __expf(eb - b32); kb[e] = k * __expf(b32 - eb);
                qif[e] = q * __expf(ef); qib[e] = q * __expf(eb);
            }
            *(LAS v4u*)(QF + i * 272 + d0 * 2) = (v4u){pk2(qf[0], qf[1]), pk2(qf[2], qf[3]), pk2(qf[4], qf[5]), pk2(qf[6], qf[7])};
            *(LAS v4u*)(KF + i * 272 + d0 * 2) = (v4u){pk2(kf[0], kf[1]), pk2(kf[2], kf[3]), pk2(kf[4], kf[5]), pk2(kf[6], kf[7])};
            *(LAS v4u*)(QB + i * 272 + d0 * 2) = (v4u){pk2(qb[0], qb[1]), pk2(qb[2], qb[3]), pk2(qb[4], qb[5]), pk2(qb[6], qb[7])};
            *(LAS v4u*)(KB + i * 272 + d0 * 2) = (v4u){pk2(kb[0], kb[1]), pk2(kb[2], kb[3]), pk2(kb[4], kb[5]), pk2(kb[6], kb[7])};
            *(LAS v4u*)(KRAW + i * 256 + d0 * 2) = k8;
            const int kap = d0 >> 5, u = (d0 & 31) >> 3, pc = 32 * kap + 16 * (u & 1) + 4 * (u >> 1);
            bf16* qi_f = (bf16*)(REC + tile_idx(0, b, h, c) * REC_BYTES) + i * 128 + pc; bf16* qi_b = (bf16*)(REC + tile_idx(1, b, h, c) * REC_BYTES) + i * 128 + pc;
            *(v2u*)qi_f = (v2u){pk2(qif[0], qif[1]), pk2(qif[2], qif[3])}; *(v2u*)(qi_f + 8) = (v2u){pk2(qif[4], qif[5]), pk2(qif[6], qif[7])};
            *(v2u*)qi_b = (v2u){pk2(qib[0], qib[1]), pk2(qib[2], qib[3])}; *(v2u*)(qi_b + 8) = (v2u){pk2(qib[4], qib[5]), pk2(qib[6], qib[7])};
        }
        __syncthreads();
        {
            const int dir = wave >> 2, tq = wave & 3, fr = lane & 15, g = lane >> 4;
            const LAS unsigned char* QX = dir ? QB : QF; const LAS unsigned char* KX = dir ? KB : KF;
            bf16x8 bq[4];
#pragma unroll
            for (int kap = 0; kap < 4; ++kap) bq[kap] = *(const LAS bf16x8*)(QX + (16 * tq + fr) * 272 + (32 * kap + 8 * g) * 2);
            bf16* pm = (bf16*)(REC + tile_idx(dir, b, h, c) * REC_BYTES + REC_PM);
            const int i = 16 * tq + fr;
#pragma unroll
            for (int tk = 0; tk < 4; ++tk) {
                f32x4 acc = {0.f, 0.f, 0.f, 0.f};
#pragma unroll
                for (int kap = 0; kap < 4; ++kap) { const bf16x8 af = *(const LAS bf16x8*)(KX + (16 * tk + fr) * 272 + (32 * kap + 8 * g) * 2);
                    acc = __builtin_amdgcn_mfma_f32_16x16x32_bf16(af, bq[kap], acc, 0, 0, 0); }
                float s[4];
#pragma unroll
                for (int e = 0; e < 4; ++e) { const int j = 16 * tk + 4 * g + e; const bool keep = dir ? (j >= i) : (j <= i); s[e] = keep ? acc[e] : 0.f; }
                *(v2u*)(pm + i * 64 + 16 * tk + 4 * g) = (v2u){pk2(s[0], s[1]), pk2(s[2], s[3])};
            }
        }
        {
            const int d = tid & 127, blk = tid >> 7, i0 = blk * 16;
            const float f63 = BF[63 * 128 + d], b0 = BB[d];
            unsigned wf[8], wb[8];
#pragma unroll
            for (int e2 = 0; e2 < 8; ++e2) {
                const int ia = i0 + 2 * e2, ib = ia + 1;
                const float ka = bf2f((unsigned)*(const LAS unsigned short*)(KRAW + ia * 256 + d * 2)), kb2 = bf2f((unsigned)*(const LAS unsigned short*)(KRAW + ib * 256 + d * 2));
                wf[e2] = pk2(ka * __expf(f63 - BF[ia * 128 + d]), kb2 * __expf(f63 - BF[ib * 128 + d]));
                wb[e2] = pk2(ka * __expf(b0 - BB[ia * 128 + d]), kb2 * __expf(b0 - BB[ib * 128 + d]));
            }
            bf16* kf_ = (bf16*)(REC + tile_idx(0, b, h, c) * REC_BYTES + REC_KDT) + d * 64 + i0; bf16* kb_ = (bf16*)(REC + tile_idx(1, b, h, c) * REC_BYTES + REC_KDT) + d * 64 + i0;
            *(v4u*)kf_ = (v4u){wf[0], wf[1], wf[2], wf[3]}; *(v4u*)(kf_ + 8) = (v4u){wf[4], wf[5], wf[6], wf[7]};
            *(v4u*)kb_ = (v4u){wb[0], wb[1], wb[2], wb[3]}; *(v4u*)(kb_ + 8) = (v4u){wb[4], wb[5], wb[6], wb[7]};
        }
        __syncthreads();
        for (int rep = 0; rep < 4; ++rep) { const int idx = tid + NTHREADS * rep, i = idx >> 5, u = idx & 31;
            *(LAS v4u*)(VS + i * 528 + u * 16) = *(const v4u*)(Vg + (size_t)(row0 + i) * 1024 + h * 256 + u * 8); }
        __syncthreads();
        {
            const int dv = tid & 255, half = tid >> 8; unsigned w[16];
#pragma unroll
            for (int e2 = 0; e2 < 16; ++e2) { const int ia = 32 * half + 2 * e2;
                w[e2] = (unsigned)*(const LAS unsigned short*)(VS + ia * 528 + dv * 2) | ((unsigned)*(const LAS unsigned short*)(VS + (ia + 1) * 528 + dv * 2) << 16); }
            bf16* vt = VT + ((size_t)(b * 4 + h) * NCHUNK + c) * 16384 + dv * 64 + 32 * half;
#pragma unroll
            for (int q4 = 0; q4 < 4; ++q4) *(v4u*)(vt + 8 * q4) = (v4u){w[4 * q4], w[4 * q4 + 1], w[4 * q4 + 2], w[4 * q4 + 3]};
        }
        __syncthreads();
    }
}

constexpr int SC_QI = 0, SC_KDT = 17408, SC_PM = 35840, SC_DEC = 45056, SC_VT = 45568, SC_BUF = 47872, SC_SA = 3 * SC_BUF, SC_NCH = 2720, SC_IT = 22;
DI void scan_load(v4u (&r)[SC_IT], const unsigned char* rec, const unsigned char* vt, int pl) {
#pragma unroll
    for (int it = 0; it < SC_IT - 1; ++it) r[it] = *(const v4u*)(rec + pl * 16 + it * 2048);
    r[SC_IT - 1] = *(const v4u*)(vt + pl * 16);
}
DI void scan_store(LAS unsigned char* buf, const v4u (&r)[SC_IT], int pl) {
#pragma unroll
    for (int it = 0; it < SC_IT - 1; ++it) { const int cid = pl + 128 * it;
        int dst;
        if (cid < 1024) dst = SC_QI + (cid >> 4) * 272 + (cid & 15) * 16;
        else if (cid < 2048) { const int x = cid - 1024; dst = SC_KDT + (x >> 3) * 144 + (x & 7) * 16; }
        else if (cid < 2560) { const int x = cid - 2048; dst = SC_PM + (x >> 3) * 144 + (x & 7) * 16; }
        else dst = SC_DEC + (cid - 2560) * 16;
        if (cid < 2592) *(LAS v4u*)(buf + dst) = r[it]; }
    *(LAS v4u*)(buf + SC_VT + (pl >> 3) * 144 + (pl & 7) * 16) = r[SC_IT - 1];
}
DI void p5_scan(const Args& a, LAS unsigned char* lds, int tid, int lane, int wave, int bid, int G) {
    unsigned char* ws = a.ws;
    const unsigned char* REC = ws + WS_REC; const unsigned char* VT = ws + WS_VT;
    for (int item = bid; item < 256; item += G) {
        const int sl = item & 15, dir = (item >> 4) & 1, h = (item >> 5) & 3, b = item >> 7;
        bf16* O = dir ? (bf16*)((unsigned char*)a.out + DO_OB) : (bf16*)(ws + WS_OF);
        const size_t t0 = tile_idx(dir, b, h, 0); const size_t v0i = (size_t)(b * 4 + h) * NCHUNK;
        const int fr = lane & 15, g = lane >> 4;
#define SCAN_SRC(step) REC + (t0 + (dir ? 128 - (step) : (step))) * REC_BYTES, VT + (v0i + (dir ? 128 - (step) : (step))) * 32768 + sl * 2048
        const bool loader = (wave >= 1 && wave <= 6);
        const int pr = (wave - 1) >> 1, pl = ((wave - 1) & 1) * 64 + lane;
        v4u r[SC_IT];
        __syncthreads();
        if (loader) { scan_load(r, SCAN_SRC(pr), pl); scan_store(lds + pr * SC_BUF, r, pl); scan_load(r, SCAN_SRC(pr + 3), pl); }
        if (wave == 0) *(LAS v4u*)(lds + SC_SA + 4096 + lane * 16) = (v4u){0u, 0u, 0u, 0u}, *(LAS v4u*)(lds + SC_SA + 4096 + 1024 + lane * 16) = (v4u){0u, 0u, 0u, 0u},
                       *(LAS v4u*)(lds + SC_SA + 4096 + 2048 + lane * 16) = (v4u){0u, 0u, 0u, 0u}, *(LAS v4u*)(lds + SC_SA + 4096 + 3072 + lane * 16) = (v4u){0u, 0u, 0u, 0u};
        __syncthreads();
        if (wave == 0) {
#pragma unroll 1
            for (int s = 0; s < NCHUNK; ++s) {
                LAS unsigned char* cur = lds + (s % 3) * SC_BUF;
                const int cs = dir ? 128 - s : s;
                const LAS unsigned char* sap = lds + SC_SA + ((s + 1) & 1) * 4096 + lane * 16;
                bf16x8 sa[4], vf[2];
#pragma unroll
                for (int kap = 0; kap < 4; ++kap) sa[kap] = *(const LAS bf16x8*)(sap + kap * 1024);
#pragma unroll
                for (int kp = 0; kp < 2; ++kp) vf[kp] = *(const LAS bf16x8*)(cur + SC_VT + fr * 144 + (32 * kp + 8 * g) * 2);
#pragma unroll
                for (int t = 0; t < 4; ++t) {
                    f32x4 o = {0.f, 0.f, 0.f, 0.f};
#pragma unroll
                    for (int kap = 0; kap < 4; ++kap) { const bf16x8 qf = *(const LAS bf16x8*)(cur + SC_QI + (16 * t + fr) * 272 + (32 * kap + 8 * g) * 2);
                        o = __builtin_amdgcn_mfma_f32_16x16x32_bf16(sa[kap], qf, o, 0, 0, 0); }
#pragma unroll
                    for (int kp = 0; kp < 2; ++kp) { const bf16x8 pf = *(const LAS bf16x8*)(cur + SC_PM + (16 * t + fr) * 144 + (32 * kp + 8 * g) * 2);
                        o = __builtin_amdgcn_mfma_f32_16x16x32_bf16(vf[kp], pf, o, 0, 0, 0); }
                    if (cs != 0) { const size_t row = (size_t)b * 8192 + 64 * (cs - 1) + 16 * t + fr;
                        *(v2u*)(O + row * 1024 + h * 256 + 16 * sl + 4 * g) = (v2u){cvtpk(o[0], o[1]), cvtpk(o[2], o[3])}; }
                }
                __syncthreads();
            }
        } else if (wave == 7) {
            f32x4 S[8];
#pragma unroll
            for (int j = 0; j < 8; ++j) S[j] = (f32x4){0.f, 0.f, 0.f, 0.f};
#pragma unroll 1
            for (int s = 0; s < NCHUNK; ++s) {
                LAS unsigned char* cur = lds + (s % 3) * SC_BUF;
                bf16x8 vf[2];
#pragma unroll
                for (int kp = 0; kp < 2; ++kp) vf[kp] = *(const LAS bf16x8*)(cur + SC_VT + fr * 144 + (32 * kp + 8 * g) * 2);
#pragma unroll
                for (int j = 0; j < 8; ++j) { const f32x4 dc = *(const LAS f32x4*)(cur + SC_DEC + (16 * j + 4 * g) * 4); S[j] = S[j] * dc; }
#pragma unroll
                for (int j = 0; j < 8; ++j)
#pragma unroll
                    for (int kp = 0; kp < 2; ++kp) { const bf16x8 kf = *(const LAS bf16x8*)(cur + SC_KDT + (16 * j + fr) * 144 + (32 * kp + 8 * g) * 2);
                        S[j] = __builtin_amdgcn_mfma_f32_16x16x32_bf16(kf, vf[kp], S[j], 0, 0, 0); }
                LAS unsigned char* sap = lds + SC_SA + (s & 1) * 4096 + lane * 16;
#pragma unroll
                for (int kap = 0; kap < 4; ++kap) { const f32x4 lo = S[2 * kap], hi = S[2 * kap + 1];
                    *(LAS v4u*)(sap + kap * 1024) = (v4u){cvtpk(lo[0], lo[1]), cvtpk(lo[2], lo[3]), cvtpk(hi[0], hi[1]), cvtpk(hi[2], hi[3])}; }
                __syncthreads();
            }
        } else {
#pragma unroll 1
            for (int s = 0; s < NCHUNK; ++s) {
                if (s >= 1 && s + 2 < NCHUNK && (s + 2) % 3 == pr) { __builtin_amdgcn_s_sleep(6); scan_store(lds + ((s + 2) % 3) * SC_BUF, r, pl); if (s + 5 < NCHUNK) scan_load(r, SCAN_SRC(s + 5), pl); }
                __syncthreads();
            }
        }
#undef SCAN_SRC
    }
}
constexpr size_t WS_BAR = 68 * MiB + 256 * 1024;
#define XB_TMO      128
#define XB_XCNT(j)  (256  + 64 * (j))
#define XB_XSUB(j)  (1280 + 64 * (j))
#define XB_XGEN(j)  (2304 + 64 * (j))
#define XB_TOP      3328
#define XB_TOPGEN   3392
#define XCD_BAR_WORDS 3456
#define XB_SPIN_CAP (1u << 18)

__device__ __forceinline__ unsigned xb_ld(unsigned* p)              { return __hip_atomic_load(p, __ATOMIC_RELAXED, __HIP_MEMORY_SCOPE_AGENT); }
__device__ __forceinline__ unsigned xb_add(unsigned* p, unsigned v) { return __hip_atomic_fetch_add(p, v, __ATOMIC_RELAXED, __HIP_MEMORY_SCOPE_AGENT); }
__device__ __forceinline__ unsigned xb_xcc_id() { return (unsigned)__builtin_amdgcn_s_getreg((3 << 11) | 20) & 0xFu; }
#define XB_SPIN(cond, bar) do { unsigned _sp = 0; while (cond) { __builtin_amdgcn_s_sleep(1); \
    if ((++_sp & 255u) == 0u) { if (xb_ld(&(bar)[XB_TMO])) break; if (_sp > XB_SPIN_CAP) { atomicAdd(&(bar)[XB_TMO], 1u); break; } } } } while (0)

struct XcdBarrier {
    unsigned* bar; unsigned x;
    volatile LAS unsigned* st;
};

__device__ __forceinline__ XcdBarrier xcd_barrier_post(unsigned* bar, volatile LAS unsigned* st) {
    XcdBarrier b; b.bar = bar; b.x = xb_xcc_id(); b.st = st;
    if (threadIdx.x == 0) (void)xb_add(&bar[XB_XCNT(b.x)], 1u);
    return b;
}
__device__ __forceinline__ void xcd_barrier_complete(unsigned* bar, unsigned x, unsigned& nloc, unsigned& nx) {
    const unsigned G = gridDim.x * gridDim.y * gridDim.z;
    unsigned sum, cnt, mine, sp = 0u;
    for (;;) {
        sum = 0u; cnt = 0u; mine = 0u;
#pragma unroll
        for (unsigned j = 0; j < 16; ++j) { const unsigned c = xb_ld(&bar[XB_XCNT(j)]); sum += c; cnt += (c > 0u) ? 1u : 0u; mine = (j == x) ? c : mine; }
        if (sum == G) break;
        __builtin_amdgcn_s_sleep(1);
        if ((++sp & 255u) == 0u) { if (xb_ld(&bar[XB_TMO])) break; if (sp > XB_SPIN_CAP) { atomicAdd(&bar[XB_TMO], 1u); break; } }
    }
    nloc = mine > 0u ? mine : 1u; nx = cnt > 0u ? cnt : 1u;
}

__device__ __forceinline__ void xcd_barrier(const XcdBarrier& b) {
    asm volatile("s_waitcnt vmcnt(0)" ::: "memory");
    __syncthreads();
    if (threadIdx.x == 0) {
        unsigned* bar = b.bar;
        __builtin_amdgcn_s_waitcnt(0);
        unsigned nloc = b.st[0], nx = b.st[1];
        if (nloc == 0u) { xcd_barrier_complete(bar, b.x, nloc, nx); b.st[0] = nloc; b.st[1] = nx; }
        const unsigned old = xb_add(&bar[XB_XSUB(b.x)], 1u);
        const unsigned gen = old / nloc;
        if (old + 1u == (gen + 1u) * nloc) {
            __builtin_amdgcn_fence(__ATOMIC_RELEASE, "agent");
            asm volatile("s_waitcnt vmcnt(0)" ::: "memory");
            const unsigned og = xb_add(&bar[XB_TOP], 1u);
            const unsigned tg = og / nx;
            if (og + 1u == (tg + 1u) * nx) xb_add(&bar[XB_TOPGEN], 1u);
            else XB_SPIN(xb_ld(&bar[XB_TOPGEN]) == tg, bar);
            __builtin_amdgcn_fence(__ATOMIC_ACQUIRE, "agent");
            xb_add(&bar[XB_XGEN(b.x)], 1u);
            asm volatile("s_waitcnt vmcnt(0)" ::: "memory");
        } else {
            XB_SPIN(xb_ld(&bar[XB_XGEN(b.x)]) == gen, bar);
            __builtin_amdgcn_fence(__ATOMIC_ACQUIRE, "agent");
            asm volatile("s_waitcnt vmcnt(0)" ::: "memory");
        }
    }
    __syncthreads();
}

#ifndef ONE_LAUNCH
#define ONE_LAUNCH 1
#endif
constexpr int NPH = 13;
__global__ void __launch_bounds__(NTHREADS, 2) fwd_kernel(Args a) {
    extern __shared__ __attribute__((aligned(16))) unsigned char lds_raw[];
    LAS unsigned char* lds = (LAS unsigned char*)lds_raw;
    const int tid = threadIdx.x, lane = tid & 63, wave = __builtin_amdgcn_readfirstlane(tid >> 6), bid = blockIdx.x, G = gridDim.x;
    unsigned char* ws = a.ws;
    const int lo = a.ph_lo, hi = a.ph_hi;
    volatile LAS unsigned* bst = (volatile LAS unsigned*)(lds + LDS_BYTES - 16);
    if (tid < 2) bst[tid] = 0u;
    __syncthreads();
    XcdBarrier xbar = xcd_barrier_post((unsigned*)(a.ws + WS_BAR), bst);
    const int vb = (G == 256) ? (bid & 7) * 32 + (bid >> 3) : bid;
#define IN(k) (lo <= (k) && (k) < hi)
#define SEAM(k) do { if (IN(k) && IN((k) + 1)) { if ((k) == 0) cg::this_grid().sync(); else xcd_barrier(xbar); } } while (0)
    pg8::EP ep;
    ep.Q = (bf16*)((unsigned char*)a.out + DO_Q); ep.K = (bf16*)(ws + WS_K); ep.V = (bf16*)((unsigned char*)a.out + DO_V); ep.R = (float*)(ws + WS_R);
    ep.GT2 = (bf16*)(ws + WS_GT2); ep.PQ = (bf16*)(ws + WS_PQ); ep.SGA = (bf16*)(ws + WS_SGA); ep.SGF = (bf16*)(ws + WS_SGF); ep.ON = (bf16*)(ws + WS_ON);
    ep.OG = (bf16*)(ws + WS_OG); ep.MG = (bf16*)(ws + WS_MG); ep.H1B = (bf16*)(ws + WS_H1B); ep.HF = (bf16*)(ws + WS_HF);
    ep.x = a.x; ep.H = a.out; ep.PART1 = (float*)(ws + WS_PART1); ep.gnorm = a.gla_norm;
    const bf16* ALL = (const bf16*)(ws + WS_ALL);

    if (IN(0)) { p0_prologue(a, lds, tid, lane, wave, bid, G); }
    SEAM(0);
    if (IN(1)) { pg8::Gemm g{ALL, ALL, 0, 0, 1024}; pg8::Sched S{1, 845, G, vb, 0, 0, 0}; pg8::Epi<1> E{ep};
        pg8::gemm_phase<pg8::Epi<1>, pg8::Sched, true, true>(lds, g, S, E); }
    SEAM(1);
    if (IN(2)) { p2_sym_rem(a, tid, lane, wave, bid, G); }
    SEAM(2);
    if (IN(3)) { pg8::Gemm g{(const bf16*)(ws + WS_CS), (const bf16*)(ws + WS_EOT), 0, 0, KH}; pg8::Sched S{2, 256, G, vb, 0, 0, 0}; pg8::Epi<2> E{ep};
        pg8::gemm_phase<pg8::Epi<2>, pg8::Sched, true, true>(lds, g, S, E); }
    SEAM(3);
    if (IN(4)) { p4_gla_prep(a, lds, tid, lane, wave, bid, G); p4_combine(a, tid, bid, G); }
    SEAM(4);
    if (IN(5)) { p5_scan(a, lds, tid, lane, wave, vb, G); }
    SEAM(5);
    if (IN(6)) { p6_post(a, lane, wave, bid, G);
        pg8::Gemm g{ALL, ALL, 0, 0, 1024}; pg8::Sched S{3, 512, G, vb, 8, 0, 82}; pg8::Epi<3> E{ep};
        pg8::gemm_phase<pg8::Epi<3>, pg8::Sched, true, true>(lds, g, S, E); }
    SEAM(6);
    if (IN(7)) {
        { pg8::Gemm g{ALL, ALL, 0, 0, 1024}; pg8::Sched S{3, 256, G, vb, 4, 0, 78}; pg8::Epi<4> E{ep};
          pg8::gemm_phase<pg8::Epi<4>, pg8::Sched, true, true>(lds, g, S, E); }
        { pg8::Gemm g{(const bf16*)(ws + WS_FN), (const bf16*)(ws + WS_WFT), 0, 0, 512}; pg8::Sched S{3, 256, G, vb, 4, 0, 0}; pg8::Epi<5> E{ep};
          pg8::gemm_phase<pg8::Epi<5>, pg8::Sched, true, true>(lds, g, S, E); }
    }
    SEAM(7);
    if (IN(8)) { pg8::Gemm g{(const bf16*)(ws + WS_OG), (const bf16*)(ws + WS_WOT), 0, 0, 1024}; pg8::Sched S{3, 256, G, vb, 4, 0, 0}; pg8::Epi<6> E{ep};
        pg8::gemm_phase<pg8::Epi<6>, pg8::Sched, true, true>(lds, g, S, E); }
    SEAM(8);
    if (IN(9)) { pg8::Gemm g{(const bf16*)(ws + WS_MG), (const bf16*)(ws + WS_WOUTT), 0, 0, 1024}; pg8::Sched S{3, 256, G, vb, 4, 0, 0}; pg8::Epi<7> E{ep};
        pg8::gemm_phase<pg8::Epi<7>, pg8::Sched, true, true>(lds, g, S, E); }
    SEAM(9);
    if (IN(10)) { pg8::Gemm g{(const bf16*)(ws + WS_H1B), (const bf16*)(ws + WS_W1T), 0, 0, 1024}; pg8::Sched S{3, 1024, G, vb, 16, 0, 0}; pg8::Epi<8> E{ep};
        pg8::gemm_phase<pg8::Epi<8>, pg8::Sched, true, true>(lds, g, S, E); }
    SEAM(10);
    if (IN(11)) { pg8::Gemm g{(const bf16*)(ws + WS_HF), (const bf16*)(ws + WS_W2T), 0, 0, 4096}; pg8::Sched S{3, 256, G, vb, 4, 0, 0}; pg8::Epi<9> E{ep};
        pg8::gemm_phase<pg8::Epi<9>, pg8::Sched, true, true>(lds, g, S, E); }
    SEAM(11);
    if (IN(12)) { p11_final(a, lane, wave, bid, G); }
#ifdef PROBE_REP
    if (IN(13)) { pg8::Gemm g{(const bf16*)(ws + WS_HF), (const bf16*)(ws + WS_W2T), 0, 0, 4096}; pg8::Sched S{3, 256, G, vb, 4, 0, 0}; pg8::Epi<10> E{ep};
        pg8::gemm_phase<pg8::Epi<10>, pg8::Sched, true, true>(lds, g, S, E); }
    if (IN(14)) { const int gw = bid * NWAVES + wave, NGW = G * NWAVES;
        for (int row = gw; row < NREAL; row += NGW) { f32x4* xr = (f32x4*)(a.out + (size_t)row * D) + lane; float s = 0.f;
            for (int j = 0; j < 4; ++j) { const f32x4 v = xr[64 * j]; s += v.x + v.y + v.z + v.w; }
            if (wave_sum(s) == 123456.789f) xr[0] = (f32x4){s, s, s, s}; } }
#endif
#undef IN
#undef SEAM
}

extern "C" void kernel_launch(void* const* d_in, const int* in_sizes, int n_in, void* d_out, int out_size, void* d_ws, size_t ws_size, hipStream_t stream) {
    static int grid = 0;
    if (grid == 0) {
        int dev = 0, cus = 0, per_cu = 0;
        (void)hipGetDevice(&dev); (void)hipDeviceGetAttribute(&cus, hipDeviceAttributeMultiprocessorCount, dev);
        (void)hipFuncSetAttribute((const void*)fwd_kernel, hipFuncAttributeMaxDynamicSharedMemorySize, LDS_BYTES);
        (void)hipOccupancyMaxActiveBlocksPerMultiprocessor(&per_cu, (const void*)fwd_kernel, NTHREADS, LDS_BYTES);
        (void)hipGetLastError();
        if (per_cu < 1) { fprintf(stderr, "kernel_launch: occupancy query says %d blocks/CU\n", per_cu); per_cu = 1; }
        grid = cus * 1;
        if (grid > 256) grid = 256;
    }
    (void)hipMemsetAsync((char*)d_ws + WS_BAR, 0, 16384, stream);
    Args a{};
    const float* const* in = (const float* const*)d_in;
    a.x = in[0]; a.meta = in[1]; a.norm_mix = in[2]; a.w_in = in[3]; a.wdf = in[4]; a.bdf = in[5]; a.wdb = in[6]; a.bdb = in[7]; a.gla_norm = in[8];
    a.w_o = in[9]; a.w_fnet = in[10]; a.w_out = in[11]; a.norm_ffn = in[12]; a.w_ff1 = in[13]; a.w_ff2 = in[14]; a.norm_final = in[15];
    a.out = (float*)d_out; a.ws = (unsigned char*)d_ws;
#if ONE_LAUNCH
    a.ph_lo = 0; a.ph_hi = NPH;
    void* args[] = {&a};
    hipError_t e = hipLaunchCooperativeKernel((const void*)fwd_kernel, dim3(grid), dim3(NTHREADS), args, LDS_BYTES, stream);
    if (e != hipSuccess) fprintf(stderr, "cooperative launch failed: %s (grid %d)\n", hipGetErrorString(e), grid);
#else
    for (int p = 0; p < NPH; ++p) { a.ph_lo = p; a.ph_hi = p + 1; hipLaunchKernelGGL(fwd_kernel, dim3(grid), dim3(NTHREADS), LDS_BYTES, stream, a);
#ifdef PROBE_REP
        if (p == PROBE_REP) for (int q = 0; q < PROBE_N; ++q) hipLaunchKernelGGL(fwd_kernel, dim3(grid), dim3(NTHREADS), LDS_BYTES, stream, a);
#ifdef PROBE_DRY
        if (p == PROBE_AFTER) { Args a2 = a; a2.ph_lo = PROBE_DRY; a2.ph_hi = PROBE_DRY + 1; for (int q = 0; q < PROBE_N; ++q) hipLaunchKernelGGL(fwd_kernel, dim3(grid), dim3(NTHREADS), LDS_BYTES, stream, a2); }
#endif
#endif
    }
#endif
}
```

```cpp
#include <hip/hip_runtime.h>
#include <hip/hip_cooperative_groups.h>
#include <cstdio>
#include <cstdint>
namespace cg = cooperative_groups;
namespace pg8 {
#define PG8_LAS __attribute__((address_space(3)))
typedef unsigned short bf16_t;
typedef short bf16x8 __attribute__((ext_vector_type(8)));
typedef float f32x4 __attribute__((ext_vector_type(4)));
typedef unsigned u32x4 __attribute__((ext_vector_type(4)));
constexpr int BM = 256, BK = 64, HALF = 128, HTB = HALF * BK * 2  , STAGE_BYTES = 8 * HTB, NXCD = 8, WGM = 8;

__host__ __device__ __forceinline__ int lds_byte(int r, int c) { const int st = (r >> 4) * 2 + (c >> 5), rr = r & 15, cc = c & 31, ob = rr * 64 + cc * 2; return st * 1024 + (ob ^ (((ob >> 9) & 1) << 5)); }
__host__ __device__ __forceinline__ void stage_rc(int b, int& R, int& C) { const int st = b / 1024, sb = b % 1024, swz = sb ^ (((sb >> 9) & 1) << 5); R = (st >> 1) * 16 + swz / 64; C = (st & 1) * 32 + (swz % 64) / 2; }
__host__ __device__ __forceinline__ int perm32(int rho) { const int n = rho >> 4, i = rho & 15; return 8 * (i >> 2) + 4 * n + (i & 3); }

struct Unit { int pm, pn; };
struct Gemm { const bf16_t* A; const bf16_t* Bt; int M, N, K; };

__device__ __forceinline__ unsigned cvt_pk_bf16(float lo, float hi) { unsigned r; asm volatile("v_cvt_pk_bf16_f32 %0, %1, %2" : "=v"(r) : "v"(lo), "v"(hi)); return r; }
__device__ __forceinline__ float bflo(unsigned w) { return __uint_as_float(w << 16); }
__device__ __forceinline__ float bfhi(unsigned w) { return __uint_as_float(w & 0xffff0000u); }

struct Sched {
    int mode, n, G, c, nN, offM, offN;
    __device__ __forceinline__ bool next(int i, Unit& u) const {
        const int L = i * G + c; if (L >= n) return false;
        if (mode == 1) {
            if (L < 585) { u.pm = L / 9; u.pn = 65 + L % 9; }
            else { const int l2 = L - 585; u.pm = 65 + 9 + (l2 & 3); u.pn = l2 >> 2; }
        } else if (mode == 2) {
            const int grp = L >> 6, r = L & 63; u.pm = grp * 16 + (r >> 2); u.pn = grp * 4 + (r & 3);
        } else {
            const int x = (L & 255) >> 5, ul = (L >> 8) * 32 + (L & 31);
            u.pm = 8 * x + (ul & 7) + offM; u.pn = (ul >> 3) + offN; }
        return true;
    }
    __device__ __forceinline__ void a_ready(const Unit&) const {}
    __device__ __forceinline__ void done(const Unit&) const {}
};

struct EP {
    bf16_t *Q, *K, *V; float* R; bf16_t* GT2; bf16_t* PQ; bf16_t *SGA, *SGF, *ON, *OG, *MG, *H1B, *HF;
    const float* x; float* H; float* PART1; const float* gnorm;
};
constexpr int LDG = 8320;
template <int MODE> struct Epi {
    static constexpr bool PERM = true, AFTER_DRAIN = false;
    EP p;
    __device__ __forceinline__ void operator()(const f32x4 (&acc)[2][2][4][2], const Unit& u, int wr, int wc, int fr, int fq) const {
#pragma unroll
        for (int ai = 0; ai < 2; ++ai)
#pragma unroll
            for (int m = 0; m < 4; ++m) {
                const int r = ai * HALF + wr * 64 + m * 16 + fr;
                float ss = 0.f;
                float rstd = 1.f;
                if (MODE == 8) { const float* pp = p.PART1 + (size_t)(u.pm * BM + r) * 16; float s = 0.f;
#pragma unroll
                    for (int t = 0; t < 4; ++t) { const f32x4 q4 = *(const f32x4*)(pp + 4 * t); s += (q4[0] + q4[1]) + (q4[2] + q4[3]); }
                    rstd = 1.0f / sqrtf(s * (1.0f / 1024.0f) + 1e-6f); }
#pragma unroll
                for (int bj = 0; bj < 2; ++bj) {
                    const int c = bj * HALF + wc * 32 + 8 * fq;
                    f32x4 v0 = acc[ai][bj][m][0], v1 = acc[ai][bj][m][1];
                    if (MODE == 1) {
                        if (u.pm < 65) {
                            const int t = u.pn - 65; const size_t row = (size_t)u.pm * BM + r;
                            if (t < 8) {
                                bf16_t* dst; float sc = 1.f;
                                if (t < 2) { dst = p.Q + row * 512 + t * 256 + c; sc = 0.08838834764831845f; }
                                else if (t < 4) dst = p.K + row * 512 + (t - 2) * 256 + c;
                                else dst = p.V + row * 1024 + (t - 4) * 256 + c;
                                u32x4 w; w.x = cvt_pk_bf16(v0[0] * sc, v0[1] * sc); w.y = cvt_pk_bf16(v0[2] * sc, v0[3] * sc); w.z = cvt_pk_bf16(v1[0] * sc, v1[1] * sc); w.w = cvt_pk_bf16(v1[2] * sc, v1[3] * sc);
                                *(u32x4*)dst = w;
                            } else if (c < 32) { float* dst = p.R + row * 32 + c; *(f32x4*)dst = v0; *(f32x4*)(dst + 4) = v1; }
                        } else {
                            const int gcol = (u.pm - 74) * BM + r, cs = gcol >> 9, col = gcol & 511;
                            u32x4 w; w.x = cvt_pk_bf16(v0[0], v0[1]); w.y = cvt_pk_bf16(v0[2], v0[3]); w.z = cvt_pk_bf16(v1[0], v1[1]); w.w = cvt_pk_bf16(v1[2], v1[3]);
                            if (u.pn < 64) { const int b = u.pn >> 5, l = 16 + (u.pn & 31) * 256 + c;
                                *(u32x4*)(p.GT2 + ((size_t)(b * 512 + col) * 2 + cs) * LDG + l) = w; }
                            else if (c == 48 || c == 56) { const int l = c - 48;
                                *(u32x4*)(p.GT2 + ((size_t)(col) * 2 + cs) * LDG + l) = w; *(u32x4*)(p.GT2 + ((size_t)(512 + col) * 2 + cs) * LDG + l) = w; }
                        }
                    } else if (MODE == 2) {
                        const int grp = u.pm >> 4; const size_t idx = (size_t)(u.pm & 15) * BM + r; const int n = (u.pn & 3) * BM + c;
                        u32x4 w; w.x = cvt_pk_bf16(v0[0], v0[1]); w.y = cvt_pk_bf16(v0[2], v0[3]); w.z = cvt_pk_bf16(v1[0], v1[1]); w.w = cvt_pk_bf16(v1[2], v1[3]);
                        *(u32x4*)(p.PQ + ((size_t)grp * 4096 + idx) * 1024 + n) = w;
                    } else if (MODE == 3) {
                        const int t = u.pn - 82; const size_t row = (size_t)u.pm * BM + r;
                        bf16_t* dst = (t < 4 ? p.SGA : p.SGF) + row * 1024 + (t & 3) * 256 + c;
                        float s[8];
#pragma unroll
                        for (int e = 0; e < 4; ++e) { s[e] = 1.f / (1.f + __expf(-v0[e])); s[4 + e] = 1.f / (1.f + __expf(-v1[e])); }
                        u32x4 w; w.x = cvt_pk_bf16(s[0], s[1]); w.y = cvt_pk_bf16(s[2], s[3]); w.z = cvt_pk_bf16(s[4], s[5]); w.w = cvt_pk_bf16(s[6], s[7]);
                        *(u32x4*)dst = w;
                    } else if (MODE == 4) {
                        const int t = u.pn - 78; const size_t off = ((size_t)u.pm * BM + r) * 1024 + t * 256 + c;
                        const u32x4 o = *(const u32x4*)(p.ON + off);
                        float s[8];
#pragma unroll
                        for (int e = 0; e < 4; ++e) { s[e] = v0[e] / (1.f + __expf(-v0[e])); s[4 + e] = v1[e] / (1.f + __expf(-v1[e])); }
                        u32x4 w; w.x = cvt_pk_bf16(s[0] * bflo(o.x), s[1] * bfhi(o.x)); w.y = cvt_pk_bf16(s[2] * bflo(o.y), s[3] * bfhi(o.y));
                        w.z = cvt_pk_bf16(s[4] * bflo(o.z), s[5] * bfhi(o.z)); w.w = cvt_pk_bf16(s[6] * bflo(o.w), s[7] * bfhi(o.w));
                        *(u32x4*)(p.OG + off) = w;
                    } else if (MODE == 5 || MODE == 6) {
                        const size_t off = ((size_t)u.pm * BM + r) * 1024 + u.pn * BM + c;
                        const u32x4 gt = *(const u32x4*)((MODE == 5 ? p.SGF : p.SGA) + off);
                        float s[8] = {v0[0] * bflo(gt.x), v0[1] * bfhi(gt.x), v0[2] * bflo(gt.y), v0[3] * bfhi(gt.y), v1[0] * bflo(gt.z), v1[1] * bfhi(gt.z), v1[2] * bflo(gt.w), v1[3] * bfhi(gt.w)};
                        if (MODE == 6) { const u32x4 mg = *(const u32x4*)(p.MG + off);
                            s[0] += bflo(mg.x); s[1] += bfhi(mg.x); s[2] += bflo(mg.y); s[3] += bfhi(mg.y); s[4] += bflo(mg.z); s[5] += bfhi(mg.z); s[6] += bflo(mg.w); s[7] += bfhi(mg.w); }
                        u32x4 w; w.x = cvt_pk_bf16(s[0], s[1]); w.y = cvt_pk_bf16(s[2], s[3]); w.z = cvt_pk_bf16(s[4], s[5]); w.w = cvt_pk_bf16(s[6], s[7]);
                        *(u32x4*)(p.MG + off) = w;
                    } else if (MODE == 7) {
                        const size_t off = ((size_t)u.pm * BM + r) * 1024 + u.pn * BM + c;
                        const f32x4 x0 = *(const f32x4*)(p.x + off), x1 = *(const f32x4*)(p.x + off + 4);
                        v0 = v0 + x0; v1 = v1 + x1;
                        u32x4 w; w.x = cvt_pk_bf16(v0[0], v0[1]); w.y = cvt_pk_bf16(v0[2], v0[3]); w.z = cvt_pk_bf16(v1[0], v1[1]); w.w = cvt_pk_bf16(v1[2], v1[3]);
                        *(u32x4*)(p.H1B + off) = w;
                        ss += (v0[0] * v0[0] + v0[1] * v0[1]) + (v0[2] * v0[2] + v0[3] * v0[3]) + (v1[0] * v1[0] + v1[1] * v1[1]) + (v1[2] * v1[2] + v1[3] * v1[3]);
                    } else if (MODE == 8) {
                        const size_t off = ((size_t)u.pm * BM + r) * 4096 + u.pn * BM + c;
                        float s[8];
#pragma unroll
                        for (int e = 0; e < 4; ++e) { float a = fmaxf(v0[e] * rstd, 0.f), b = fmaxf(v1[e] * rstd, 0.f); s[e] = a * a; s[4 + e] = b * b; }
                        u32x4 w; w.x = cvt_pk_bf16(s[0], s[1]); w.y = cvt_pk_bf16(s[2], s[3]); w.z = cvt_pk_bf16(s[4], s[5]); w.w = cvt_pk_bf16(s[6], s[7]);
                        *(u32x4*)(p.HF + off) = w;
                    } else if (MODE == 10) {
                        const size_t off = ((size_t)u.pm * BM + r) * 1024 + u.pn * BM + c;
                        const f32x4 x0 = *(const f32x4*)(p.H + off), x1 = *(const f32x4*)(p.H + off + 4);
                        if (v0[0] + x0[0] + x1[1] + v1[2] == 123456.789f) { *(f32x4*)(p.H + off) = v0 + x0; }
                    } else if (MODE == 9) {
                        const size_t off = ((size_t)u.pm * BM + r) * 1024 + u.pn * BM + c;
                        const u32x4 hb = *(const u32x4*)(p.H1B + off);
                        const f32x4 x0 = {bflo(hb.x), bfhi(hb.x), bflo(hb.y), bfhi(hb.y)}, x1 = {bflo(hb.z), bfhi(hb.z), bflo(hb.w), bfhi(hb.w)};
                        *(f32x4*)(p.H + off) = v0 + x0; *(f32x4*)(p.H + off + 4) = v1 + x1;
                    }
                }
                if (MODE == 7) { ss += __shfl_xor(ss, 16); ss += __shfl_xor(ss, 32);
                    if (fq == 0) p.PART1[(size_t)(u.pm * BM + r) * 16 + u.pn * 4 + wc] = ss; }
            }
    }
};
template <class Epi, class Sched, bool ALIGN_EPI = false, bool SP2 = false>
__device__ __forceinline__ void gemm_phase(PG8_LAS unsigned char* lds, const Gemm g, const Sched& S, const Epi& E) {
    const int tid = threadIdx.x, wid = __builtin_amdgcn_readfirstlane(tid >> 6), lane = tid & 63, wr = wid >> 2, wc = wid & 3, fr = lane & 15, fq = lane >> 4;
    const int K = g.K, nt = K / BK;
    unsigned voffA[2], voffB[2];
#pragma unroll
    for (int i = 0; i < 2; ++i) { int R, C; stage_rc(tid * 16 + i * 8192, R, C); const int Rb = Epi::PERM ? ((R & ~31) + perm32(R & 31)) : R;
        voffA[i] = (unsigned)(R * K + C) * 2u; voffB[i] = (unsigned)(Rb * K + C) * 2u; }
    const size_t kstep = (size_t)(BK * 2);
    const size_t hstep = (size_t)HALF * K * 2;
    const size_t tstep = 2 * hstep;
    const unsigned ldsw = (unsigned)wid * 1024u;
    const int aoff = lds_byte(wr * 64 + fr, fq * 8), boff = lds_byte(wc * 32 + fr, fq * 8);
#define PG8_SA(b, h) (((b) * 2 + (h)) * HTB)
#define PG8_SB(b, h) ((4 + (b) * 2 + (h)) * HTB)
#define PG8_STAGE(bufoff, gbase, voff) do { _Pragma("unroll") for (int _i = 0; _i < 2; ++_i) \
        __builtin_amdgcn_global_load_lds((const unsigned*)((const char*)(gbase) + (voff)[_i]), (PG8_LAS unsigned*)(lds + (bufoff) + ldsw + _i * 8192), 16, 0, 0); } while (0)
#define PG8_LDA(dst, b, h) do { _Pragma("unroll") for (int m = 0; m < 4; ++m) _Pragma("unroll") for (int k = 0; k < 2; ++k) dst[m][k] = *(const PG8_LAS bf16x8*)(lds + PG8_SA(b, h) + aoff + m * 2048 + k * 1024); } while (0)
#define PG8_LDB(dst, b, h) do { _Pragma("unroll") for (int n = 0; n < 2; ++n) _Pragma("unroll") for (int k = 0; k < 2; ++k) dst[n][k] = *(const PG8_LAS bf16x8*)(lds + PG8_SB(b, h) + boff + n * 2048 + k * 1024); } while (0)
#define PG8_MMA(ai, bj, At, Bt) do { __builtin_amdgcn_s_setprio(1); _Pragma("unroll") for (int m = 0; m < 4; ++m) _Pragma("unroll") for (int n = 0; n < 2; ++n) _Pragma("unroll") for (int k = 0; k < 2; ++k) \
        acc[ai][bj][m][n] = __builtin_amdgcn_mfma_f32_16x16x32_bf16(Bt[n][k], At[m][k], acc[ai][bj][m][n], 0, 0, 0); __builtin_amdgcn_s_setprio(0); } while (0)
#define PG8_WAIT_V(n) asm volatile("s_waitcnt vmcnt(" #n ")" ::: "memory")
#define PG8_WAIT_L(n) asm volatile("s_waitcnt lgkmcnt(" #n ")" ::: "memory")
#define PG8_BAR __builtin_amdgcn_s_barrier()
#define PG8_SCHED __builtin_amdgcn_sched_barrier(0)
    Unit cur, nxt; int ui = 0;
    if (!S.next(0, cur)) return;
    f32x4 acc[2][2][4][2];
#pragma unroll
    for (int a = 0; a < 2; ++a)
#pragma unroll
        for (int b = 0; b < 2; ++b)
#pragma unroll
            for (int m = 0; m < 4; ++m)
#pragma unroll
                for (int n = 0; n < 2; ++n) acc[a][b][m][n] = (f32x4){0.f, 0.f, 0.f, 0.f};
    bf16x8 At[4][2], B0[2][2], B1[2][2];
    const char* cA = (const char*)g.A + (size_t)cur.pm * tstep; const char* cB = (const char*)g.Bt + (size_t)cur.pn * tstep;
    S.a_ready(cur);
    if constexpr (SP2) {
        PG8_STAGE(PG8_SB(0, 0), cB, voffB); PG8_STAGE(PG8_SB(0, 1), cB + hstep, voffB); PG8_STAGE(PG8_SA(0, 0), cA, voffA); PG8_STAGE(PG8_SA(0, 1), cA + hstep, voffA);
        if (wr == 1) PG8_BAR;
        PG8_WAIT_V(2); PG8_BAR;
        PG8_STAGE(PG8_SB(1, 0), cB + kstep, voffB); PG8_STAGE(PG8_SA(1, 0), cA + kstep, voffA); PG8_STAGE(PG8_SB(1, 1), cB + hstep + kstep, voffB);
        PG8_WAIT_V(6); PG8_BAR;
    } else {
        PG8_STAGE(PG8_SB(0, 0), cB, voffB); PG8_STAGE(PG8_SA(0, 0), cA, voffA); PG8_STAGE(PG8_SB(0, 1), cB + hstep, voffB); PG8_STAGE(PG8_SA(0, 1), cA + hstep, voffA);
        if (wr == 1) PG8_BAR;
        PG8_WAIT_V(4); PG8_BAR;
        PG8_STAGE(PG8_SB(1, 0), cB + kstep, voffB); PG8_STAGE(PG8_SA(1, 0), cA + kstep, voffA); PG8_STAGE(PG8_SB(1, 1), cB + hstep + kstep, voffB);
        PG8_WAIT_V(6); PG8_BAR;
    }
    for (;;) {
        const bool has_next = S.next(ui + 1, nxt);
        const char* nA = has_next ? (const char*)g.A + (size_t)nxt.pm * tstep : cA; const char* nB = has_next ? (const char*)g.Bt + (size_t)nxt.pn * tstep : cB;
        for (int t = 0; t < nt; t += 2) {
            const bool last = (t == nt - 2);
            const char* a1 = cA + (size_t)(t + 1) * kstep;
            const char* a2 = last ? nA : cA + (size_t)(t + 2) * kstep; const char* b2 = last ? nB : cB + (size_t)(t + 2) * kstep;
            const char* a3 = a2 + kstep; const char* b3 = b2 + kstep;
            if (last && has_next) S.a_ready(nxt);
            if constexpr (SP2) {
            PG8_LDB(B0, 0, 0); PG8_LDB(B1, 0, 1); PG8_SCHED; PG8_LDA(At, 0, 0); PG8_STAGE(PG8_SA(1, 1), a1 + hstep, voffA);
            PG8_WAIT_V(8); PG8_WAIT_L(0); PG8_BAR; PG8_MMA(0, 0, At, B0); PG8_MMA(0, 1, At, B1); PG8_BAR; PG8_SCHED;
            PG8_LDA(At, 0, 1); PG8_STAGE(PG8_SB(0, 0), b2, voffB); PG8_STAGE(PG8_SB(0, 1), b2 + hstep, voffB); PG8_STAGE(PG8_SA(0, 0), a2, voffA);
            PG8_WAIT_V(8); PG8_WAIT_L(0); PG8_BAR; PG8_MMA(1, 0, At, B0); PG8_MMA(1, 1, At, B1); PG8_BAR; PG8_SCHED;
            PG8_LDB(B0, 1, 0); PG8_LDB(B1, 1, 1); PG8_SCHED; PG8_LDA(At, 1, 0); PG8_STAGE(PG8_SA(0, 1), a2 + hstep, voffA);
            PG8_WAIT_V(8); PG8_WAIT_L(0); PG8_BAR; PG8_MMA(0, 0, At, B0); PG8_MMA(0, 1, At, B1); PG8_BAR; PG8_SCHED;
            PG8_LDA(At, 1, 1); PG8_STAGE(PG8_SB(1, 0), b3, voffB); PG8_STAGE(PG8_SB(1, 1), b3 + hstep, voffB); PG8_STAGE(PG8_SA(1, 0), a3, voffA);
            PG8_WAIT_V(8); PG8_WAIT_L(0); PG8_BAR; PG8_MMA(1, 0, At, B0); PG8_MMA(1, 1, At, B1); PG8_BAR; PG8_SCHED;
            } else {
            PG8_LDB(B0, 0, 0); PG8_SCHED; PG8_LDA(At, 0, 0); PG8_STAGE(PG8_SA(1, 1), a1 + hstep, voffA);
            PG8_WAIT_L(8); PG8_BAR; PG8_WAIT_L(0); PG8_MMA(0, 0, At, B0); PG8_BAR; PG8_SCHED;
            PG8_LDB(B1, 0, 1); PG8_STAGE(PG8_SB(0, 0), b2, voffB);
            PG8_BAR; PG8_WAIT_L(0); PG8_MMA(0, 1, At, B1); PG8_BAR;
            PG8_LDA(At, 0, 1); PG8_STAGE(PG8_SA(0, 0), a2, voffA);
            PG8_BAR; PG8_WAIT_L(0); PG8_MMA(1, 0, At, B0); PG8_BAR; PG8_SCHED;
            PG8_STAGE(PG8_SB(0, 1), b2 + hstep, voffB);
            PG8_WAIT_V(6); PG8_BAR; PG8_MMA(1, 1, At, B1); PG8_BAR;
            PG8_LDB(B0, 1, 0); PG8_SCHED; PG8_LDA(At, 1, 0); PG8_STAGE(PG8_SA(0, 1), a2 + hstep, voffA);
            PG8_WAIT_L(8); PG8_BAR; PG8_WAIT_L(0); PG8_MMA(0, 0, At, B0); PG8_BAR; PG8_SCHED;
            PG8_LDB(B1, 1, 1); PG8_STAGE(PG8_SB(1, 0), b3, voffB);
            PG8_BAR; PG8_WAIT_L(0); PG8_MMA(0, 1, At, B1); PG8_BAR;
            PG8_LDA(At, 1, 1); PG8_STAGE(PG8_SA(1, 0), a3, voffA);
            PG8_BAR; PG8_WAIT_L(0); PG8_MMA(1, 0, At, B0); PG8_BAR; PG8_SCHED;
            PG8_STAGE(PG8_SB(1, 1), b3 + hstep, voffB);
            PG8_WAIT_V(6); PG8_BAR; PG8_MMA(1, 1, At, B1); PG8_BAR;
            }
        }
        if constexpr (ALIGN_EPI) { if (wr == 0) PG8_BAR; }
        if constexpr (!Epi::AFTER_DRAIN) { E(acc, cur, wr, wc, fr, fq); S.done(cur); }
        if (!has_next) break;
#pragma unroll
        for (int a = 0; a < 2; ++a)
#pragma unroll
            for (int b = 0; b < 2; ++b)
#pragma unroll
                for (int m = 0; m < 4; ++m)
#pragma unroll
                    for (int n = 0; n < 2; ++n) acc[a][b][m][n] = (f32x4){0.f, 0.f, 0.f, 0.f};
        cur = nxt; cA = nA; cB = nB; ++ui;
        if constexpr (ALIGN_EPI) { if (wr == 1) PG8_BAR; }
    }
    PG8_WAIT_V(0);
    if constexpr (!ALIGN_EPI) { if (wr == 0) PG8_BAR; }
    PG8_BAR;
    if constexpr (Epi::AFTER_DRAIN) { E.fused(acc, cur, wr, wc, fr, fq, lds, wid, lane); S.done(cur); }
#undef PG8_SA
#undef PG8_SB
#undef PG8_STAGE
#undef PG8_LDA
#undef PG8_LDB
#undef PG8_MMA
#undef PG8_WAIT_V
#undef PG8_WAIT_L
#undef PG8_BAR
#undef PG8_SCHED
}
}
#define LAS __attribute__((address_space(3)))
#define DI __device__ __forceinline__
typedef unsigned short bf16;
typedef unsigned v4u __attribute__((ext_vector_type(4)));
typedef unsigned v2u __attribute__((ext_vector_type(2)));
typedef float f32x4 __attribute__((ext_vector_type(4)));
typedef short bf16x8 __attribute__((ext_vector_type(8)));
constexpr int NTHREADS = 512, NWAVES = 8;
constexpr int D = 1024, NREAL = 16384, MROWS = 16640, LSEQ = 8208, FF = 4096, DIN = 5664, NCHUNK = 129;
constexpr int LDG = 8320, KH = 2176;
constexpr size_t MiB = 1u << 20;
constexpr size_t WS_PART1 = 0;
constexpr size_t WS_ALL = 1 * MiB;
constexpr size_t WS_WOT = 46 * MiB, WS_WFT = 48 * MiB, WS_WOUTT = 49 * MiB, WS_W1T = 51 * MiB, WS_W2T = 59 * MiB;
constexpr size_t WS_TAB = 67 * MiB;
constexpr size_t WS_CS = 68 * MiB + 512 * 1024;
constexpr size_t WS_GT2 = 136 * MiB + 512 * 1024;
constexpr size_t WS_EOT = 169 * MiB;
constexpr size_t WS_REMP = 186 * MiB;
constexpr size_t WS_PQ = 189 * MiB;
constexpr size_t WS_K = 221 * MiB;
constexpr size_t WS_R = 237 * MiB + 512 * 1024;
constexpr size_t WS_FN = 240 * MiB;
constexpr size_t DO_V = 0, DO_Q = 33 * MiB, DO_OB = 0;
constexpr size_t WS_REC = 69 * MiB;
constexpr size_t REC_BYTES = 43008, REC_KDT = 16384, REC_PM = 32768, REC_DEC = 40960;
constexpr size_t WS_QI_UNUSED = 69 * MiB;
constexpr size_t WS_KDT = 102 * MiB;
constexpr size_t WS_VT = 153 * MiB + 768 * 1024;
constexpr size_t WS_PM = 168 * MiB;
constexpr size_t WS_DEC = 184 * MiB + 512 * 1024;
constexpr size_t WS_OF = 189 * MiB;
constexpr size_t WS_ON = 69 * MiB, WS_SGA = 101 * MiB, WS_SGF = 133 * MiB, WS_OG = 165 * MiB, WS_MG = 197 * MiB;
constexpr size_t WS_H1B = 69 * MiB, WS_HF = 101 * MiB;
constexpr int LDS_BYTES = 155648;
struct Args {
    const float *x, *meta, *norm_mix, *w_in, *wdf, *bdf, *wdb, *bdb, *gla_norm, *w_o, *w_fnet, *w_out, *norm_ffn, *w_ff1, *w_ff2, *norm_final;
    float* out; unsigned char* ws; int ph_lo, ph_hi;
};
DI unsigned f2bf(float f) { unsigned u = __builtin_bit_cast(unsigned, f); return (u + 0x7fffu + ((u >> 16) & 1u)) >> 16; }
DI unsigned pk2(float lo, float hi) { return f2bf(lo) | (f2bf(hi) << 16); }
typedef float f32x2_t __attribute__((ext_vector_type(2)));
typedef __bf16 bf16x2_t __attribute__((ext_vector_type(2)));
DI unsigned cvtpk(float lo, float hi) { f32x2_t v = {lo, hi}; bf16x2_t b = __builtin_convertvector(v, bf16x2_t); return __builtin_bit_cast(unsigned, b); }
DI float bf2f(unsigned h) { return __uint_as_float(h << 16); }
DI float wave_sum(float v) {
#pragma unroll
    for (int o = 1; o < 64; o <<= 1) v += __shfl_xor(v, o);
    return v;
}
DI void transpose_item(const float* W, int pitch, int K, int ncols, bf16* WT, int row_off, LAS float* scr, int item, int lane, const float* kscale) {
    const int nblk = ncols / 32, kb = item / nblk, nb = item % nblk, k0 = 64 * kb, n0 = 32 * nb;
#pragma unroll 8
    for (int i = 0; i < 32; ++i) { const int kk = 2 * i + (lane >> 5); float v = W[(size_t)(k0 + kk) * pitch + n0 + (lane & 31)]; if (kscale) v *= kscale[k0 + kk]; scr[kk * 33 + (lane & 31)] = v; }
    asm volatile("s_waitcnt lgkmcnt(0)" ::: "memory");
    const int c = lane & 7;
#pragma unroll
    for (int j = 0; j < 4; ++j) { const int n = (lane >> 3) + 8 * j; const LAS float* s = scr + (8 * c) * 33 + n;
        v4u o; o.x = pk2(s[0 * 33], s[1 * 33]); o.y = pk2(s[2 * 33], s[3 * 33]); o.z = pk2(s[4 * 33], s[5 * 33]); o.w = pk2(s[6 * 33], s[7 * 33]);
        *(v4u*)(WT + (size_t)(row_off + n0 + n) * K + k0 + 8 * c) = o; }
    asm volatile("s_waitcnt lgkmcnt(0)" ::: "memory");
}
DI void rms_row_to_bf16(const float* xrow, const float* gain, bf16* orow, int lane) {
    const f32x4* xr = (const f32x4*)xrow + lane; const f32x4* gr = (const f32x4*)gain + lane;
    f32x4 v[4]; float s = 0.f;
#pragma unroll
    for (int j = 0; j < 4; ++j) { v[j] = xr[64 * j]; s += (v[j].x * v[j].x + v[j].y * v[j].y) + (v[j].z * v[j].z + v[j].w * v[j].w); }
    const float rstd = 1.f / sqrtf(wave_sum(s) * (1.f / 1024.f) + 1e-6f);
    unsigned long long* o8 = (unsigned long long*)orow + lane;
#pragma unroll
    for (int j = 0; j < 4; ++j) { const f32x4 g = gr[64 * j];
        o8[64 * j] = (unsigned long long)pk2(v[j].x * rstd * g.x, v[j].y * rstd * g.y) | ((unsigned long long)pk2(v[j].z * rstd * g.z, v[j].w * rstd * g.w) << 32); }
}

DI void p0_prologue(const Args& a, LAS unsigned char* lds, int tid, int lane, int wave, int bid, int G) {
    unsigned char* ws = a.ws;
    bf16* ALL = (bf16*)(ws + WS_ALL);
    const int gw = bid * NWAVES + wave, NGW = G * NWAVES;
    const int gt = bid * NTHREADS + tid, NGT = G * NTHREADS;
    LAS float* tabc = (LAS float*)lds; LAS float* tabs = tabc + LSEQ;
    for (int j = tid; j < LSEQ; j += NTHREADS) { const float ang = 6.283185307179586f * (float)j / (float)LSEQ; tabc[j] = __cosf(ang); tabs[j] = __sinf(ang); }
    __syncthreads();
    {
        bf16* CS = (bf16*)(ws + WS_CS);
        const int nchunk = 4 * 4096 * (KH / 8);
        for (int ch = gt; ch < nchunk; ch += NGT) {
            const int k8 = ch % (KH / 8); const int rest = ch / (KH / 8); const int idx = rest & 4095, grp = rest >> 12, cs = grp >> 1, kh = grp & 1;
            const int m = idx + 9, l0 = kh * KH + k8 * 8;
            unsigned j = ((unsigned)l0 * (unsigned)m) % (unsigned)LSEQ;
            float v[8];
#pragma unroll
            for (int e = 0; e < 8; ++e) { v[e] = (l0 + e <= 4104) ? (cs ? tabs[j] : tabc[j]) : 0.f; j += m; if (j >= (unsigned)LSEQ) j -= LSEQ; }
            v4u o; o.x = pk2(v[0], v[1]); o.y = pk2(v[2], v[3]); o.z = pk2(v[4], v[5]); o.w = pk2(v[6], v[7]);
            *(v4u*)(CS + (size_t)ch * 8) = o;
        }
        bf16* TAB = (bf16*)(ws + WS_TAB);
        const int nch2 = 32 * 2 * (LDG / 8);
        for (int ch = gt; ch < nch2; ch += NGT) {
            const int l8 = ch % (LDG / 8); const int rest = ch / (LDG / 8); const int cs = rest & 1, rho = rest >> 1;
            const int lp = 8200 + rho, l0 = l8 * 8;
            unsigned j = ((unsigned)l0 * (unsigned)lp) % (unsigned)LSEQ;
            float v[8];
#pragma unroll
            for (int e = 0; e < 8; ++e) { v[e] = (rho < 8 && l0 + e < LSEQ) ? (cs ? -tabs[j] : tabc[j]) : 0.f; j += lp; while (j >= (unsigned)LSEQ) j -= LSEQ; }
            v4u o; o.x = pk2(v[0], v[1]); o.y = pk2(v[2], v[3]); o.z = pk2(v[4], v[5]); o.w = pk2(v[6], v[7]);
            *(v4u*)(TAB + (size_t)ch * 8) = o;
        }
    }
    __syncthreads();
    {
        LAS float* Wl = (LAS float*)lds;
        LAS float* c128 = Wl + 64 * 128; LAS float* s128 = c128 + 128;
        if (tid < 128) { const float ang = 6.283185307179586f * (float)tid / 128.f; c128[tid] = __cosf(ang); s128[tid] = __sinf(ang); }
        for (int item = bid; item < 256; item += G) {
            const int kb = item >> 4, g = (item >> 2) & 3, nq = item & 3;
            __syncthreads();
            for (int idx = tid; idx < 64 * 128; idx += NTHREADS) { const int kk = idx >> 7, c = idx & 127; Wl[idx] = a.w_in[(size_t)(kb * 64 + kk) * DIN + 3104 + g * 128 + c]; }
            __syncthreads();
            const int n = nq * 32 + (tid & 31), kg = tid >> 5;
            float ac[4] = {0.f, 0.f, 0.f, 0.f}, as[4] = {0.f, 0.f, 0.f, 0.f};
            const LAS float* w0 = Wl + (kg * 4) * 128;
#pragma unroll 4
            for (int c = 0; c < 128; ++c) { const int j = (c * n) & 127; const float cc = c128[j], ss = s128[j];
#pragma unroll
                for (int q = 0; q < 4; ++q) { const float w = w0[q * 128 + c]; ac[q] += w * cc; as[q] += w * ss; } }
            bf16* dc = ALL + (size_t)(74 * 256 + g * 128 + n) * D + kb * 64 + kg * 4;
            bf16* ds = ALL + (size_t)(76 * 256 + g * 128 + n) * D + kb * 64 + kg * 4;
            *(v2u*)dc = (v2u){pk2(ac[0], ac[1]), pk2(ac[2], ac[3])}; *(v2u*)ds = (v2u){pk2(as[0], as[1]), pk2(as[2], as[3])};
        }
        __syncthreads();
    }
    {
        LAS float* scr = (LAS float*)(lds + wave * 16384);
        bf16* WT = ALL + (size_t)65 * 256 * D;
        const int I_Q = 16 * 16, I_V = 16 * 32, I_R = 16 * 1, I_G = 16 * 32;
        const int I_O = 16 * 32, I_F = 8 * 32, I_1 = 16 * 128, I_2 = 64 * 32;
        const int NIT = 2 * I_Q + I_V + I_R + 3 * I_G + 2 * I_O + I_F + I_1 + I_2;
        for (int it = gw; it < NIT; it += NGW) {
            int r = it;
            if (r < I_Q) { transpose_item(a.w_in + 0, DIN, D, 512, WT, 0, scr, r, lane, nullptr); continue; } r -= I_Q;
            if (r < I_Q) { transpose_item(a.w_in + 512, DIN, D, 512, WT, 512, scr, r, lane, nullptr); continue; } r -= I_Q;
            if (r < I_V) { transpose_item(a.w_in + 1024, DIN, D, 1024, WT, 1024, scr, r, lane, nullptr); continue; } r -= I_V;
            if (r < I_R) { transpose_item(a.w_in + 3072, DIN, D, 32, WT, 2048, scr, r, lane, nullptr); continue; } r -= I_R;
            if (r < I_G) { transpose_item(a.w_in + 2048, DIN, D, 1024, WT, 13 * 256, scr, r, lane, nullptr); continue; } r -= I_G;
            if (r < I_G) { transpose_item(a.w_in + 3616, DIN, D, 1024, WT, 17 * 256, scr, r, lane, nullptr); continue; } r -= I_G;
            if (r < I_G) { transpose_item(a.w_in + 4640, DIN, D, 1024, WT, 21 * 256, scr, r, lane, nullptr); continue; } r -= I_G;
            if (r < I_O) { transpose_item(a.w_o, D, D, 1024, (bf16*)(ws + WS_WOT), 0, scr, r, lane, nullptr); continue; } r -= I_O;
            if (r < I_O) { transpose_item(a.w_out, D, D, 1024, (bf16*)(ws + WS_WOUTT), 0, scr, r, lane, nullptr); continue; } r -= I_O;
            if (r < I_F) { transpose_item(a.w_fnet, D, 512, 1024, (bf16*)(ws + WS_WFT), 0, scr, r, lane, nullptr); continue; } r -= I_F;
            if (r < I_1) { transpose_item(a.w_ff1, FF, D, FF, (bf16*)(ws + WS_W1T), 0, scr, r, lane, a.norm_ffn); continue; } r -= I_1;
            transpose_item(a.w_ff2, D, FF, 1024, (bf16*)(ws + WS_W2T), 0, scr, r, lane, nullptr);
        }
    }
    {
        bf16* t8 = ALL + (size_t)(73 * 256 + 32) * D;
        for (int i = gt; i < 224 * D / 8; i += NGT) *(v4u*)(t8 + (size_t)i * 8) = (v4u){0u, 0u, 0u, 0u};
        bf16* x64 = ALL + (size_t)16384 * D;
        for (int i = gt; i < 256 * D / 8; i += NGT) { const int row = i / (D / 8); if (row < 48 || row >= 64) *(v4u*)(x64 + (size_t)i * 8) = (v4u){0u, 0u, 0u, 0u}; }
        bf16* GT2 = (bf16*)(ws + WS_GT2);
        for (int i = gt; i < 2048 * 14; i += NGT) { const int row = i / 14, c = i % 14; *(v4u*)(GT2 + (size_t)row * LDG + LSEQ + c * 8) = (v4u){0u, 0u, 0u, 0u}; }
    }
    for (int m = gw; m < NREAL + 16; m += NGW) {
        if (m < NREAL) rms_row_to_bf16(a.x + (size_t)m * D, a.norm_mix, ALL + (size_t)m * D, lane);
        else rms_row_to_bf16(a.meta + (size_t)(m - NREAL) * D, a.norm_mix, ALL + (size_t)(NREAL + 48 + (m - NREAL)) * D, lane);
    }
}
DI void p2_sym_rem(const Args& a, int tid, int lane, int wave, int bid, int G) {
    unsigned char* ws = a.ws;
    const bf16* GT2 = (const bf16*)(ws + WS_GT2);
    bf16* EOT = (bf16*)(ws + WS_EOT);
    const int gt = bid * NTHREADS + tid, NGT = G * NTHREADS;
    const int nchunk = 4 * 1024 * (KH / 8);
    for (int ch = gt; ch < nchunk; ch += NGT) {
        const int k8 = ch % (KH / 8); const int rest = ch / (KH / 8); const int n = rest & 1023, grp = rest >> 10, cs = grp >> 1, kh = grp & 1;
        const int l0 = kh * KH + k8 * 8;
        const bf16* src = GT2 + ((size_t)n * 2 + cs) * LDG;
        float v[8];
        if (l0 > 4104) {
#pragma unroll
            for (int e = 0; e < 8; ++e) v[e] = 0.f;
        } else {
            const v4u f = *(const v4u*)(src + l0);
            const float fw[8] = {bf2f(f.x & 0xffffu), bf2f(f.x >> 16), bf2f(f.y & 0xffffu), bf2f(f.y >> 16), bf2f(f.z & 0xffffu), bf2f(f.z >> 16), bf2f(f.w & 0xffffu), bf2f(f.w >> 16)};
#pragma unroll
            for (int e = 0; e < 8; ++e) { const int l = l0 + e;
                if (l > 4104) v[e] = 0.f;
                else if (l == 0 || l == 4104) v[e] = cs ? 0.f : fw[e];
                else { const float mir = bf2f((unsigned)src[LSEQ - l]); v[e] = cs ? fw[e] - mir : fw[e] + mir; } }
        }
        v4u o; o.x = pk2(v[0], v[1]); o.y = pk2(v[2], v[3]); o.z = pk2(v[4], v[5]); o.w = pk2(v[6], v[7]);
        *(v4u*)(EOT + (size_t)ch * 8) = o;
    }
    typedef float f32x16 __attribute__((ext_vector_type(16)));
    const bf16* TAB = (const bf16*)(ws + WS_TAB);
    float* REMP = (float*)(ws + WS_REMP);
    const int gw = bid * NWAVES + wave, NGW = G * NWAVES;
    for (int task = gw; task < 32 * 65; task += NGW) {
        const int nt = task & 31, ks = task >> 5; const int r = lane & 31, h = lane >> 5;
        f32x16 acc; for (int i = 0; i < 16; ++i) acc[i] = 0.f;
        const bf16* ap = TAB + (size_t)r * (2 * LDG) + ks * 256 + 8 * h;
        const bf16* bp = GT2 + (size_t)(nt * 32 + r) * (2 * LDG) + ks * 256 + 8 * h;
#pragma unroll 4
        for (int kk = 0; kk < 16; ++kk) { const bf16x8 af = *(const bf16x8*)(ap + kk * 16), bfr = *(const bf16x8*)(bp + kk * 16);
            acc = __builtin_amdgcn_mfma_f32_32x32x16_bf16(af, bfr, acc, 0, 0, 0); }
#pragma unroll
        for (int i = 0; i < 4; ++i) REMP[((size_t)ks * 8 + i + 4 * h) * 1024 + nt * 32 + r] = acc[i];
    }
}

DI void p4_combine(const Args& a, int tid, int bid, int G) {
    unsigned char* ws = a.ws;
    const bf16* PQ = (const bf16*)(ws + WS_PQ); const float* REMP = (const float*)(ws + WS_REMP); bf16* FN = (bf16*)(ws + WS_FN);
    const float scale = 0.0009756003f;
    const int gt = bid * NTHREADS + tid, NGT = G * NTHREADS;
    for (int ch = gt; ch < NREAL * 64; ch += NGT) {
        const int c8 = ch & 63, row = ch >> 6, b = row >> 13, s = row & 8191, l = s + 16, n = b * 512 + c8 * 8;
        float v[8];
        if (l >= 8200) { const int rho = l - 8200;
#pragma unroll
            for (int e = 0; e < 8; ++e) v[e] = 0.f;
            for (int ks = 0; ks < 65; ++ks) { const f32x4 p0 = *(const f32x4*)(REMP + ((size_t)ks * 8 + rho) * 1024 + n), p1 = *(const f32x4*)(REMP + ((size_t)ks * 8 + rho) * 1024 + n + 4);
                v[0] += p0[0]; v[1] += p0[1]; v[2] += p0[2]; v[3] += p0[3]; v[4] += p1[0]; v[5] += p1[1]; v[6] += p1[2]; v[7] += p1[3]; }
        } else {
            const bool mir = l > 4104; const int idx = (mir ? LSEQ - l : l) - 9; const float sg = mir ? 1.f : -1.f;
            const size_t off = (size_t)idx * 1024 + n;
            const v4u p0 = *(const v4u*)(PQ + off), p1 = *(const v4u*)(PQ + (size_t)4096 * 1024 + off), q0 = *(const v4u*)(PQ + (size_t)2 * 4096 * 1024 + off), q1 = *(const v4u*)(PQ + (size_t)3 * 4096 * 1024 + off);
            const unsigned pp0[4] = {p0.x, p0.y, p0.z, p0.w}, pp1[4] = {p1.x, p1.y, p1.z, p1.w}, qq0[4] = {q0.x, q0.y, q0.z, q0.w}, qq1[4] = {q1.x, q1.y, q1.z, q1.w};
#pragma unroll
            for (int e = 0; e < 4; ++e) {
                v[2 * e] = (bf2f(pp0[e] & 0xffffu) + bf2f(pp1[e] & 0xffffu)) + sg * (bf2f(qq0[e] & 0xffffu) + bf2f(qq1[e] & 0xffffu));
                v[2 * e + 1] = (bf2f(pp0[e] >> 16) + bf2f(pp1[e] >> 16)) + sg * (bf2f(qq0[e] >> 16) + bf2f(qq1[e] >> 16)); }
        }
        v4u o; o.x = pk2(v[0] * scale, v[1] * scale); o.y = pk2(v[2] * scale, v[3] * scale); o.z = pk2(v[4] * scale, v[5] * scale); o.w = pk2(v[6] * scale, v[7] * scale);
        *(v4u*)(FN + (size_t)row * 512 + c8 * 8) = o;
    }
}

DI void p6_post(const Args& a, int lane, int wave, int bid, int G) {
    unsigned char* ws = a.ws;
    const bf16* OF = (const bf16*)(ws + WS_OF); const bf16* OB = (const bf16*)((unsigned char*)a.out + DO_OB); bf16* ON = (bf16*)(ws + WS_ON);
    const int gw = bid * NWAVES + wave, NGW = G * NWAVES;
    const int c0 = lane * 16;
    float gn[16];
#pragma unroll
    for (int e = 0; e < 16; ++e) gn[e] = a.gla_norm[(c0 & 255) + e];
    for (int row = gw; row < NREAL; row += NGW) {
        const size_t off = (size_t)row * 1024 + c0;
        const v4u f0 = *(const v4u*)(OF + off), f1 = *(const v4u*)(OF + off + 8), b0 = *(const v4u*)(OB + off), b1 = *(const v4u*)(OB + off + 8);
        const unsigned fw[8] = {f0.x, f0.y, f0.z, f0.w, f1.x, f1.y, f1.z, f1.w}, bw[8] = {b0.x, b0.y, b0.z, b0.w, b1.x, b1.y, b1.z, b1.w};
        float v[16]; float ss = 0.f;
#pragma unroll
        for (int e = 0; e < 8; ++e) { v[2 * e] = bf2f(fw[e] & 0xffffu) + bf2f(bw[e] & 0xffffu); v[2 * e + 1] = bf2f(fw[e] >> 16) + bf2f(bw[e] >> 16); ss += v[2 * e] * v[2 * e] + v[2 * e + 1] * v[2 * e + 1]; }
        ss += __shfl_xor(ss, 1); ss += __shfl_xor(ss, 2); ss += __shfl_xor(ss, 4); ss += __shfl_xor(ss, 8);
        const float rstd = 1.f / sqrtf(ss * (1.f / 256.f) + 1e-6f);
        unsigned w[8];
#pragma unroll
        for (int e = 0; e < 8; ++e) w[e] = pk2(v[2 * e] * rstd * gn[2 * e], v[2 * e + 1] * rstd * gn[2 * e + 1]);
        *(v4u*)(ON + off) = (v4u){w[0], w[1], w[2], w[3]}; *(v4u*)(ON + off + 8) = (v4u){w[4], w[5], w[6], w[7]};
    }
}

DI void p11_final(const Args& a, int lane, int wave, int bid, int G) {
    const int gw = bid * NWAVES + wave, NGW = G * NWAVES;
    for (int row = gw; row < NREAL; row += NGW) {
        f32x4* xr = (f32x4*)(a.out + (size_t)row * D) + lane; const f32x4* gr = (const f32x4*)a.norm_final + lane;
        f32x4 v[4]; float s = 0.f;
#pragma unroll
        for (int j = 0; j < 4; ++j) { v[j] = xr[64 * j]; s += (v[j].x * v[j].x + v[j].y * v[j].y) + (v[j].z * v[j].z + v[j].w * v[j].w); }
        const float rstd = 1.f / sqrtf(wave_sum(s) * (1.f / 1024.f) + 1e-6f);
#pragma unroll
        for (int j = 0; j < 4; ++j) { const f32x4 g = gr[64 * j]; xr[64 * j] = (f32x4){v[j].x * rstd * g.x, v[j].y * rstd * g.y, v[j].z * rstd * g.z, v[j].w * rstd * g.w}; }
    }
}
DI float logsig(float x) { return fminf(x, 0.f) - __logf(1.f + __expf(-fabsf(x))); }
DI size_t tile_idx(int dir, int b, int h, int c) { return (size_t)((dir * 2 + b) * 4 + h) * NCHUNK + c; }
DI void p4_gla_prep(const Args& a, LAS unsigned char* lds, int tid, int lane, int wave, int bid, int G) {
    unsigned char* ws = a.ws;
    const bf16* Qg = (const bf16*)((unsigned char*)a.out + DO_Q); const bf16* Kg = (const bf16*)(ws + WS_K); const bf16* Vg = (const bf16*)((unsigned char*)a.out + DO_V);
    const float* Rg = (const float*)(ws + WS_R);
    unsigned char* REC = ws + WS_REC; bf16* VT = (bf16*)(ws + WS_VT);
    LAS float* BF = (LAS float*)lds; LAS float* BB = BF + 64 * 128;
    LAS unsigned char* QF = lds + 65536; LAS unsigned char* KF = QF + 17408; LAS unsigned char* QB = KF + 17408; LAS unsigned char* KB = QB + 17408;
    LAS unsigned char* KRAW = lds + 135168;
    LAS float* RS = (LAS float*)QF; LAS float* WD = RS + 64 * 32;
    LAS unsigned char* VS = lds;
    f32x4 rq; v4u q8p[2], k8p[2], v8p[4];
#define PREP_ROW0(t) ((((t) >> 2) % NCHUNK == 0) ? NREAL : ((t) >> 2) / NCHUNK * 8192 + 64 * ((((t) >> 2) % NCHUNK) - 1))
#define PREP_LOAD_QKR(t) do { const int r0_ = PREP_ROW0(t), h_ = (t) & 3; rq = *(const f32x4*)(Rg + (size_t)r0_ * 32 + tid * 4); \
        _Pragma("unroll") for (int rep = 0; rep < 2; ++rep) { const int g_ = tid + NTHREADS * rep, i_ = g_ >> 4, d0_ = (g_ & 15) * 8; \
            q8p[rep] = *(const v4u*)(Qg + (size_t)(r0_ + i_) * 512 + h_ * 128 + d0_); k8p[rep] = *(const v4u*)(Kg + (size_t)(r0_ + i_) * 512 + h_ * 128 + d0_); } } while (0)
#define PREP_LOAD_V(t) do { const int r0_ = PREP_ROW0(t), h_ = (t) & 3; \
        _Pragma("unroll") for (int rep = 0; rep < 4; ++rep) { const int idx_ = tid + NTHREADS * rep, i_ = idx_ >> 5, u_ = idx_ & 31; v8p[rep] = *(const v4u*)(Vg + (size_t)(r0_ + i_) * 1024 + h_ * 256 + u_ * 8); } } while (0)
    if (bid < 2 * NCHUNK * 4) { PREP_LOAD_QKR(bid); PREP_LOAD_V(bid); }
    for (int task = bid; task < 2 * NCHUNK * 4; task += G) {
        const int h = task & 3, c = (task >> 2) % NCHUNK, b = (task >> 2) / NCHUNK;
        const int row0 = (c == 0) ? NREAL : b * 8192 + 64 * (c - 1);
        const bool has_next = task + G < 2 * NCHUNK * 4;
        {
            const int d = tid & 127, part = tid >> 7;
            float wf[16], wb[16];
#pragma unroll
            for (int j = 0; j < 16; ++j) { wf[j] = a.wdf[j * 512 + h * 128 + d]; wb[j] = a.wdb[j * 512 + h * 128 + d]; }
            const float bfw = a.bdf[h * 128 + d], bbw = a.bdb[h * 128 + d];
            *(LAS f32x4*)(RS + tid * 4) = rq;
            __syncthreads();
            float laf[16], lab[16];
#pragma unroll
            for (int ii = 0; ii < 16; ++ii) { const int i = part * 16 + ii; float lf = bfw, lb = bbw;
#pragma unroll
                for (int j4 = 0; j4 < 4; ++j4) { const f32x4 rf = *(const LAS f32x4*)(RS + i * 32 + 4 * j4), rb = *(const LAS f32x4*)(RS + i * 32 + 16 + 4 * j4);
                    lf += rf[0] * wf[4 * j4] + rf[1] * wf[4 * j4 + 1] + rf[2] * wf[4 * j4 + 2] + rf[3] * wf[4 * j4 + 3];
                    lb += rb[0] * wb[4 * j4] + rb[1] * wb[4 * j4 + 1] + rb[2] * wb[4 * j4 + 2] + rb[3] * wb[4 * j4 + 3]; }
                laf[ii] = logsig(lf) * 0.0625f; lab[ii] = logsig(lb) * 0.0625f;
                if (c == 0 && i < 48) { laf[ii] = 0.f; lab[ii] = 0.f; } }
#pragma unroll
            for (int ii = 1; ii < 16; ++ii) laf[ii] += laf[ii - 1];
#pragma unroll
            for (int ii = 14; ii >= 0; --ii) lab[ii] += lab[ii + 1];
            LAS float* TOT = WD;
            TOT[part * 128 + d] = laf[15]; TOT[512 + part * 128 + d] = lab[0];
            __syncthreads();
            float of = 0.f, ob = 0.f;
#pragma unroll
            for (int q = 0; q < 4; ++q) { if (q < part) of += TOT[q * 128 + d]; if (q > part) ob += TOT[512 + q * 128 + d]; }
#pragma unroll
            for (int ii = 0; ii < 16; ++ii) { const int i = part * 16 + ii; BF[i * 128 + d] = laf[ii] + of; BB[i * 128 + d] = lab[ii] + ob; }
            if (part == 3) ((float*)(REC + tile_idx(0, b, h, c) * REC_BYTES + REC_DEC))[d] = __expf(laf[15] + of);
            if (part == 0) ((float*)(REC + tile_idx(1, b, h, c) * REC_BYTES + REC_DEC))[d] = __expf(lab[0] + ob);
        }
        __syncthreads();
#pragma unroll
        for (int rep = 0; rep < 2; ++rep) {
            const int g = tid + NTHREADS * rep, i = g >> 4, d0 = (g & 15) * 8;
            const v4u q8 = q8p[rep], k8 = k8p[rep];
            const unsigned qw[4] = {q8.x, q8.y, q8.z, q8.w}, kw[4] = {k8.x, k8.y, k8.z, k8.w};
            float qf[8], kf[8], qb[8], kb[8], qif[8], qib[8];
#pragma unroll
            for (int e = 0; e < 8; ++e) {
                const int d = d0 + e; const float q = bf2f((e & 1) ? (qw[e >> 1] >> 16) : (qw[e >> 1] & 0xffffu)), k = bf2f((e & 1) ? (kw[e >> 1] >> 16) : (kw[e >> 1] & 0xffffu));
                const float ef = BF[i * 128 + d], eb = BB[i * 128 + d], f31 = BF[31 * 128 + d], b32 = BB[32 * 128 + d];
                qf[e] = q * __expf(ef - f31); kf[e] = k * __expf(f31 - ef); qb[e] = q * __expf(eb - b32); kb[e] = k * __expf(b32 - eb);
                qif[e] = q * __expf(ef); qib[e] = q * __expf(eb);
            }
            *(LAS v4u*)(QF + i * 272 + d0 * 2) = (v4u){pk2(qf[0], qf[1]), pk2(qf[2], qf[3]), pk2(qf[4], qf[5]), pk2(qf[6], qf[7])};
            *(LAS v4u*)(KF + i * 272 + d0 * 2) = (v4u){pk2(kf[0], kf[1]), pk2(kf[2], kf[3]), pk2(kf[4], kf[5]), pk2(kf[6], kf[7])};
            *(LAS v4u*)(QB + i * 272 + d0 * 2) = (v4u){pk2(qb[0], qb[1]), pk2(qb[2], qb[3]), pk2(qb[4], qb[5]), pk2(qb[6], qb[7])};
            *(LAS v4u*)(KB + i * 272 + d0 * 2) = (v4u){pk2(kb[0], kb[1]), pk2(kb[2], kb[3]), pk2(kb[4], kb[5]), pk2(kb[6], kb[7])};
            *(LAS v4u*)(KRAW + i * 256 + d0 * 2) = k8;
            const int kap = d0 >> 5, u = (d0 & 31) >> 3, pc = 32 * kap + 16 * (u & 1) + 4 * (u >> 1);
            bf16* qi_f = (bf16*)(REC + tile_idx(0, b, h, c) * REC_BYTES) + i * 128 + pc; bf16* qi_b = (bf16*)(REC + tile_idx(1, b, h, c) * REC_BYTES) + i * 128 + pc;
            *(v2u*)qi_f = (v2u){pk2(qif[0], qif[1]), pk2(qif[2], qif[3])}; *(v2u*)(qi_f + 8) = (v2u){pk2(qif[4], qif[5]), pk2(qif[6], qif[7])};
            *(v2u*)qi_b = (v2u){pk2(qib[0], qib[1]), pk2(qib[2], qib[3])}; *(v2u*)(qi_b + 8) = (v2u){pk2(qib[4], qib[5]), pk2(qib[6], qib[7])};
        }
        if (has_next) PREP_LOAD_QKR(task + G);
        __syncthreads();
        {
            const int dir = wave >> 2, tq = wave & 3, fr = lane & 15, g = lane >> 4;
            const LAS unsigned char* QX = dir ? QB : QF; const LAS unsigned char* KX = dir ? KB : KF;
            bf16x8 bq[4];
#pragma unroll
            for (int kap = 0; kap < 4; ++kap) bq[kap] = *(const LAS bf16x8*)(QX + (16 * tq + fr) * 272 + (32 * kap + 8 * g) * 2);
            bf16* pm = (bf16*)(REC + tile_idx(dir, b, h, c) * REC_BYTES + REC_PM);
            const int i = 16 * tq + fr;
#pragma unroll
            for (int tk = 0; tk < 4; ++tk) {
                f32x4 acc = {0.f, 0.f, 0.f, 0.f};
#pragma unroll
                for (int kap = 0; kap < 4; ++kap) { const bf16x8 af = *(const LAS bf16x8*)(KX + (16 * tk + fr) * 272 + (32 * kap + 8 * g) * 2);
                    acc = __builtin_amdgcn_mfma_f32_16x16x32_bf16(af, bq[kap], acc, 0, 0, 0); }
                float s[4];
#pragma unroll
                for (int e = 0; e < 4; ++e) { const int j = 16 * tk + 4 * g + e; const bool keep = dir ? (j >= i) : (j <= i); s[e] = keep ? acc[e] : 0.f; }
                *(v2u*)(pm + i * 64 + 16 * tk + 4 * g) = (v2u){pk2(s[0], s[1]), pk2(s[2], s[3])};
            }
        }
        {
            const int d = tid & 127, blk = tid >> 7, i0 = blk * 16;
            const float f63 = BF[63 * 128 + d], b0 = BB[d];
            unsigned wf[8], wb[8];
#pragma unroll
            for (int e2 = 0; e2 < 8; ++e2) {
                const int ia = i0 + 2 * e2, ib = ia + 1;
                const float ka = bf2f((unsigned)*(const LAS unsigned short*)(KRAW + ia * 256 + d * 2)), kb2 = bf2f((unsigned)*(const LAS unsigned short*)(KRAW + ib * 256 + d * 2));
                wf[e2] = pk2(ka * __expf(f63 - BF[ia * 128 + d]), kb2 * __expf(f63 - BF[ib * 128 + d]));
                wb[e2] = pk2(ka * __expf(b0 - BB[ia * 128 + d]), kb2 * __expf(b0 - BB[ib * 128 + d]));
            }
            bf16* kf_ = (bf16*)(REC + tile_idx(0, b, h, c) * REC_BYTES + REC_KDT) + d * 64 + i0; bf16* kb_ = (bf16*)(REC + tile_idx(1, b, h, c) * REC_BYTES + REC_KDT) + d * 64 + i0;
            *(v4u*)kf_ = (v4u){wf[0], wf[1], wf[2], wf[3]}; *(v4u*)(kf_ + 8) = (v4u){wf[4], wf[5], wf[6], wf[7]};
            *(v4u*)kb_ = (v4u){wb[0], wb[1], wb[2], wb[3]}; *(v4u*)(kb_ + 8) = (v4u){wb[4], wb[5], wb[6], wb[7]};
        }
        __syncthreads();
#pragma unroll
        for (int rep = 0; rep < 4; ++rep) { const int idx = tid + NTHREADS * rep, i = idx >> 5, u = idx & 31;
            *(LAS v4u*)(VS + i * 528 + u * 16) = v8p[rep]; }
        if (has_next) PREP_LOAD_V(task + G);
        __syncthreads();
        {
            const int dv = tid & 255, half = tid >> 8; unsigned w[16];
#pragma unroll
            for (int e2 = 0; e2 < 16; ++e2) { const int ia = 32 * half + 2 * e2;
                w[e2] = (unsigned)*(const LAS unsigned short*)(VS + ia * 528 + dv * 2) | ((unsigned)*(const LAS unsigned short*)(VS + (ia + 1) * 528 + dv * 2) << 16); }
            bf16* vt = VT + ((size_t)(b * 4 + h) * NCHUNK + c) * 16384 + dv * 64 + 32 * half;
#pragma unroll
            for (int q4 = 0; q4 < 4; ++q4) *(v4u*)(vt + 8 * q4) = (v4u){w[4 * q4], w[4 * q4 + 1], w[4 * q4 + 2], w[4 * q4 + 3]};
        }
        __syncthreads();
    }
}

constexpr int SC_QI = 0, SC_KDT = 17408, SC_PM = 35840, SC_DEC = 45056, SC_VT = 45568, SC_BUF = 47872, SC_SA = 3 * SC_BUF, SC_NCH = 2720, SC_IT = 22;
DI void scan_load(v4u (&r)[SC_IT], const unsigned char* rec, const unsigned char* vt, int pl) {
#pragma unroll
    for (int it = 0; it < SC_IT - 1; ++it) r[it] = *(const v4u*)(rec + pl * 16 + it * 2048);
    r[SC_IT - 1] = *(const v4u*)(vt + pl * 16);
}
DI void scan_store(LAS unsigned char* buf, const v4u (&r)[SC_IT], int pl) {
#pragma unroll
    for (int it = 0; it < SC_IT - 1; ++it) { const int cid = pl + 128 * it;
        int dst;
        if (cid < 1024) dst = SC_QI + (cid >> 4) * 272 + (cid & 15) * 16;
        else if (cid < 2048) { const int x = cid - 1024; dst = SC_KDT + (x >> 3) * 144 + (x & 7) * 16; }
        else if (cid < 2560) { const int x = cid - 2048; dst = SC_PM + (x >> 3) * 144 + (x & 7) * 16; }
        else dst = SC_DEC + (cid - 2560) * 16;
        if (cid < 2592) *(LAS v4u*)(buf + dst) = r[it]; }
    *(LAS v4u*)(buf + SC_VT + (pl >> 3) * 144 + (pl & 7) * 16) = r[SC_IT - 1];
}
DI void p5_scan(const Args& a, LAS unsigned char* lds, int tid, int lane, int wave, int bid, int G) {
    unsigned char* ws = a.ws;
    const unsigned char* REC = ws + WS_REC; const unsigned char* VT = ws + WS_VT;
    for (int item = bid; item < 256; item += G) {
        const int sl = item & 15, dir = (item >> 4) & 1, h = (item >> 5) & 3, b = item >> 7;
        bf16* O = dir ? (bf16*)((unsigned char*)a.out + DO_OB) : (bf16*)(ws + WS_OF);
        const size_t t0 = tile_idx(dir, b, h, 0); const size_t v0i = (size_t)(b * 4 + h) * NCHUNK;
        const int fr = lane & 15, g = lane >> 4;
#define SCAN_SRC(step) REC + (t0 + (dir ? 128 - (step) : (step))) * REC_BYTES, VT + (v0i + (dir ? 128 - (step) : (step))) * 32768 + sl * 2048
        const bool loader = (wave >= 1 && wave <= 6);
        const int pr = (wave - 1) >> 1, pl = ((wave - 1) & 1) * 64 + lane;
        v4u r[SC_IT];
        __syncthreads();
        if (loader) { scan_load(r, SCAN_SRC(pr), pl); scan_store(lds + pr * SC_BUF, r, pl); scan_load(r, SCAN_SRC(pr + 3), pl); }
        if (wave == 0) *(LAS v4u*)(lds + SC_SA + 4096 + lane * 16) = (v4u){0u, 0u, 0u, 0u}, *(LAS v4u*)(lds + SC_SA + 4096 + 1024 + lane * 16) = (v4u){0u, 0u, 0u, 0u},
                       *(LAS v4u*)(lds + SC_SA + 4096 + 2048 + lane * 16) = (v4u){0u, 0u, 0u, 0u}, *(LAS v4u*)(lds + SC_SA + 4096 + 3072 + lane * 16) = (v4u){0u, 0u, 0u, 0u};
        __syncthreads();
        if (wave == 0) {
#pragma unroll 1
            for (int s = 0; s < NCHUNK; ++s) {
                LAS unsigned char* cur = lds + (s % 3) * SC_BUF;
                const int cs = dir ? 128 - s : s;
                const LAS unsigned char* sap = lds + SC_SA + ((s + 1) & 1) * 4096 + lane * 16;
                bf16x8 sa[4], vf[2];
#pragma unroll
                for (int kap = 0; kap < 4; ++kap) sa[kap] = *(const LAS bf16x8*)(sap + kap * 1024);
#pragma unroll
                for (int kp = 0; kp < 2; ++kp) vf[kp] = *(const LAS bf16x8*)(cur + SC_VT + fr * 144 + (32 * kp + 8 * g) * 2);
#pragma unroll
                for (int t = 0; t < 4; ++t) {
                    f32x4 o = {0.f, 0.f, 0.f, 0.f};
#pragma unroll
                    for (int kap = 0; kap < 4; ++kap) { const bf16x8 qf = *(const LAS bf16x8*)(cur + SC_QI + (16 * t + fr) * 272 + (32 * kap + 8 * g) * 2);
                        o = __builtin_amdgcn_mfma_f32_16x16x32_bf16(sa[kap], qf, o, 0, 0, 0); }
#pragma unroll
                    for (int kp = 0; kp < 2; ++kp) { const bf16x8 pf = *(const LAS bf16x8*)(cur + SC_PM + (16 * t + fr) * 144 + (32 * kp + 8 * g) * 2);
                        o = __builtin_amdgcn_mfma_f32_16x16x32_bf16(vf[kp], pf, o, 0, 0, 0); }
                    if (cs != 0) { const size_t row = (size_t)b * 8192 + 64 * (cs - 1) + 16 * t + fr;
                        *(v2u*)(O + row * 1024 + h * 256 + 16 * sl + 4 * g) = (v2u){cvtpk(o[0], o[1]), cvtpk(o[2], o[3])}; }
                }
                __syncthreads();
            }
        } else if (wave == 7) {
            f32x4 S[8];
#pragma unroll
            for (int j = 0; j < 8; ++j) S[j] = (f32x4){0.f, 0.f, 0.f, 0.f};
#pragma unroll 1
            for (int s = 0; s < NCHUNK; ++s) {
                LAS unsigned char* cur = lds + (s % 3) * SC_BUF;
                bf16x8 vf[2];
#pragma unroll
                for (int kp = 0; kp < 2; ++kp) vf[kp] = *(const LAS bf16x8*)(cur + SC_VT + fr * 144 + (32 * kp + 8 * g) * 2);
#pragma unroll
                for (int j = 0; j < 8; ++j) { const f32x4 dc = *(const LAS f32x4*)(cur + SC_DEC + (16 * j + 4 * g) * 4); S[j] = S[j] * dc; }
#pragma unroll
                for (int j = 0; j < 8; ++j)
#pragma unroll
                    for (int kp = 0; kp < 2; ++kp) { const bf16x8 kf = *(const LAS bf16x8*)(cur + SC_KDT + (16 * j + fr) * 144 + (32 * kp + 8 * g) * 2);
                        S[j] = __builtin_amdgcn_mfma_f32_16x16x32_bf16(kf, vf[kp], S[j], 0, 0, 0); }
                LAS unsigned char* sap = lds + SC_SA + (s & 1) * 4096 + lane * 16;
#pragma unroll
                for (int kap = 0; kap < 4; ++kap) { const f32x4 lo = S[2 * kap], hi = S[2 * kap + 1];
                    *(LAS v4u*)(sap + kap * 1024) = (v4u){cvtpk(lo[0], lo[1]), cvtpk(lo[2], lo[3]), cvtpk(hi[0], hi[1]), cvtpk(hi[2], hi[3])}; }
                __syncthreads();
            }
        } else {
#pragma unroll 1
            for (int s = 0; s < NCHUNK; ++s) {
                if (s >= 1 && s + 2 < NCHUNK && (s + 2) % 3 == pr) { __builtin_amdgcn_s_sleep(6); scan_store(lds + ((s + 2) % 3) * SC_BUF, r, pl); if (s + 5 < NCHUNK) scan_load(r, SCAN_SRC(s + 5), pl); }
                __syncthreads();
            }
        }
#undef SCAN_SRC
    }
}
constexpr size_t WS_BAR = 68 * MiB + 256 * 1024;
#define XB_TMO      128
#define XB_XCNT(j)  (256  + 64 * (j))
#define XB_XSUB(j)  (1280 + 64 * (j))
#define XB_XGEN(j)  (2304 + 64 * (j))
#define XB_TOP      3328
#define XB_TOPGEN   3392
#define XCD_BAR_WORDS 3456
#define XB_SPIN_CAP (1u << 18)

__device__ __forceinline__ unsigned xb_ld(unsigned* p)              { return __hip_atomic_load(p, __ATOMIC_RELAXED, __HIP_MEMORY_SCOPE_AGENT); }
__device__ __forceinline__ unsigned xb_add(unsigned* p, unsigned v) { return __hip_atomic_fetch_add(p, v, __ATOMIC_RELAXED, __HIP_MEMORY_SCOPE_AGENT); }
__device__ __forceinline__ unsigned xb_xcc_id() { return (unsigned)__builtin_amdgcn_s_getreg((3 << 11) | 20) & 0xFu; }
#define XB_SPIN(cond, bar) do { unsigned _sp = 0; while (cond) { __builtin_amdgcn_s_sleep(1); \
    if ((++_sp & 255u) == 0u) { if (xb_ld(&(bar)[XB_TMO])) break; if (_sp > XB_SPIN_CAP) { atomicAdd(&(bar)[XB_TMO], 1u); break; } } } } while (0)

struct XcdBarrier {
    unsigned* bar; unsigned x;
    volatile LAS unsigned* st;
};

__device__ __forceinline__ XcdBarrier xcd_barrier_post(unsigned* bar, volatile LAS unsigned* st) {
    XcdBarrier b; b.bar = bar; b.x = xb_xcc_id(); b.st = st;
    if (threadIdx.x == 0) (void)xb_add(&bar[XB_XCNT(b.x)], 1u);
    return b;
}
__device__ __forceinline__ void xcd_barrier_complete(unsigned* bar, unsigned x, unsigned& nloc, unsigned& nx) {
    const unsigned G = gridDim.x * gridDim.y * gridDim.z;
    unsigned sum, cnt, mine, sp = 0u;
    for (;;) {
        sum = 0u; cnt = 0u; mine = 0u;
#pragma unroll
        for (unsigned j = 0; j < 16; ++j) { const unsigned c = xb_ld(&bar[XB_XCNT(j)]); sum += c; cnt += (c > 0u) ? 1u : 0u; mine = (j == x) ? c : mine; }
        if (sum == G) break;
        __builtin_amdgcn_s_sleep(1);
        if ((++sp & 255u) == 0u) { if (xb_ld(&bar[XB_TMO])) break; if (sp > XB_SPIN_CAP) { atomicAdd(&bar[XB_TMO], 1u); break; } }
    }
    nloc = mine > 0u ? mine : 1u; nx = cnt > 0u ? cnt : 1u;
}

__device__ __forceinline__ void xcd_barrier(const XcdBarrier& b) {
    asm volatile("s_waitcnt vmcnt(0)" ::: "memory");
    __syncthreads();
    if (threadIdx.x == 0) {
        unsigned* bar = b.bar;
        __builtin_amdgcn_s_waitcnt(0);
        unsigned nloc = b.st[0], nx = b.st[1];
        if (nloc == 0u) { xcd_barrier_complete(bar, b.x, nloc, nx); b.st[0] = nloc; b.st[1] = nx; }
        const unsigned old = xb_add(&bar[XB_XSUB(b.x)], 1u);
        const unsigned gen = old / nloc;
        if (old + 1u == (gen + 1u) * nloc) {
            __builtin_amdgcn_fence(__ATOMIC_RELEASE, "agent");
            asm volatile("s_waitcnt vmcnt(0)" ::: "memory");
            const unsigned og = xb_add(&bar[XB_TOP], 1u);
            const unsigned tg = og / nx;
            if (og + 1u == (tg + 1u) * nx) xb_add(&bar[XB_TOPGEN], 1u);
            else XB_SPIN(xb_ld(&bar[XB_TOPGEN]) == tg, bar);
            __builtin_amdgcn_fence(__ATOMIC_ACQUIRE, "agent");
            xb_add(&bar[XB_XGEN(b.x)], 1u);
            asm volatile("s_waitcnt vmcnt(0)" ::: "memory");
        } else {
            XB_SPIN(xb_ld(&bar[XB_XGEN(b.x)]) == gen, bar);
            __builtin_amdgcn_fence(__ATOMIC_ACQUIRE, "agent");
            asm volatile("s_waitcnt vmcnt(0)" ::: "memory");
        }
    }
    __syncthreads();
}

#ifndef ONE_LAUNCH
#define ONE_LAUNCH 1
#endif
constexpr int NPH = 13;
__global__ void __launch_bounds__(NTHREADS, 2) fwd_kernel(Args a) {
    extern __shared__ __attribute__((aligned(16))) unsigned char lds_raw[];
    LAS unsigned char* lds = (LAS unsigned char*)lds_raw;
    const int tid = threadIdx.x, lane = tid & 63, wave = __builtin_amdgcn_readfirstlane(tid >> 6), bid = blockIdx.x, G = gridDim.x;
    unsigned char* ws = a.ws;
    const int lo = a.ph_lo, hi = a.ph_hi;
    volatile LAS unsigned* bst = (volatile LAS unsigned*)(lds + LDS_BYTES - 16);
    if (tid < 2) bst[tid] = 0u;
    __syncthreads();
    XcdBarrier xbar = xcd_barrier_post((unsigned*)(a.ws + WS_BAR), bst);
    const int vb = (G == 256) ? (bid & 7) * 32 + (bid >> 3) : bid;
#define IN(k) (lo <= (k) && (k) < hi)
#define SEAM(k) do { if (IN(k) && IN((k) + 1)) { if (hi > 1000) cg::this_grid().sync(); else xcd_barrier(xbar); } } while (0)
    pg8::EP ep;
    ep.Q = (bf16*)((unsigned char*)a.out + DO_Q); ep.K = (bf16*)(ws + WS_K); ep.V = (bf16*)((unsigned char*)a.out + DO_V); ep.R = (float*)(ws + WS_R);
    ep.GT2 = (bf16*)(ws + WS_GT2); ep.PQ = (bf16*)(ws + WS_PQ); ep.SGA = (bf16*)(ws + WS_SGA); ep.SGF = (bf16*)(ws + WS_SGF); ep.ON = (bf16*)(ws + WS_ON);
    ep.OG = (bf16*)(ws + WS_OG); ep.MG = (bf16*)(ws + WS_MG); ep.H1B = (bf16*)(ws + WS_H1B); ep.HF = (bf16*)(ws + WS_HF);
    ep.x = a.x; ep.H = a.out; ep.PART1 = (float*)(ws + WS_PART1); ep.gnorm = a.gla_norm;
    const bf16* ALL = (const bf16*)(ws + WS_ALL);

    if (IN(0)) { p0_prologue(a, lds, tid, lane, wave, bid, G); }
    SEAM(0);
    if (IN(1)) { pg8::Gemm g{ALL, ALL, 0, 0, 1024}; pg8::Sched S{1, 845, G, vb, 0, 0, 0}; pg8::Epi<1> E{ep};
        pg8::gemm_phase<pg8::Epi<1>, pg8::Sched, true, true>(lds, g, S, E); }
    SEAM(1);
    if (IN(2)) { p2_sym_rem(a, tid, lane, wave, bid, G); }
    SEAM(2);
    if (IN(3)) { pg8::Gemm g{(const bf16*)(ws + WS_CS), (const bf16*)(ws + WS_EOT), 0, 0, KH}; pg8::Sched S{2, 256, G, vb, 0, 0, 0}; pg8::Epi<2> E{ep};
        pg8::gemm_phase<pg8::Epi<2>, pg8::Sched, true, true>(lds, g, S, E); }
    SEAM(3);
    if (IN(4)) { p4_gla_prep(a, lds, tid, lane, wave, bid, G); p4_combine(a, tid, bid, G); }
    SEAM(4);
    if (IN(5)) { p5_scan(a, lds, tid, lane, wave, vb, G); }
    SEAM(5);
    if (IN(6)) { p6_post(a, lane, wave, bid, G);
        pg8::Gemm g{ALL, ALL, 0, 0, 1024}; pg8::Sched S{3, 512, G, vb, 8, 0, 82}; pg8::Epi<3> E{ep};
        pg8::gemm_phase<pg8::Epi<3>, pg8::Sched, true, true>(lds, g, S, E); }
    SEAM(6);
    if (IN(7)) {
        { pg8::Gemm g{ALL, ALL, 0, 0, 1024}; pg8::Sched S{3, 256, G, vb, 4, 0, 78}; pg8::Epi<4> E{ep};
          pg8::gemm_phase<pg8::Epi<4>, pg8::Sched, true, true>(lds, g, S, E); }
        { pg8::Gemm g{(const bf16*)(ws + WS_FN), (const bf16*)(ws + WS_WFT), 0, 0, 512}; pg8::Sched S{3, 256, G, vb, 4, 0, 0}; pg8::Epi<5> E{ep};
          pg8::gemm_phase<pg8::Epi<5>, pg8::Sched, true, true>(lds, g, S, E); }
    }
    SEAM(7);
    if (IN(8)) { pg8::Gemm g{(const bf16*)(ws + WS_OG), (const bf16*)(ws + WS_WOT), 0, 0, 1024}; pg8::Sched S{3, 256, G, vb, 4, 0, 0}; pg8::Epi<6> E{ep};
        pg8::gemm_phase<pg8::Epi<6>, pg8::Sched, true, true>(lds, g, S, E); }
    SEAM(8);
    if (IN(9)) { pg8::Gemm g{(const bf16*)(ws + WS_MG), (const bf16*)(ws + WS_WOUTT), 0, 0, 1024}; pg8::Sched S{3, 256, G, vb, 4, 0, 0}; pg8::Epi<7> E{ep};
        pg8::gemm_phase<pg8::Epi<7>, pg8::Sched, true, true>(lds, g, S, E); }
    SEAM(9);
    if (IN(10)) { pg8::Gemm g{(const bf16*)(ws + WS_H1B), (const bf16*)(ws + WS_W1T), 0, 0, 1024}; pg8::Sched S{3, 1024, G, vb, 16, 0, 0}; pg8::Epi<8> E{ep};
        pg8::gemm_phase<pg8::Epi<8>, pg8::Sched, true, true>(lds, g, S, E); }
    SEAM(10);
    if (IN(11)) { pg8::Gemm g{(const bf16*)(ws + WS_HF), (const bf16*)(ws + WS_W2T), 0, 0, 4096}; pg8::Sched S{3, 256, G, vb, 4, 0, 0}; pg8::Epi<9> E{ep};
        pg8::gemm_phase<pg8::Epi<9>, pg8::Sched, true, true>(lds, g, S, E); }
    SEAM(11);
    if (IN(12)) { p11_final(a, lane, wave, bid, G); }
#ifdef PROBE_REP
    if (IN(13)) { pg8::Gemm g{(const bf16*)(ws + WS_HF), (const bf16*)(ws + WS_W2T), 0, 0, 4096}; pg8::Sched S{3, 256, G, vb, 4, 0, 0}; pg8::Epi<10> E{ep};
        pg8::gemm_phase<pg8::Epi<10>, pg8::Sched, true, true>(lds, g, S, E); }
    if (IN(14)) { const int gw = bid * NWAVES + wave, NGW = G * NWAVES;
        for (int row = gw; row < NREAL; row += NGW) { f32x4* xr = (f32x4*)(a.out + (size_t)row * D) + lane; float s = 0.f;
            for (int j = 0; j < 4; ++j) { const f32x4 v = xr[64 * j]; s += v.x + v.y + v.z + v.w; }
            if (wave_sum(s) == 123456.789f) xr[0] = (f32x4){s, s, s, s}; } }
#endif
#undef IN
#undef SEAM
}

extern "C" void kernel_launch(void* const* d_in, const int* in_sizes, int n_in, void* d_out, int out_size, void* d_ws, size_t ws_size, hipStream_t stream) {
    static int grid = 0;
    if (grid == 0) {
        int dev = 0, cus = 0, per_cu = 0;
        (void)hipGetDevice(&dev); (void)hipDeviceGetAttribute(&cus, hipDeviceAttributeMultiprocessorCount, dev);
        (void)hipFuncSetAttribute((const void*)fwd_kernel, hipFuncAttributeMaxDynamicSharedMemorySize, LDS_BYTES);
        (void)hipOccupancyMaxActiveBlocksPerMultiprocessor(&per_cu, (const void*)fwd_kernel, NTHREADS, LDS_BYTES);
        (void)hipGetLastError();
        if (per_cu < 1) { fprintf(stderr, "kernel_launch: occupancy query says %d blocks/CU\n", per_cu); per_cu = 1; }
        grid = cus * 1;
        if (grid > 256) grid = 256;
    }
    (void)hipMemsetAsync((char*)d_ws + WS_BAR, 0, 16384, stream);
    Args a{};
    const float* const* in = (const float* const*)d_in;
    a.x = in[0]; a.meta = in[1]; a.norm_mix = in[2]; a.w_in = in[3]; a.wdf = in[4]; a.bdf = in[5]; a.wdb = in[6]; a.bdb = in[7]; a.gla_norm = in[8];
    a.w_o = in[9]; a.w_fnet = in[10]; a.w_out = in[11]; a.norm_ffn = in[12]; a.w_ff1 = in[13]; a.w_ff2 = in[14]; a.norm_final = in[15];
    a.out = (float*)d_out; a.ws = (unsigned char*)d_ws;
#if ONE_LAUNCH
    a.ph_lo = 0; a.ph_hi = NPH;
    void* args[] = {&a};
    hipError_t e = hipLaunchCooperativeKernel((const void*)fwd_kernel, dim3(grid), dim3(NTHREADS), args, LDS_BYTES, stream);
    if (e != hipSuccess) fprintf(stderr, "cooperative launch failed: %s (grid %d)\n", hipGetErrorString(e), grid);
#else
    for (int p = 0; p < NPH; ++p) { a.ph_lo = p; a.ph_hi = p + 1; hipLaunchKernelGGL(fwd_kernel, dim3(grid), dim3(NTHREADS), LDS_BYTES, stream, a);
#ifdef PROBE_REP
        if (p == PROBE_REP) for (int q = 0; q < PROBE_N; ++q) hipLaunchKernelGGL(fwd_kernel, dim3(grid), dim3(NTHREADS), LDS_BYTES, stream, a);
#ifdef PROBE_DRY
        if (p == PROBE_AFTER) { Args a2 = a; a2.ph_lo = PROBE_DRY; a2.ph_hi = PROBE_DRY + 1; for (int q = 0; q < PROBE_N; ++q) hipLaunchKernelGGL(fwd_kernel, dim3(grid), dim3(NTHREADS), LDS_BYTES, stream, a2); }
#endif
#endif
    }
#endif
}
```

```cpp
#include <hip/hip_runtime.h>
#include <hip/hip_cooperative_groups.h>
#include <cstdio>
#include <cstdint>
namespace cg = cooperative_groups;
namespace pg8 {
#define PG8_LAS __attribute__((address_space(3)))
typedef unsigned short bf16_t;
typedef short bf16x8 __attribute__((ext_vector_type(8)));
typedef float f32x4 __attribute__((ext_vector_type(4)));
typedef unsigned u32x4 __attribute__((ext_vector_type(4)));
constexpr int BM = 256, BK = 64, HALF = 128, HTB = HALF * BK * 2  , STAGE_BYTES = 8 * HTB, NXCD = 8, WGM = 8;

__host__ __device__ __forceinline__ int lds_byte(int r, int c) { const int st = (r >> 4) * 2 + (c >> 5), rr = r & 15, cc = c & 31, ob = rr * 64 + cc * 2; return st * 1024 + (ob ^ (((ob >> 9) & 1) << 5)); }
__host__ __device__ __forceinline__ void stage_rc(int b, int& R, int& C) { const int st = b / 1024, sb = b % 1024, swz = sb ^ (((sb >> 9) & 1) << 5); R = (st >> 1) * 16 + swz / 64; C = (st & 1) * 32 + (swz % 64) / 2; }
__host__ __device__ __forceinline__ int perm32(int rho) { const int n = rho >> 4, i = rho & 15; return 8 * (i >> 2) + 4 * n + (i & 3); }

struct Unit { int pm, pn; };
struct Gemm { const bf16_t* A; const bf16_t* Bt; int M, N, K; };

__device__ __forceinline__ unsigned cvt_pk_bf16(float lo, float hi) { unsigned r; asm volatile("v_cvt_pk_bf16_f32 %0, %1, %2" : "=v"(r) : "v"(lo), "v"(hi)); return r; }
__device__ __forceinline__ float bflo(unsigned w) { return __uint_as_float(w << 16); }
__device__ __forceinline__ float bfhi(unsigned w) { return __uint_as_float(w & 0xffff0000u); }

struct Sched {
    int mode, n, G, c, nN, offM, offN;
    __device__ __forceinline__ bool next(int i, Unit& u) const {
        const int L = i * G + c; if (L >= n) return false;
        if (mode == 1) {
            if (L < 585) { u.pm = L / 9; u.pn = 65 + L % 9; }
            else { const int l2 = L - 585; u.pm = 65 + 9 + (l2 & 3); u.pn = l2 >> 2; }
        } else if (mode == 2) {
            const int grp = L >> 6, r = L & 63; u.pm = grp * 16 + (r >> 2); u.pn = grp * 4 + (r & 3);
        } else {
            const int x = (L & 255) >> 5, ul = (L >> 8) * 32 + (L & 31);
            u.pm = 8 * x + (ul & 7) + offM; u.pn = (ul >> 3) + offN; }
        return true;
    }
    __device__ __forceinline__ void a_ready(const Unit&) const {}
    __device__ __forceinline__ void done(const Unit&) const {}
};

struct EP {
    bf16_t *Q, *K, *V; float* R; bf16_t* GT2; bf16_t* PQ; bf16_t *SGA, *SGF, *ON, *OG, *MG, *H1B, *HF;
    const float* x; float* H; float* PART1; const float* gnorm;
};
constexpr int LDG = 8320;
template <int MODE> struct Epi {
    static constexpr bool PERM = true, AFTER_DRAIN = false;
    EP p;
    __device__ __forceinline__ void operator()(const f32x4 (&acc)[2][2][4][2], const Unit& u, int wr, int wc, int fr, int fq) const {
#pragma unroll
        for (int ai = 0; ai < 2; ++ai)
#pragma unroll
            for (int m = 0; m < 4; ++m) {
                const int r = ai * HALF + wr * 64 + m * 16 + fr;
                float ss = 0.f;
                float rstd = 1.f;
                if (MODE == 8) { const float* pp = p.PART1 + (size_t)(u.pm * BM + r) * 16; float s = 0.f;
#pragma unroll
                    for (int t = 0; t < 4; ++t) { const f32x4 q4 = *(const f32x4*)(pp + 4 * t); s += (q4[0] + q4[1]) + (q4[2] + q4[3]); }
                    rstd = 1.0f / sqrtf(s * (1.0f / 1024.0f) + 1e-6f); }
#pragma unroll
                for (int bj = 0; bj < 2; ++bj) {
                    const int c = bj * HALF + wc * 32 + 8 * fq;
                    f32x4 v0 = acc[ai][bj][m][0], v1 = acc[ai][bj][m][1];
                    if (MODE == 1) {
                        if (u.pm < 65) {
                            const int t = u.pn - 65; const size_t row = (size_t)u.pm * BM + r;
                            if (t < 8) {
                                bf16_t* dst; float sc = 1.f;
                                if (t < 2) { dst = p.Q + row * 512 + t * 256 + c; sc = 0.08838834764831845f; }
                                else if (t < 4) dst = p.K + row * 512 + (t - 2) * 256 + c;
                                else dst = p.V + row * 1024 + (t - 4) * 256 + c;
                                u32x4 w; w.x = cvt_pk_bf16(v0[0] * sc, v0[1] * sc); w.y = cvt_pk_bf16(v0[2] * sc, v0[3] * sc); w.z = cvt_pk_bf16(v1[0] * sc, v1[1] * sc); w.w = cvt_pk_bf16(v1[2] * sc, v1[3] * sc);
                                *(u32x4*)dst = w;
                            } else if (c < 32) { float* dst = p.R + row * 32 + c; *(f32x4*)dst = v0; *(f32x4*)(dst + 4) = v1; }
                        } else {
                            const int gcol = (u.pm - 74) * BM + r, cs = gcol >> 9, col = gcol & 511;
                            u32x4 w; w.x = cvt_pk_bf16(v0[0], v0[1]); w.y = cvt_pk_bf16(v0[2], v0[3]); w.z = cvt_pk_bf16(v1[0], v1[1]); w.w = cvt_pk_bf16(v1[2], v1[3]);
                            if (u.pn < 64) { const int b = u.pn >> 5, l = 16 + (u.pn & 31) * 256 + c;
                                *(u32x4*)(p.GT2 + ((size_t)(b * 512 + col) * 2 + cs) * LDG + l) = w; }
                            else if (c == 48 || c == 56) { const int l = c - 48;
                                *(u32x4*)(p.GT2 + ((size_t)(col) * 2 + cs) * LDG + l) = w; *(u32x4*)(p.GT2 + ((size_t)(512 + col) * 2 + cs) * LDG + l) = w; }
                        }
                    } else if (MODE == 2) {
                        const int grp = u.pm >> 4; const size_t idx = (size_t)(u.pm & 15) * BM + r; const int n = (u.pn & 3) * BM + c;
                        u32x4 w; w.x = cvt_pk_bf16(v0[0], v0[1]); w.y = cvt_pk_bf16(v0[2], v0[3]); w.z = cvt_pk_bf16(v1[0], v1[1]); w.w = cvt_pk_bf16(v1[2], v1[3]);
                        *(u32x4*)(p.PQ + ((size_t)grp * 4096 + idx) * 1024 + n) = w;
                    } else if (MODE == 3) {
                        const int t = u.pn - 82; const size_t row = (size_t)u.pm * BM + r;
                        bf16_t* dst = (t < 4 ? p.SGA : p.SGF) + row * 1024 + (t & 3) * 256 + c;
                        float s[8];
#pragma unroll
                        for (int e = 0; e < 4; ++e) { s[e] = 1.f / (1.f + __expf(-v0[e])); s[4 + e] = 1.f / (1.f + __expf(-v1[e])); }
                        u32x4 w; w.x = cvt_pk_bf16(s[0], s[1]); w.y = cvt_pk_bf16(s[2], s[3]); w.z = cvt_pk_bf16(s[4], s[5]); w.w = cvt_pk_bf16(s[6], s[7]);
                        *(u32x4*)dst = w;
                    } else if (MODE == 4) {
                        const int t = u.pn - 78; const size_t off = ((size_t)u.pm * BM + r) * 1024 + t * 256 + c;
                        const u32x4 o = *(const u32x4*)(p.ON + off);
                        float s[8];
#pragma unroll
                        for (int e = 0; e < 4; ++e) { s[e] = v0[e] / (1.f + __expf(-v0[e])); s[4 + e] = v1[e] / (1.f + __expf(-v1[e])); }
                        u32x4 w; w.x = cvt_pk_bf16(s[0] * bflo(o.x), s[1] * bfhi(o.x)); w.y = cvt_pk_bf16(s[2] * bflo(o.y), s[3] * bfhi(o.y));
                        w.z = cvt_pk_bf16(s[4] * bflo(o.z), s[5] * bfhi(o.z)); w.w = cvt_pk_bf16(s[6] * bflo(o.w), s[7] * bfhi(o.w));
                        *(u32x4*)(p.OG + off) = w;
                    } else if (MODE == 5 || MODE == 6) {
                        const size_t off = ((size_t)u.pm * BM + r) * 1024 + u.pn * BM + c;
                        const u32x4 gt = *(const u32x4*)((MODE == 5 ? p.SGF : p.SGA) + off);
                        float s[8] = {v0[0] * bflo(gt.x), v0[1] * bfhi(gt.x), v0[2] * bflo(gt.y), v0[3] * bfhi(gt.y), v1[0] * bflo(gt.z), v1[1] * bfhi(gt.z), v1[2] * bflo(gt.w), v1[3] * bfhi(gt.w)};
                        if (MODE == 6) { const u32x4 mg = *(const u32x4*)(p.MG + off);
                            s[0] += bflo(mg.x); s[1] += bfhi(mg.x); s[2] += bflo(mg.y); s[3] += bfhi(mg.y); s[4] += bflo(mg.z); s[5] += bfhi(mg.z); s[6] += bflo(mg.w); s[7] += bfhi(mg.w); }
                        u32x4 w; w.x = cvt_pk_bf16(s[0], s[1]); w.y = cvt_pk_bf16(s[2], s[3]); w.z = cvt_pk_bf16(s[4], s[5]); w.w = cvt_pk_bf16(s[6], s[7]);
                        *(u32x4*)(p.MG + off) = w;
                    } else if (MODE == 7) {
                        const size_t off = ((size_t)u.pm * BM + r) * 1024 + u.pn * BM + c;
                        const f32x4 x0 = *(const f32x4*)(p.x + off), x1 = *(const f32x4*)(p.x + off + 4);
                        v0 = v0 + x0; v1 = v1 + x1;
                        u32x4 w; w.x = cvt_pk_bf16(v0[0], v0[1]); w.y = cvt_pk_bf16(v0[2], v0[3]); w.z = cvt_pk_bf16(v1[0], v1[1]); w.w = cvt_pk_bf16(v1[2], v1[3]);
                        *(u32x4*)(p.H1B + off) = w;
                        ss += (v0[0] * v0[0] + v0[1] * v0[1]) + (v0[2] * v0[2] + v0[3] * v0[3]) + (v1[0] * v1[0] + v1[1] * v1[1]) + (v1[2] * v1[2] + v1[3] * v1[3]);
                    } else if (MODE == 8) {
                        const size_t off = ((size_t)u.pm * BM + r) * 4096 + u.pn * BM + c;
                        float s[8];
#pragma unroll
                        for (int e = 0; e < 4; ++e) { float a = fmaxf(v0[e] * rstd, 0.f), b = fmaxf(v1[e] * rstd, 0.f); s[e] = a * a; s[4 + e] = b * b; }
                        u32x4 w; w.x = cvt_pk_bf16(s[0], s[1]); w.y = cvt_pk_bf16(s[2], s[3]); w.z = cvt_pk_bf16(s[4], s[5]); w.w = cvt_pk_bf16(s[6], s[7]);
                        *(u32x4*)(p.HF + off) = w;
                    } else if (MODE == 10) {
                        const size_t off = ((size_t)u.pm * BM + r) * 1024 + u.pn * BM + c;
                        const f32x4 x0 = *(const f32x4*)(p.H + off), x1 = *(const f32x4*)(p.H + off + 4);
                        if (v0[0] + x0[0] + x1[1] + v1[2] == 123456.789f) { *(f32x4*)(p.H + off) = v0 + x0; }
                    } else if (MODE == 9) {
                        const size_t off = ((size_t)u.pm * BM + r) * 1024 + u.pn * BM + c;
                        const u32x4 hb = *(const u32x4*)(p.H1B + off);
                        const f32x4 x0 = {bflo(hb.x), bfhi(hb.x), bflo(hb.y), bfhi(hb.y)}, x1 = {bflo(hb.z), bfhi(hb.z), bflo(hb.w), bfhi(hb.w)};
                        *(f32x4*)(p.H + off) = v0 + x0; *(f32x4*)(p.H + off + 4) = v1 + x1;
                    }
                }
                if (MODE == 7) { ss += __shfl_xor(ss, 16); ss += __shfl_xor(ss, 32);
                    if (fq == 0) p.PART1[(size_t)(u.pm * BM + r) * 16 + u.pn * 4 + wc] = ss; }
            }
    }
};
template <class Epi, class Sched, bool ALIGN_EPI = false, bool SP2 = false>
__device__ __forceinline__ void gemm_phase(PG8_LAS unsigned char* lds, const Gemm g, const Sched& S, const Epi& E) {
    const int tid = threadIdx.x, wid = __builtin_amdgcn_readfirstlane(tid >> 6), lane = tid & 63, wr = wid >> 2, wc = wid & 3, fr = lane & 15, fq = lane >> 4;
    const int K = g.K, nt = K / BK;
    unsigned voffA[2], voffB[2];
#pragma unroll
    for (int i = 0; i < 2; ++i) { int R, C; stage_rc(tid * 16 + i * 8192, R, C); const int Rb = Epi::PERM ? ((R & ~31) + perm32(R & 31)) : R;
        voffA[i] = (unsigned)(R * K + C) * 2u; voffB[i] = (unsigned)(Rb * K + C) * 2u; }
    const size_t kstep = (size_t)(BK * 2);
    const size_t hstep = (size_t)HALF * K * 2;
    const size_t tstep = 2 * hstep;
    const unsigned ldsw = (unsigned)wid * 1024u;
    const int aoff = lds_byte(wr * 64 + fr, fq * 8), boff = lds_byte(wc * 32 + fr, fq * 8);
#define PG8_SA(b, h) (((b) * 2 + (h)) * HTB)
#define PG8_SB(b, h) ((4 + (b) * 2 + (h)) * HTB)
#define PG8_STAGE(bufoff, gbase, voff) do { _Pragma("unroll") for (int _i = 0; _i < 2; ++_i) \
        __builtin_amdgcn_global_load_lds((const unsigned*)((const char*)(gbase) + (voff)[_i]), (PG8_LAS unsigned*)(lds + (bufoff) + ldsw + _i * 8192), 16, 0, 0); } while (0)
#define PG8_LDA(dst, b, h) do { _Pragma("unroll") for (int m = 0; m < 4; ++m) _Pragma("unroll") for (int k = 0; k < 2; ++k) dst[m][k] = *(const PG8_LAS bf16x8*)(lds + PG8_SA(b, h) + aoff + m * 2048 + k * 1024); } while (0)
#define PG8_LDB(dst, b, h) do { _Pragma("unroll") for (int n = 0; n < 2; ++n) _Pragma("unroll") for (int k = 0; k < 2; ++k) dst[n][k] = *(const PG8_LAS bf16x8*)(lds + PG8_SB(b, h) + boff + n * 2048 + k * 1024); } while (0)
#define PG8_MMA(ai, bj, At, Bt) do { __builtin_amdgcn_s_setprio(1); _Pragma("unroll") for (int m = 0; m < 4; ++m) _Pragma("unroll") for (int n = 0; n < 2; ++n) _Pragma("unroll") for (int k = 0; k < 2; ++k) \
        acc[ai][bj][m][n] = __builtin_amdgcn_mfma_f32_16x16x32_bf16(Bt[n][k], At[m][k], acc[ai][bj][m][n], 0, 0, 0); __builtin_amdgcn_s_setprio(0); } while (0)
#define PG8_WAIT_V(n) asm volatile("s_waitcnt vmcnt(" #n ")" ::: "memory")
#define PG8_WAIT_L(n) asm volatile("s_waitcnt lgkmcnt(" #n ")" ::: "memory")
#define PG8_BAR __builtin_amdgcn_s_barrier()
#define PG8_SCHED __builtin_amdgcn_sched_barrier(0)
    Unit cur, nxt; int ui = 0;
    if (!S.next(0, cur)) return;
    f32x4 acc[2][2][4][2];
#pragma unroll
    for (int a = 0; a < 2; ++a)
#pragma unroll
        for (int b = 0; b < 2; ++b)
#pragma unroll
            for (int m = 0; m < 4; ++m)
#pragma unroll
                for (int n = 0; n < 2; ++n) acc[a][b][m][n] = (f32x4){0.f, 0.f, 0.f, 0.f};
    bf16x8 At[4][2], B0[2][2], B1[2][2];
    const char* cA = (const char*)g.A + (size_t)cur.pm * tstep; const char* cB = (const char*)g.Bt + (size_t)cur.pn * tstep;
    S.a_ready(cur);
    if constexpr (SP2) {
        PG8_STAGE(PG8_SB(0, 0), cB, voffB); PG8_STAGE(PG8_SB(0, 1), cB + hstep, voffB); PG8_STAGE(PG8_SA(0, 0), cA, voffA); PG8_STAGE(PG8_SA(0, 1), cA + hstep, voffA);
        if (wr == 1) PG8_BAR;
        PG8_WAIT_V(2); PG8_BAR;
        PG8_STAGE(PG8_SB(1, 0), cB + kstep, voffB); PG8_STAGE(PG8_SA(1, 0), cA + kstep, voffA); PG8_STAGE(PG8_SB(1, 1), cB + hstep + kstep, voffB);
        PG8_WAIT_V(6); PG8_BAR;
    } else {
        PG8_STAGE(PG8_SB(0, 0), cB, voffB); PG8_STAGE(PG8_SA(0, 0), cA, voffA); PG8_STAGE(PG8_SB(0, 1), cB + hstep, voffB); PG8_STAGE(PG8_SA(0, 1), cA + hstep, voffA);
        if (wr == 1) PG8_BAR;
        PG8_WAIT_V(4); PG8_BAR;
        PG8_STAGE(PG8_SB(1, 0), cB + kstep, voffB); PG8_STAGE(PG8_SA(1, 0), cA + kstep, voffA); PG8_STAGE(PG8_SB(1, 1), cB + hstep + kstep, voffB);
        PG8_WAIT_V(6); PG8_BAR;
    }
    for (;;) {
        const bool has_next = S.next(ui + 1, nxt);
        const char* nA = has_next ? (const char*)g.A + (size_t)nxt.pm * tstep : cA; const char* nB = has_next ? (const char*)g.Bt + (size_t)nxt.pn * tstep : cB;
        for (int t = 0; t < nt; t += 2) {
            const bool last = (t == nt - 2);
            const char* a1 = cA + (size_t)(t + 1) * kstep;
            const char* a2 = last ? nA : cA + (size_t)(t + 2) * kstep; const char* b2 = last ? nB : cB + (size_t)(t + 2) * kstep;
            const char* a3 = a2 + kstep; const char* b3 = b2 + kstep;
            if (last && has_next) S.a_ready(nxt);
            if constexpr (SP2) {
            PG8_LDB(B0, 0, 0); PG8_LDB(B1, 0, 1); PG8_SCHED; PG8_LDA(At, 0, 0); PG8_STAGE(PG8_SA(1, 1), a1 + hstep, voffA);
            PG8_WAIT_V(8); PG8_WAIT_L(0); PG8_BAR; PG8_MMA(0, 0, At, B0); PG8_MMA(0, 1, At, B1); PG8_BAR; PG8_SCHED;
            PG8_LDA(At, 0, 1); PG8_STAGE(PG8_SB(0, 0), b2, voffB); PG8_STAGE(PG8_SB(0, 1), b2 + hstep, voffB); PG8_STAGE(PG8_SA(0, 0), a2, voffA);
            PG8_WAIT_V(8); PG8_WAIT_L(0); PG8_BAR; PG8_MMA(1, 0, At, B0); PG8_MMA(1, 1, At, B1); PG8_BAR; PG8_SCHED;
            PG8_LDB(B0, 1, 0); PG8_LDB(B1, 1, 1); PG8_SCHED; PG8_LDA(At, 1, 0); PG8_STAGE(PG8_SA(0, 1), a2 + hstep, voffA);
            PG8_WAIT_V(8); PG8_WAIT_L(0); PG8_BAR; PG8_MMA(0, 0, At, B0); PG8_MMA(0, 1, At, B1); PG8_BAR; PG8_SCHED;
            PG8_LDA(At, 1, 1); PG8_STAGE(PG8_SB(1, 0), b3, voffB); PG8_STAGE(PG8_SB(1, 1), b3 + hstep, voffB); PG8_STAGE(PG8_SA(1, 0), a3, voffA);
            PG8_WAIT_V(8); PG8_WAIT_L(0); PG8_BAR; PG8_MMA(1, 0, At, B0); PG8_MMA(1, 1, At, B1); PG8_BAR; PG8_SCHED;
            } else {
            PG8_LDB(B0, 0, 0); PG8_SCHED; PG8_LDA(At, 0, 0); PG8_STAGE(PG8_SA(1, 1), a1 + hstep, voffA);
            PG8_WAIT_L(8); PG8_BAR; PG8_WAIT_L(0); PG8_MMA(0, 0, At, B0); PG8_BAR; PG8_SCHED;
            PG8_LDB(B1, 0, 1); PG8_STAGE(PG8_SB(0, 0), b2, voffB);
            PG8_BAR; PG8_WAIT_L(0); PG8_MMA(0, 1, At, B1); PG8_BAR;
            PG8_LDA(At, 0, 1); PG8_STAGE(PG8_SA(0, 0), a2, voffA);
            PG8_BAR; PG8_WAIT_L(0); PG8_MMA(1, 0, At, B0); PG8_BAR; PG8_SCHED;
            PG8_STAGE(PG8_SB(0, 1), b2 + hstep, voffB);
            PG8_WAIT_V(6); PG8_BAR; PG8_MMA(1, 1, At, B1); PG8_BAR;
            PG8_LDB(B0, 1, 0); PG8_SCHED; PG8_LDA(At, 1, 0); PG8_STAGE(PG8_SA(0, 1), a2 + hstep, voffA);
            PG8_WAIT_L(8); PG8_BAR; PG8_WAIT_L(0); PG8_MMA(0, 0, At, B0); PG8_BAR; PG8_SCHED;
            PG8_LDB(B1, 1, 1); PG8_STAGE(PG8_SB(1, 0), b3, voffB);
            PG8_BAR; PG8_WAIT_L(0); PG8_MMA(0, 1, At, B1); PG8_BAR;
            PG8_LDA(At, 1, 1); PG8_STAGE(PG8_SA(1, 0), a3, voffA);
            PG8_BAR; PG8_WAIT_L(0); PG8_MMA(1, 0, At, B0); PG8_BAR; PG8_SCHED;
            PG8_STAGE(PG8_SB(1, 1), b3 + hstep, voffB);
            PG8_WAIT_V(6); PG8_BAR; PG8_MMA(1, 1, At, B1); PG8_BAR;
            }
        }
        if constexpr (ALIGN_EPI) { if (wr == 0) PG8_BAR; }
        if constexpr (!Epi::AFTER_DRAIN) { E(acc, cur, wr, wc, fr, fq); S.done(cur); }
        if (!has_next) break;
#pragma unroll
        for (int a = 0; a < 2; ++a)
#pragma unroll
            for (int b = 0; b < 2; ++b)
#pragma unroll
                for (int m = 0; m < 4; ++m)
#pragma unroll
                    for (int n = 0; n < 2; ++n) acc[a][b][m][n] = (f32x4){0.f, 0.f, 0.f, 0.f};
        cur = nxt; cA = nA; cB = nB; ++ui;
        if constexpr (ALIGN_EPI) { if (wr == 1) PG8_BAR; }
    }
    PG8_WAIT_V(0);
    if constexpr (!ALIGN_EPI) { if (wr == 0) PG8_BAR; }
    PG8_BAR;
    if constexpr (Epi::AFTER_DRAIN) { E.fused(acc, cur, wr, wc, fr, fq, lds, wid, lane); S.done(cur); }
#undef PG8_SA
#undef PG8_SB
#undef PG8_STAGE
#undef PG8_LDA
#undef PG8_LDB
#undef PG8_MMA
#undef PG8_WAIT_V
#undef PG8_WAIT_L
#undef PG8_BAR
#undef PG8_SCHED
}
}
#define LAS __attribute__((address_space(3)))
#define DI __device__ __forceinline__
typedef unsigned short bf16;
typedef unsigned v4u __attribute__((ext_vector_type(4)));
typedef unsigned v2u __attribute__((ext_vector_type(2)));
typedef float f32x4 __attribute__((ext_vector_type(4)));
typedef short bf16x8 __attribute__((ext_vector_type(8)));
constexpr int NTHREADS = 512, NWAVES = 8;
constexpr int D = 1024, NREAL = 16384, MROWS = 16640, LSEQ = 8208, FF = 4096, DIN = 5664, NCHUNK = 129;
constexpr int LDG = 8320, KH = 2176;
constexpr size_t MiB = 1u << 20;
constexpr size_t WS_PART1 = 0;
constexpr size_t WS_ALL = 1 * MiB;
constexpr size_t WS_WOT = 46 * MiB, WS_WFT = 48 * MiB, WS_WOUTT = 49 * MiB, WS_W1T = 51 * MiB, WS_W2T = 59 * MiB;
constexpr size_t WS_TAB = 67 * MiB;
constexpr size_t WS_CS = 68 * MiB + 512 * 1024;
constexpr size_t WS_GT2 = 136 * MiB + 512 * 1024;
constexpr size_t WS_EOT = 169 * MiB;
constexpr size_t WS_REMP = 186 * MiB;
constexpr size_t WS_PQ = 189 * MiB;
constexpr size_t WS_K = 221 * MiB;
constexpr size_t WS_R = 237 * MiB + 512 * 1024;
constexpr size_t WS_FN = 240 * MiB;
constexpr size_t DO_V = 0, DO_Q = 33 * MiB, DO_OB = 0;
constexpr size_t WS_REC = 69 * MiB;
constexpr size_t REC_BYTES = 43008, REC_KDT = 16384, REC_PM = 32768, REC_DEC = 40960;
constexpr size_t WS_QI_UNUSED = 69 * MiB;
constexpr size_t WS_KDT = 102 * MiB;
constexpr size_t WS_VT = 153 * MiB + 768 * 1024;
constexpr size_t WS_PM = 168 * MiB;
constexpr size_t WS_DEC = 184 * MiB + 512 * 1024;
constexpr size_t WS_OF = 189 * MiB;
constexpr size_t WS_ON = 69 * MiB, WS_SGA = 101 * MiB, WS_SGF = 133 * MiB, WS_OG = 165 * MiB, WS_MG = 197 * MiB;
constexpr size_t WS_H1B = 69 * MiB, WS_HF = 101 * MiB;
constexpr int LDS_BYTES = 155648;
struct Args {
    const float *x, *meta, *norm_mix, *w_in, *wdf, *bdf, *wdb, *bdb, *gla_norm, *w_o, *w_fnet, *w_out, *norm_ffn, *w_ff1, *w_ff2, *norm_final;
    float* out; unsigned char* ws; int ph_lo, ph_hi;
};
DI unsigned f2bf(float f) { unsigned u = __builtin_bit_cast(unsigned, f); return (u + 0x7fffu + ((u >> 16) & 1u)) >> 16; }
DI unsigned pk2(float lo, float hi) { return f2bf(lo) | (f2bf(hi) << 16); }
typedef float f32x2_t __attribute__((ext_vector_type(2)));
typedef __bf16 bf16x2_t __attribute__((ext_vector_type(2)));
DI unsigned cvtpk(float lo, float hi) { f32x2_t v = {lo, hi}; bf16x2_t b = __builtin_convertvector(v, bf16x2_t); return __builtin_bit_cast(unsigned, b); }
DI float bf2f(unsigned h) { return __uint_as_float(h << 16); }
DI float wave_sum(float v) {
#pragma unroll
    for (int o = 1; o < 64; o <<= 1) v += __shfl_xor(v, o);
    return v;
}
DI void transpose_item(const float* W, int pitch, int K, int ncols, bf16* WT, int row_off, LAS float* scr, int item, int lane, const float* kscale) {
    const int nblk = ncols / 32, kb = item / nblk, nb = item % nblk, k0 = 64 * kb, n0 = 32 * nb;
#pragma unroll 8
    for (int i = 0; i < 32; ++i) { const int kk = 2 * i + (lane >> 5); float v = W[(size_t)(k0 + kk) * pitch + n0 + (lane & 31)]; if (kscale) v *= kscale[k0 + kk]; scr[kk * 33 + (lane & 31)] = v; }
    asm volatile("s_waitcnt lgkmcnt(0)" ::: "memory");
    const int c = lane & 7;
#pragma unroll
    for (int j = 0; j < 4; ++j) { const int n = (lane >> 3) + 8 * j; const LAS float* s = scr + (8 * c) * 33 + n;
        v4u o; o.x = pk2(s[0 * 33], s[1 * 33]); o.y = pk2(s[2 * 33], s[3 * 33]); o.z = pk2(s[4 * 33], s[5 * 33]); o.w = pk2(s[6 * 33], s[7 * 33]);
        *(v4u*)(WT + (size_t)(row_off + n0 + n) * K + k0 + 8 * c) = o; }
    asm volatile("s_waitcnt lgkmcnt(0)" ::: "memory");
}
DI void rms_row_to_bf16(const float* xrow, const float* gain, bf16* orow, int lane) {
    const f32x4* xr = (const f32x4*)xrow + lane; const f32x4* gr = (const f32x4*)gain + lane;
    f32x4 v[4]; float s = 0.f;
#pragma unroll
    for (int j = 0; j < 4; ++j) { v[j] = xr[64 * j]; s += (v[j].x * v[j].x + v[j].y * v[j].y) + (v[j].z * v[j].z + v[j].w * v[j].w); }
    const float rstd = 1.f / sqrtf(wave_sum(s) * (1.f / 1024.f) + 1e-6f);
    unsigned long long* o8 = (unsigned long long*)orow + lane;
#pragma unroll
    for (int j = 0; j < 4; ++j) { const f32x4 g = gr[64 * j];
        o8[64 * j] = (unsigned long long)pk2(v[j].x * rstd * g.x, v[j].y * rstd * g.y) | ((unsigned long long)pk2(v[j].z * rstd * g.z, v[j].w * rstd * g.w) << 32); }
}

DI void gen_cs_tab(const Args& a, LAS unsigned char* lds, int tid, int vbi, int nb) {
    unsigned char* ws = a.ws;
    const int gt = vbi * NTHREADS + tid, NGT = nb * NTHREADS;
    LAS float* tabc = (LAS float*)lds; LAS float* tabs = tabc + LSEQ;
    __syncthreads();
    for (int j = tid; j < LSEQ; j += NTHREADS) { const float ang = 6.283185307179586f * (float)j / (float)LSEQ; tabc[j] = __cosf(ang); tabs[j] = __sinf(ang); }
    __syncthreads();
    {
        bf16* CS = (bf16*)(ws + WS_CS);
        const int nchunk = 4 * 4096 * (KH / 8);
        for (int ch = gt; ch < nchunk; ch += NGT) {
            const int k8 = ch % (KH / 8); const int rest = ch / (KH / 8); const int idx = rest & 4095, grp = rest >> 12, cs = grp >> 1, kh = grp & 1;
            const int m = idx + 9, l0 = kh * KH + k8 * 8;
            unsigned j = ((unsigned)l0 * (unsigned)m) % (unsigned)LSEQ;
            float v[8];
#pragma unroll
            for (int e = 0; e < 8; ++e) { v[e] = (l0 + e <= 4104) ? (cs ? tabs[j] : tabc[j]) : 0.f; j += m; if (j >= (unsigned)LSEQ) j -= LSEQ; }
            v4u o; o.x = pk2(v[0], v[1]); o.y = pk2(v[2], v[3]); o.z = pk2(v[4], v[5]); o.w = pk2(v[6], v[7]);
            *(v4u*)(CS + (size_t)ch * 8) = o;
        }
        bf16* TAB = (bf16*)(ws + WS_TAB);
        const int nch2 = 32 * 2 * (LDG / 8);
        for (int ch = gt; ch < nch2; ch += NGT) {
            const int l8 = ch % (LDG / 8); const int rest = ch / (LDG / 8); const int cs = rest & 1, rho = rest >> 1;
            const int lp = 8200 + rho, l0 = l8 * 8;
            unsigned j = ((unsigned)l0 * (unsigned)lp) % (unsigned)LSEQ;
            float v[8];
#pragma unroll
            for (int e = 0; e < 8; ++e) { v[e] = (rho < 8 && l0 + e < LSEQ) ? (cs ? -tabs[j] : tabc[j]) : 0.f; j += lp; while (j >= (unsigned)LSEQ) j -= LSEQ; }
            v4u o; o.x = pk2(v[0], v[1]); o.y = pk2(v[2], v[3]); o.z = pk2(v[4], v[5]); o.w = pk2(v[6], v[7]);
            *(v4u*)(TAB + (size_t)ch * 8) = o;
        }
    }
    __syncthreads();
}

DI void p0_prologue(const Args& a, LAS unsigned char* lds, int tid, int lane, int wave, int bid, int G) {
    unsigned char* ws = a.ws;
    bf16* ALL = (bf16*)(ws + WS_ALL);
    const int gw = bid * NWAVES + wave, NGW = G * NWAVES;
    const int gt = bid * NTHREADS + tid, NGT = G * NTHREADS;
    {
        LAS float* Wl = (LAS float*)lds;
        LAS float* c128 = Wl + 64 * 128; LAS float* s128 = c128 + 128;
        if (tid < 128) { const float ang = 6.283185307179586f * (float)tid / 128.f; c128[tid] = __cosf(ang); s128[tid] = __sinf(ang); }
        for (int item = bid; item < 256; item += G) {
            const int kb = item >> 4, g = (item >> 2) & 3, nq = item & 3;
            __syncthreads();
            for (int idx = tid; idx < 64 * 128; idx += NTHREADS) { const int kk = idx >> 7, c = idx & 127; Wl[idx] = a.w_in[(size_t)(kb * 64 + kk) * DIN + 3104 + g * 128 + c]; }
            __syncthreads();
            const int n = nq * 32 + (tid & 31), kg = tid >> 5;
            float ac[4] = {0.f, 0.f, 0.f, 0.f}, as[4] = {0.f, 0.f, 0.f, 0.f};
            const LAS float* w0 = Wl + (kg * 4) * 128;
#pragma unroll 4
            for (int c = 0; c < 128; ++c) { const int j = (c * n) & 127; const float cc = c128[j], ss = s128[j];
#pragma unroll
                for (int q = 0; q < 4; ++q) { const float w = w0[q * 128 + c]; ac[q] += w * cc; as[q] += w * ss; } }
            bf16* dc = ALL + (size_t)(74 * 256 + g * 128 + n) * D + kb * 64 + kg * 4;
            bf16* ds = ALL + (size_t)(76 * 256 + g * 128 + n) * D + kb * 64 + kg * 4;
            *(v2u*)dc = (v2u){pk2(ac[0], ac[1]), pk2(ac[2], ac[3])}; *(v2u*)ds = (v2u){pk2(as[0], as[1]), pk2(as[2], as[3])};
        }
        __syncthreads();
    }
    {
        LAS float* scr = (LAS float*)(lds + wave * 16384);
        bf16* WT = ALL + (size_t)65 * 256 * D;
        const int I_Q = 16 * 16, I_V = 16 * 32, I_R = 16 * 1, I_G = 16 * 32;
        const int I_O = 16 * 32, I_F = 8 * 32, I_1 = 16 * 128, I_2 = 64 * 32;
        const int NIT = 2 * I_Q + I_V + I_R + 3 * I_G + 2 * I_O + I_F + I_1 + I_2;
        for (int it = gw; it < NIT; it += NGW) {
            int r = it;
            if (r < I_Q) { transpose_item(a.w_in + 0, DIN, D, 512, WT, 0, scr, r, lane, nullptr); continue; } r -= I_Q;
            if (r < I_Q) { transpose_item(a.w_in + 512, DIN, D, 512, WT, 512, scr, r, lane, nullptr); continue; } r -= I_Q;
            if (r < I_V) { transpose_item(a.w_in + 1024, DIN, D, 1024, WT, 1024, scr, r, lane, nullptr); continue; } r -= I_V;
            if (r < I_R) { transpose_item(a.w_in + 3072, DIN, D, 32, WT, 2048, scr, r, lane, nullptr); continue; } r -= I_R;
            if (r < I_G) { transpose_item(a.w_in + 2048, DIN, D, 1024, WT, 13 * 256, scr, r, lane, nullptr); continue; } r -= I_G;
            if (r < I_G) { transpose_item(a.w_in + 3616, DIN, D, 1024, WT, 17 * 256, scr, r, lane, nullptr); continue; } r -= I_G;
            if (r < I_G) { transpose_item(a.w_in + 4640, DIN, D, 1024, WT, 21 * 256, scr, r, lane, nullptr); continue; } r -= I_G;
            if (r < I_O) { transpose_item(a.w_o, D, D, 1024, (bf16*)(ws + WS_WOT), 0, scr, r, lane, nullptr); continue; } r -= I_O;
            if (r < I_O) { transpose_item(a.w_out, D, D, 1024, (bf16*)(ws + WS_WOUTT), 0, scr, r, lane, nullptr); continue; } r -= I_O;
            if (r < I_F) { transpose_item(a.w_fnet, D, 512, 1024, (bf16*)(ws + WS_WFT), 0, scr, r, lane, nullptr); continue; } r -= I_F;
            if (r < I_1) { transpose_item(a.w_ff1, FF, D, FF, (bf16*)(ws + WS_W1T), 0, scr, r, lane, a.norm_ffn); continue; } r -= I_1;
            transpose_item(a.w_ff2, D, FF, 1024, (bf16*)(ws + WS_W2T), 0, scr, r, lane, nullptr);
        }
    }
    {
        bf16* t8 = ALL + (size_t)(73 * 256 + 32) * D;
        for (int i = gt; i < 224 * D / 8; i += NGT) *(v4u*)(t8 + (size_t)i * 8) = (v4u){0u, 0u, 0u, 0u};
        bf16* x64 = ALL + (size_t)16384 * D;
        for (int i = gt; i < 256 * D / 8; i += NGT) { const int row = i / (D / 8); if (row < 48 || row >= 64) *(v4u*)(x64 + (size_t)i * 8) = (v4u){0u, 0u, 0u, 0u}; }
        bf16* GT2 = (bf16*)(ws + WS_GT2);
        for (int i = gt; i < 2048 * 14; i += NGT) { const int row = i / 14, c = i % 14; *(v4u*)(GT2 + (size_t)row * LDG + LSEQ + c * 8) = (v4u){0u, 0u, 0u, 0u}; }
    }
    for (int m = gw; m < NREAL + 16; m += NGW) {
        if (m < NREAL) rms_row_to_bf16(a.x + (size_t)m * D, a.norm_mix, ALL + (size_t)m * D, lane);
        else rms_row_to_bf16(a.meta + (size_t)(m - NREAL) * D, a.norm_mix, ALL + (size_t)(NREAL + 48 + (m - NREAL)) * D, lane);
    }
}
DI void p2_sym_rem(const Args& a, int tid, int lane, int wave, int bid, int G) {
    unsigned char* ws = a.ws;
    const bf16* GT2 = (const bf16*)(ws + WS_GT2);
    bf16* EOT = (bf16*)(ws + WS_EOT);
    const int gt = bid * NTHREADS + tid, NGT = G * NTHREADS;
    const int nchunk = 4 * 1024 * (KH / 8);
    for (int ch = gt; ch < nchunk; ch += NGT) {
        const int k8 = ch % (KH / 8); const int rest = ch / (KH / 8); const int n = rest & 1023, grp = rest >> 10, cs = grp >> 1, kh = grp & 1;
        const int l0 = kh * KH + k8 * 8;
        const bf16* src = GT2 + ((size_t)n * 2 + cs) * LDG;
        float v[8];
        if (l0 > 4104) {
#pragma unroll
            for (int e = 0; e < 8; ++e) v[e] = 0.f;
        } else {
            const v4u f = *(const v4u*)(src + l0);
            const float fw[8] = {bf2f(f.x & 0xffffu), bf2f(f.x >> 16), bf2f(f.y & 0xffffu), bf2f(f.y >> 16), bf2f(f.z & 0xffffu), bf2f(f.z >> 16), bf2f(f.w & 0xffffu), bf2f(f.w >> 16)};
#pragma unroll
            for (int e = 0; e < 8; ++e) { const int l = l0 + e;
                if (l > 4104) v[e] = 0.f;
                else if (l == 0 || l == 4104) v[e] = cs ? 0.f : fw[e];
                else { const float mir = bf2f((unsigned)src[LSEQ - l]); v[e] = cs ? fw[e] - mir : fw[e] + mir; } }
        }
        v4u o; o.x = pk2(v[0], v[1]); o.y = pk2(v[2], v[3]); o.z = pk2(v[4], v[5]); o.w = pk2(v[6], v[7]);
        *(v4u*)(EOT + (size_t)ch * 8) = o;
    }
    typedef float f32x16 __attribute__((ext_vector_type(16)));
    const bf16* TAB = (const bf16*)(ws + WS_TAB);
    float* REMP = (float*)(ws + WS_REMP);
    const int gw = bid * NWAVES + wave, NGW = G * NWAVES;
    for (int task = gw; task < 32 * 65; task += NGW) {
        const int nt = task & 31, ks = task >> 5; const int r = lane & 31, h = lane >> 5;
        f32x16 acc; for (int i = 0; i < 16; ++i) acc[i] = 0.f;
        const bf16* ap = TAB + (size_t)r * (2 * LDG) + ks * 256 + 8 * h;
        const bf16* bp = GT2 + (size_t)(nt * 32 + r) * (2 * LDG) + ks * 256 + 8 * h;
#pragma unroll 4
        for (int kk = 0; kk < 16; ++kk) { const bf16x8 af = *(const bf16x8*)(ap + kk * 16), bfr = *(const bf16x8*)(bp + kk * 16);
            acc = __builtin_amdgcn_mfma_f32_32x32x16_bf16(af, bfr, acc, 0, 0, 0); }
#pragma unroll
        for (int i = 0; i < 4; ++i) REMP[((size_t)ks * 8 + i + 4 * h) * 1024 + nt * 32 + r] = acc[i];
    }
}

DI void p4_combine(const Args& a, int tid, int bid, int G) {
    unsigned char* ws = a.ws;
    const bf16* PQ = (const bf16*)(ws + WS_PQ); const float* REMP = (const float*)(ws + WS_REMP); bf16* FN = (bf16*)(ws + WS_FN);
    const float scale = 0.0009756003f;
    const int gt = bid * NTHREADS + tid, NGT = G * NTHREADS;
    for (int ch = gt; ch < NREAL * 64; ch += NGT) {
        const int c8 = ch & 63, row = ch >> 6, b = row >> 13, s = row & 8191, l = s + 16, n = b * 512 + c8 * 8;
        float v[8];
        if (l >= 8200) { const int rho = l - 8200;
#pragma unroll
            for (int e = 0; e < 8; ++e) v[e] = 0.f;
            for (int ks = 0; ks < 65; ++ks) { const f32x4 p0 = *(const f32x4*)(REMP + ((size_t)ks * 8 + rho) * 1024 + n), p1 = *(const f32x4*)(REMP + ((size_t)ks * 8 + rho) * 1024 + n + 4);
                v[0] += p0[0]; v[1] += p0[1]; v[2] += p0[2]; v[3] += p0[3]; v[4] += p1[0]; v[5] += p1[1]; v[6] += p1[2]; v[7] += p1[3]; }
        } else {
            const bool mir = l > 4104; const int idx = (mir ? LSEQ - l : l) - 9; const float sg = mir ? 1.f : -1.f;
            const size_t off = (size_t)idx * 1024 + n;
            const v4u p0 = *(const v4u*)(PQ + off), p1 = *(const v4u*)(PQ + (size_t)4096 * 1024 + off), q0 = *(const v4u*)(PQ + (size_t)2 * 4096 * 1024 + off), q1 = *(const v4u*)(PQ + (size_t)3 * 4096 * 1024 + off);
            const unsigned pp0[4] = {p0.x, p0.y, p0.z, p0.w}, pp1[4] = {p1.x, p1.y, p1.z, p1.w}, qq0[4] = {q0.x, q0.y, q0.z, q0.w}, qq1[4] = {q1.x, q1.y, q1.z, q1.w};
#pragma unroll
            for (int e = 0; e < 4; ++e) {
                v[2 * e] = (bf2f(pp0[e] & 0xffffu) + bf2f(pp1[e] & 0xffffu)) + sg * (bf2f(qq0[e] & 0xffffu) + bf2f(qq1[e] & 0xffffu));
                v[2 * e + 1] = (bf2f(pp0[e] >> 16) + bf2f(pp1[e] >> 16)) + sg * (bf2f(qq0[e] >> 16) + bf2f(qq1[e] >> 16)); }
        }
        v4u o; o.x = pk2(v[0] * scale, v[1] * scale); o.y = pk2(v[2] * scale, v[3] * scale); o.z = pk2(v[4] * scale, v[5] * scale); o.w = pk2(v[6] * scale, v[7] * scale);
        *(v4u*)(FN + (size_t)row * 512 + c8 * 8) = o;
    }
}

DI void p6_post(const Args& a, int lane, int wave, int bid, int G) {
    unsigned char* ws = a.ws;
    const bf16* OF = (const bf16*)(ws + WS_OF); const bf16* OB = (const bf16*)((unsigned char*)a.out + DO_OB); bf16* ON = (bf16*)(ws + WS_ON);
    const int gw = bid * NWAVES + wave, NGW = G * NWAVES;
    const int c0 = lane * 16;
    float gn[16];
#pragma unroll
    for (int e = 0; e < 16; ++e) gn[e] = a.gla_norm[(c0 & 255) + e];
    for (int row = gw; row < NREAL; row += NGW) {
        const size_t off = (size_t)row * 1024 + c0;
        const v4u f0 = *(const v4u*)(OF + off), f1 = *(const v4u*)(OF + off + 8), b0 = *(const v4u*)(OB + off), b1 = *(const v4u*)(OB + off + 8);
        const unsigned fw[8] = {f0.x, f0.y, f0.z, f0.w, f1.x, f1.y, f1.z, f1.w}, bw[8] = {b0.x, b0.y, b0.z, b0.w, b1.x, b1.y, b1.z, b1.w};
        float v[16]; float ss = 0.f;
#pragma unroll
        for (int e = 0; e < 8; ++e) { v[2 * e] = bf2f(fw[e] & 0xffffu) + bf2f(bw[e] & 0xffffu); v[2 * e + 1] = bf2f(fw[e] >> 16) + bf2f(bw[e] >> 16); ss += v[2 * e] * v[2 * e] + v[2 * e + 1] * v[2 * e + 1]; }
        ss += __shfl_xor(ss, 1); ss += __shfl_xor(ss, 2); ss += __shfl_xor(ss, 4); ss += __shfl_xor(ss, 8);
        const float rstd = 1.f / sqrtf(ss * (1.f / 256.f) + 1e-6f);
        unsigned w[8];
#pragma unroll
        for (int e = 0; e < 8; ++e) w[e] = pk2(v[2 * e] * rstd * gn[2 * e], v[2 * e + 1] * rstd * gn[2 * e + 1]);
        *(v4u*)(ON + off) = (v4u){w[0], w[1], w[2], w[3]}; *(v4u*)(ON + off + 8) = (v4u){w[4], w[5], w[6], w[7]};
    }
}

DI void p11_final(const Args& a, int lane, int wave, int bid, int G) {
    const int gw = bid * NWAVES + wave, NGW = G * NWAVES;
    for (int row = gw; row < NREAL; row += NGW) {
        f32x4* xr = (f32x4*)(a.out + (size_t)row * D) + lane; const f32x4* gr = (const f32x4*)a.norm_final + lane;
        f32x4 v[4]; float s = 0.f;
#pragma unroll
        for (int j = 0; j < 4; ++j) { v[j] = xr[64 * j]; s += (v[j].x * v[j].x + v[j].y * v[j].y) + (v[j].z * v[j].z + v[j].w * v[j].w); }
        const float rstd = 1.f / sqrtf(wave_sum(s) * (1.f / 1024.f) + 1e-6f);
#pragma unroll
        for (int j = 0; j < 4; ++j) { const f32x4 g = gr[64 * j]; xr[64 * j] = (f32x4){v[j].x * rstd * g.x, v[j].y * rstd * g.y, v[j].z * rstd * g.z, v[j].w * rstd * g.w}; }
    }
}
DI float logsig(float x) { return fminf(x, 0.f) - __logf(1.f + __expf(-fabsf(x))); }
DI size_t tile_idx(int dir, int b, int h, int c) { return (size_t)((dir * 2 + b) * 4 + h) * NCHUNK + c; }
DI void p4_gla_prep(const Args& a, LAS unsigned char* lds, int tid, int lane, int wave, int bid, int G) {
    unsigned char* ws = a.ws;
    const bf16* Qg = (const bf16*)((unsigned char*)a.out + DO_Q); const bf16* Kg = (const bf16*)(ws + WS_K); const bf16* Vg = (const bf16*)((unsigned char*)a.out + DO_V);
    const float* Rg = (const float*)(ws + WS_R);
    unsigned char* REC = ws + WS_REC; bf16* VT = (bf16*)(ws + WS_VT);
    LAS float* BF = (LAS float*)lds; LAS float* BB = BF + 64 * 128;
    LAS unsigned char* QF = lds + 65536; LAS unsigned char* KF = QF + 17408; LAS unsigned char* QB = KF + 17408; LAS unsigned char* KB = QB + 17408;
    LAS unsigned char* KRAW = lds + 135168;
    LAS float* RS = (LAS float*)QF; LAS float* WD = RS + 64 * 32;
    LAS unsigned char* VS = lds;
    f32x4 rq; v4u q8p[2], k8p[2], v8p[4];
#define PREP_ROW0(t) ((((t) >> 2) % NCHUNK == 0) ? NREAL : ((t) >> 2) / NCHUNK * 8192 + 64 * ((((t) >> 2) % NCHUNK) - 1))
#define PREP_LOAD_QKR(t) do { const int r0_ = PREP_ROW0(t), h_ = (t) & 3; rq = *(const f32x4*)(Rg + (size_t)r0_ * 32 + tid * 4); \
        _Pragma("unroll") for (int rep = 0; rep < 2; ++rep) { const int g_ = tid + NTHREADS * rep, i_ = g_ >> 4, d0_ = (g_ & 15) * 8; \
            q8p[rep] = *(const v4u*)(Qg + (size_t)(r0_ + i_) * 512 + h_ * 128 + d0_); k8p[rep] = *(const v4u*)(Kg + (size_t)(r0_ + i_) * 512 + h_ * 128 + d0_); } } while (0)
#define PREP_LOAD_V(t) do { const int r0_ = PREP_ROW0(t), h_ = (t) & 3; \
        _Pragma("unroll") for (int rep = 0; rep < 4; ++rep) { const int idx_ = tid + NTHREADS * rep, i_ = idx_ >> 5, u_ = idx_ & 31; v8p[rep] = *(const v4u*)(Vg + (size_t)(r0_ + i_) * 1024 + h_ * 256 + u_ * 8); } } while (0)
    if (bid < 2 * NCHUNK * 4) { PREP_LOAD_QKR(bid); PREP_LOAD_V(bid); }
    for (int task = bid; task < 2 * NCHUNK * 4; task += G) {
        const int h = task & 3, c = (task >> 2) % NCHUNK, b = (task >> 2) / NCHUNK;
        const int row0 = (c == 0) ? NREAL : b * 8192 + 64 * (c - 1);
        const bool has_next = task + G < 2 * NCHUNK * 4;
        {
            const int d = tid & 127, part = tid >> 7;
            float wf[16], wb[16];
#pragma unroll
            for (int j = 0; j < 16; ++j) { wf[j] = a.wdf[j * 512 + h * 128 + d]; wb[j] = a.wdb[j * 512 + h * 128 + d]; }
            const float bfw = a.bdf[h * 128 + d], bbw = a.bdb[h * 128 + d];
            *(LAS f32x4*)(RS + tid * 4) = rq;
            __syncthreads();
            float laf[16], lab[16];
#pragma unroll
            for (int ii = 0; ii < 16; ++ii) { const int i = part * 16 + ii; float lf = bfw, lb = bbw;
#pragma unroll
                for (int j4 = 0; j4 < 4; ++j4) { const f32x4 rf = *(const LAS f32x4*)(RS + i * 32 + 4 * j4), rb = *(const LAS f32x4*)(RS + i * 32 + 16 + 4 * j4);
                    lf += rf[0] * wf[4 * j4] + rf[1] * wf[4 * j4 + 1] + rf[2] * wf[4 * j4 + 2] + rf[3] * wf[4 * j4 + 3];
                    lb += rb[0] * wb[4 * j4] + rb[1] * wb[4 * j4 + 1] + rb[2] * wb[4 * j4 + 2] + rb[3] * wb[4 * j4 + 3]; }
                laf[ii] = logsig(lf) * 0.0625f; lab[ii] = logsig(lb) * 0.0625f;
                if (c == 0 && i < 48) { laf[ii] = 0.f; lab[ii] = 0.f; } }
#pragma unroll
            for (int ii = 1; ii < 16; ++ii) laf[ii] += laf[ii - 1];
#pragma unroll
            for (int ii = 14; ii >= 0; --ii) lab[ii] += lab[ii + 1];
            LAS float* TOT = WD;
            TOT[part * 128 + d] = laf[15]; TOT[512 + part * 128 + d] = lab[0];
            __syncthreads();
            float of = 0.f, ob = 0.f;
#pragma unroll
            for (int q = 0; q < 4; ++q) { if (q < part) of += TOT[q * 128 + d]; if (q > part) ob += TOT[512 + q * 128 + d]; }
#pragma unroll
            for (int ii = 0; ii < 16; ++ii) { const int i = part * 16 + ii; BF[i * 128 + d] = laf[ii] + of; BB[i * 128 + d] = lab[ii] + ob; }
            if (part == 3) ((float*)(REC + tile_idx(0, b, h, c) * REC_BYTES + REC_DEC))[d] = __expf(laf[15] + of);
            if (part == 0) ((float*)(REC + tile_idx(1, b, h, c) * REC_BYTES + REC_DEC))[d] = __expf(lab[0] + ob);
        }
        __syncthreads();
#pragma unroll
        for (int rep = 0; rep < 2; ++rep) {
            const int g = tid + NTHREADS * rep, i = g >> 4, d0 = (g & 15) * 8;
            const v4u q8 = q8p[rep], k8 = k8p[rep];
            const unsigned qw[4] = {q8.x, q8.y, q8.z, q8.w}, kw[4] = {k8.x, k8.y, k8.z, k8.w};
            float qf[8], kf[8], qb[8], kb[8], qif[8], qib[8];
#pragma unroll
            for (int e = 0; e < 8; ++e) {
                const int d = d0 + e; const float q = bf2f((e & 1) ? (qw[e >> 1] >> 16) : (qw[e >> 1] & 0xffffu)), k = bf2f((e & 1) ? (kw[e >> 1] >> 16) : (kw[e >> 1] & 0xffffu));
                const float ef = BF[i * 128 + d], eb = BB[i * 128 + d], f31 = BF[31 * 128 + d], b32 = BB[32 * 128 + d];
                qf[e] = q * __expf(ef - f31); kf[e] = k * __expf(f31 - ef); qb[e] = q * __expf(eb - b32); kb[e] = k * __expf(b32 - eb);
                qif[e] = q * __expf(ef); qib[e] = q * __expf(eb);
            }
            *(LAS v4u*)(QF + i * 272 + d0 * 2) = (v4u){pk2(qf[0], qf[1]), pk2(qf[2], qf[3]), pk2(qf[4], qf[5]), pk2(qf[6], qf[7])};
            *(LAS v4u*)(KF + i * 272 + d0 * 2) = (v4u){pk2(kf[0], kf[1]), pk2(kf[2], kf[3]), pk2(kf[4], kf[5]), pk2(kf[6], kf[7])};
            *(LAS v4u*)(QB + i * 272 + d0 * 2) = (v4u){pk2(qb[0], qb[1]), pk2(qb[2], qb[3]), pk2(qb[4], qb[5]), pk2(qb[6], qb[7])};
            *(LAS v4u*)(KB + i * 272 + d0 * 2) = (v4u){pk2(kb[0], kb[1]), pk2(kb[2], kb[3]), pk2(kb[4], kb[5]), pk2(kb[6], kb[7])};
            *(LAS v4u*)(KRAW + i * 256 + d0 * 2) = k8;
            const int kap = d0 >> 5, u = (d0 & 31) >> 3, pc = 32 * kap + 16 * (u & 1) + 4 * (u >> 1);
            bf16* qi_f = (bf16*)(REC + tile_idx(0, b, h, c) * REC_BYTES) + i * 128 + pc; bf16* qi_b = (bf16*)(REC + tile_idx(1, b, h, c) * REC_BYTES) + i * 128 + pc;
            *(v2u*)qi_f = (v2u){pk2(qif[0], qif[1]), pk2(qif[2], qif[3])}; *(v2u*)(qi_f + 8) = (v2u){pk2(qif[4], qif[5]), pk2(qif[6], qif[7])};
            *(v2u*)qi_b = (v2u){pk2(qib[0], qib[1]), pk2(qib[2], qib[3])}; *(v2u*)(qi_b + 8) = (v2u){pk2(qib[4], qib[5]), pk2(qib[6], qib[7])};
        }
        if (has_next) PREP_LOAD_QKR(task + G);
        __syncthreads();
        {
            const int dir = wave >> 2, tq = wave & 3, fr = lane & 15, g = lane >> 4;
            const LAS unsigned char* QX = dir ? QB : QF; const LAS unsigned char* KX = dir ? KB : KF;
            bf16x8 bq[4];
#pragma unroll
            for (int kap = 0; kap < 4; ++kap) bq[kap] = *(const LAS bf16x8*)(QX + (16 * tq + fr) * 272 + (32 * kap + 8 * g) * 2);
            bf16* pm = (bf16*)(REC + tile_idx(dir, b, h, c) * REC_BYTES + REC_PM);
            const int i = 16 * tq + fr;
#pragma unroll
            for (int tk = 0; tk < 4; ++tk) {
                f32x4 acc = {0.f, 0.f, 0.f, 0.f};
#pragma unroll
                for (int kap = 0; kap < 4; ++kap) { const bf16x8 af = *(const LAS bf16x8*)(KX + (16 * tk + fr) * 272 + (32 * kap + 8 * g) * 2);
                    acc = __builtin_amdgcn_mfma_f32_16x16x32_bf16(af, bq[kap], acc, 0, 0, 0); }
                float s[4];
#pragma unroll
                for (int e = 0; e < 4; ++e) { const int j = 16 * tk + 4 * g + e; const bool keep = dir ? (j >= i) : (j <= i); s[e] = keep ? acc[e] : 0.f; }
                *(v2u*)(pm + i * 64 + 16 * tk + 4 * g) = (v2u){pk2(s[0], s[1]), pk2(s[2], s[3])};
            }
        }
        {
            const int d = tid & 127, blk = tid >> 7, i0 = blk * 16;
            const float f63 = BF[63 * 128 + d], b0 = BB[d];
            unsigned wf[8], wb[8];
#pragma unroll
            for (int e2 = 0; e2 < 8; ++e2) {
                const int ia = i0 + 2 * e2, ib = ia + 1;
                const float ka = bf2f((unsigned)*(const LAS unsigned short*)(KRAW + ia * 256 + d * 2)), kb2 = bf2f((unsigned)*(const LAS unsigned short*)(KRAW + ib * 256 + d * 2));
                wf[e2] = pk2(ka * __expf(f63 - BF[ia * 128 + d]), kb2 * __expf(f63 - BF[ib * 128 + d]));
                wb[e2] = pk2(ka * __expf(b0 - BB[ia * 128 + d]), kb2 * __expf(b0 - BB[ib * 128 + d]));
            }
            bf16* kf_ = (bf16*)(REC + tile_idx(0, b, h, c) * REC_BYTES + REC_KDT) + d * 64 + i0; bf16* kb_ = (bf16*)(REC + tile_idx(1, b, h, c) * REC_BYTES + REC_KDT) + d * 64 + i0;
            *(v4u*)kf_ = (v4u){wf[0], wf[1], wf[2], wf[3]}; *(v4u*)(kf_ + 8) = (v4u){wf[4], wf[5], wf[6], wf[7]};
            *(v4u*)kb_ = (v4u){wb[0], wb[1], wb[2], wb[3]}; *(v4u*)(kb_ + 8) = (v4u){wb[4], wb[5], wb[6], wb[7]};
        }
        __syncthreads();
#pragma unroll
        for (int rep = 0; rep < 4; ++rep) { const int idx = tid + NTHREADS * rep, i = idx >> 5, u = idx & 31;
            *(LAS v4u*)(VS + i * 528 + u * 16) = v8p[rep]; }
        if (has_next) PREP_LOAD_V(task + G);
        __syncthreads();
        {
            const int dv = tid & 255, half = tid >> 8; unsigned w[16];
#pragma unroll
            for (int e2 = 0; e2 < 16; ++e2) { const int ia = 32 * half + 2 * e2;
                w[e2] = (unsigned)*(const LAS unsigned short*)(VS + ia * 528 + dv * 2) | ((unsigned)*(const LAS unsigned short*)(VS + (ia + 1) * 528 + dv * 2) << 16); }
            bf16* vt = VT + ((size_t)(b * 4 + h) * NCHUNK + c) * 16384 + dv * 64 + 32 * half;
#pragma unroll
            for (int q4 = 0; q4 < 4; ++q4) *(v4u*)(vt + 8 * q4) = (v4u){w[4 * q4], w[4 * q4 + 1], w[4 * q4 + 2], w[4 * q4 + 3]};
        }
        __syncthreads();
    }
}

constexpr int SC_QI = 0, SC_KDT = 17408, SC_PM = 35840, SC_DEC = 45056, SC_VT = 45568, SC_BUF = 47872, SC_SA = 3 * SC_BUF, SC_NCH = 2720, SC_IT = 22;
DI void scan_load(v4u (&r)[SC_IT], const unsigned char* rec, const unsigned char* vt, int pl) {
#pragma unroll
    for (int it = 0; it < SC_IT - 1; ++it) r[it] = *(const v4u*)(rec + pl * 16 + it * 2048);
    r[SC_IT - 1] = *(const v4u*)(vt + pl * 16);
}
DI void scan_store(LAS unsigned char* buf, const v4u (&r)[SC_IT], int pl) {
#pragma unroll
    for (int it = 0; it < SC_IT - 1; ++it) { const int cid = pl + 128 * it;
        int dst;
        if (cid < 1024) dst = SC_QI + (cid >> 4) * 272 + (cid & 15) * 16;
        else if (cid < 2048) { const int x = cid - 1024; dst = SC_KDT + (x >> 3) * 144 + (x & 7) * 16; }
        else if (cid < 2560) { const int x = cid - 2048; dst = SC_PM + (x >> 3) * 144 + (x & 7) * 16; }
        else dst = SC_DEC + (cid - 2560) * 16;
        if (cid < 2592) *(LAS v4u*)(buf + dst) = r[it]; }
    *(LAS v4u*)(buf + SC_VT + (pl >> 3) * 144 + (pl & 7) * 16) = r[SC_IT - 1];
}
DI void p5_scan(const Args& a, LAS unsigned char* lds, int tid, int lane, int wave, int bid, int G) {
    unsigned char* ws = a.ws;
    const unsigned char* REC = ws + WS_REC; const unsigned char* VT = ws + WS_VT;
    for (int item = bid; item < 256; item += G) {
        const int sl = item & 15, dir = (item >> 4) & 1, h = (item >> 5) & 3, b = item >> 7;
        bf16* O = dir ? (bf16*)((unsigned char*)a.out + DO_OB) : (bf16*)(ws + WS_OF);
        const size_t t0 = tile_idx(dir, b, h, 0); const size_t v0i = (size_t)(b * 4 + h) * NCHUNK;
        const int fr = lane & 15, g = lane >> 4;
#define SCAN_SRC(step) REC + (t0 + (dir ? 128 - (step) : (step))) * REC_BYTES, VT + (v0i + (dir ? 128 - (step) : (step))) * 32768 + sl * 2048
        const bool loader = (wave >= 1 && wave <= 6);
        const int pr = (wave - 1) >> 1, pl = ((wave - 1) & 1) * 64 + lane;
        v4u r[SC_IT];
        __syncthreads();
        if (loader) { scan_load(r, SCAN_SRC(pr), pl); scan_store(lds + pr * SC_BUF, r, pl); scan_load(r, SCAN_SRC(pr + 3), pl); }
        if (wave == 0) *(LAS v4u*)(lds + SC_SA + 4096 + lane * 16) = (v4u){0u, 0u, 0u, 0u}, *(LAS v4u*)(lds + SC_SA + 4096 + 1024 + lane * 16) = (v4u){0u, 0u, 0u, 0u},
                       *(LAS v4u*)(lds + SC_SA + 4096 + 2048 + lane * 16) = (v4u){0u, 0u, 0u, 0u}, *(LAS v4u*)(lds + SC_SA + 4096 + 3072 + lane * 16) = (v4u){0u, 0u, 0u, 0u};
        __syncthreads();
        if (wave == 0) {
#pragma unroll 1
            for (int s = 0; s < NCHUNK; ++s) {
                LAS unsigned char* cur = lds + (s % 3) * SC_BUF;
                const int cs = dir ? 128 - s : s;
                const LAS unsigned char* sap = lds + SC_SA + ((s + 1) & 1) * 4096 + lane * 16;
                bf16x8 sa[4], vf[2];
#pragma unroll
                for (int kap = 0; kap < 4; ++kap) sa[kap] = *(const LAS bf16x8*)(sap + kap * 1024);
#pragma unroll
                for (int kp = 0; kp < 2; ++kp) vf[kp] = *(const LAS bf16x8*)(cur + SC_VT + fr * 144 + (32 * kp + 8 * g) * 2);
#pragma unroll
                for (int t = 0; t < 4; ++t) {
                    f32x4 o = {0.f, 0.f, 0.f, 0.f};
#pragma unroll
                    for (int kap = 0; kap < 4; ++kap) { const bf16x8 qf = *(const LAS bf16x8*)(cur + SC_QI + (16 * t + fr) * 272 + (32 * kap + 8 * g) * 2);
                        o = __builtin_amdgcn_mfma_f32_16x16x32_bf16(sa[kap], qf, o, 0, 0, 0); }
#pragma unroll
                    for (int kp = 0; kp < 2; ++kp) { const bf16x8 pf = *(const LAS bf16x8*)(cur + SC_PM + (16 * t + fr) * 144 + (32 * kp + 8 * g) * 2);
                        o = __builtin_amdgcn_mfma_f32_16x16x32_bf16(vf[kp], pf, o, 0, 0, 0); }
                    if (cs != 0) { const size_t row = (size_t)b * 8192 + 64 * (cs - 1) + 16 * t + fr;
                        *(v2u*)(O + row * 1024 + h * 256 + 16 * sl + 4 * g) = (v2u){cvtpk(o[0], o[1]), cvtpk(o[2], o[3])}; }
                }
                __syncthreads();
            }
        } else if (wave == 7) {
            f32x4 S[8];
#pragma unroll
            for (int j = 0; j < 8; ++j) S[j] = (f32x4){0.f, 0.f, 0.f, 0.f};
#pragma unroll 1
            for (int s = 0; s < NCHUNK; ++s) {
                LAS unsigned char* cur = lds + (s % 3) * SC_BUF;
                bf16x8 vf[2];
#pragma unroll
                for (int kp = 0; kp < 2; ++kp) vf[kp] = *(const LAS bf16x8*)(cur + SC_VT + fr * 144 + (32 * kp + 8 * g) * 2);
#pragma unroll
                for (int j = 0; j < 8; ++j) { const f32x4 dc = *(const LAS f32x4*)(cur + SC_DEC + (16 * j + 4 * g) * 4); S[j] = S[j] * dc; }
#pragma unroll
                for (int j = 0; j < 8; ++j)
#pragma unroll
                    for (int kp = 0; kp < 2; ++kp) { const bf16x8 kf = *(const LAS bf16x8*)(cur + SC_KDT + (16 * j + fr) * 144 + (32 * kp + 8 * g) * 2);
                        S[j] = __builtin_amdgcn_mfma_f32_16x16x32_bf16(kf, vf[kp], S[j], 0, 0, 0); }
                LAS unsigned char* sap = lds + SC_SA + (s & 1) * 4096 + lane * 16;
#pragma unroll
                for (int kap = 0; kap < 4; ++kap) { const f32x4 lo = S[2 * kap], hi = S[2 * kap + 1];
                    *(LAS v4u*)(sap + kap * 1024) = (v4u){cvtpk(lo[0], lo[1]), cvtpk(lo[2], lo[3]), cvtpk(hi[0], hi[1]), cvtpk(hi[2], hi[3])}; }
                __syncthreads();
            }
        } else {
#pragma unroll 1
            for (int s = 0; s < NCHUNK; ++s) {
                if (s >= 1 && s + 2 < NCHUNK && (s + 2) % 3 == pr) { __builtin_amdgcn_s_sleep(6); scan_store(lds + ((s + 2) % 3) * SC_BUF, r, pl); if (s + 5 < NCHUNK) scan_load(r, SCAN_SRC(s + 5), pl); }
                __syncthreads();
            }
        }
#undef SCAN_SRC
    }
}
constexpr size_t WS_BAR = 68 * MiB + 256 * 1024;
#define XB_TMO      128
#define XB_XCNT(j)  (256  + 64 * (j))
#define XB_XSUB(j)  (1280 + 64 * (j))
#define XB_XGEN(j)  (2304 + 64 * (j))
#define XB_TOP      3328
#define XB_TOPGEN   3392
#define XCD_BAR_WORDS 3456
#define XB_SPIN_CAP (1u << 18)

__device__ __forceinline__ unsigned xb_ld(unsigned* p)              { return __hip_atomic_load(p, __ATOMIC_RELAXED, __HIP_MEMORY_SCOPE_AGENT); }
__device__ __forceinline__ unsigned xb_add(unsigned* p, unsigned v) { return __hip_atomic_fetch_add(p, v, __ATOMIC_RELAXED, __HIP_MEMORY_SCOPE_AGENT); }
__device__ __forceinline__ unsigned xb_xcc_id() { return (unsigned)__builtin_amdgcn_s_getreg((3 << 11) | 20) & 0xFu; }
#define XB_SPIN(cond, bar) do { unsigned _sp = 0; while (cond) { __builtin_amdgcn_s_sleep(1); \
    if ((++_sp & 255u) == 0u) { if (xb_ld(&(bar)[XB_TMO])) break; if (_sp > XB_SPIN_CAP) { atomicAdd(&(bar)[XB_TMO], 1u); break; } } } } while (0)

struct XcdBarrier {
    unsigned* bar; unsigned x;
    volatile LAS unsigned* st;
};

__device__ __forceinline__ XcdBarrier xcd_barrier_post(unsigned* bar, volatile LAS unsigned* st) {
    XcdBarrier b; b.bar = bar; b.x = xb_xcc_id(); b.st = st;
    if (threadIdx.x == 0) (void)xb_add(&bar[XB_XCNT(b.x)], 1u);
    return b;
}
__device__ __forceinline__ void xcd_barrier_complete(unsigned* bar, unsigned x, unsigned& nloc, unsigned& nx) {
    const unsigned G = gridDim.x * gridDim.y * gridDim.z;
    unsigned sum, cnt, mine, sp = 0u;
    for (;;) {
        sum = 0u; cnt = 0u; mine = 0u;
#pragma unroll
        for (unsigned j = 0; j < 16; ++j) { const unsigned c = xb_ld(&bar[XB_XCNT(j)]); sum += c; cnt += (c > 0u) ? 1u : 0u; mine = (j == x) ? c : mine; }
        if (sum == G) break;
        __builtin_amdgcn_s_sleep(1);
        if ((++sp & 255u) == 0u) { if (xb_ld(&bar[XB_TMO])) break; if (sp > XB_SPIN_CAP) { atomicAdd(&bar[XB_TMO], 1u); break; } }
    }
    nloc = mine > 0u ? mine : 1u; nx = cnt > 0u ? cnt : 1u;
}

__device__ __forceinline__ void xcd_barrier(const XcdBarrier& b) {
    asm volatile("s_waitcnt vmcnt(0)" ::: "memory");
    __syncthreads();
    if (threadIdx.x == 0) {
        unsigned* bar = b.bar;
        __builtin_amdgcn_s_waitcnt(0);
        unsigned nloc = b.st[0], nx = b.st[1];
        if (nloc == 0u) { xcd_barrier_complete(bar, b.x, nloc, nx); b.st[0] = nloc; b.st[1] = nx; }
        const unsigned old = xb_add(&bar[XB_XSUB(b.x)], 1u);
        const unsigned gen = old / nloc;
        if (old + 1u == (gen + 1u) * nloc) {
            __builtin_amdgcn_fence(__ATOMIC_RELEASE, "agent");
            asm volatile("s_waitcnt vmcnt(0)" ::: "memory");
            const unsigned og = xb_add(&bar[XB_TOP], 1u);
            const unsigned tg = og / nx;
            if (og + 1u == (tg + 1u) * nx) xb_add(&bar[XB_TOPGEN], 1u);
            else XB_SPIN(xb_ld(&bar[XB_TOPGEN]) == tg, bar);
            __builtin_amdgcn_fence(__ATOMIC_ACQUIRE, "agent");
            xb_add(&bar[XB_XGEN(b.x)], 1u);
            asm volatile("s_waitcnt vmcnt(0)" ::: "memory");
        } else {
            XB_SPIN(xb_ld(&bar[XB_XGEN(b.x)]) == gen, bar);
            __builtin_amdgcn_fence(__ATOMIC_ACQUIRE, "agent");
            asm volatile("s_waitcnt vmcnt(0)" ::: "memory");
        }
    }
    __syncthreads();
}

#ifndef ONE_LAUNCH
#define ONE_LAUNCH 1
#endif
constexpr int NPH = 13;
__global__ void __launch_bounds__(NTHREADS, 2) fwd_kernel(Args a) {
    extern __shared__ __attribute__((aligned(16))) unsigned char lds_raw[];
    LAS unsigned char* lds = (LAS unsigned char*)lds_raw;
    const int tid = threadIdx.x, lane = tid & 63, wave = __builtin_amdgcn_readfirstlane(tid >> 6), bid = blockIdx.x, G = gridDim.x;
    unsigned char* ws = a.ws;
    const int lo = a.ph_lo, hi = a.ph_hi;
    volatile LAS unsigned* bst = (volatile LAS unsigned*)(lds + LDS_BYTES - 16);
    if (tid < 2) bst[tid] = 0u;
    __syncthreads();
    XcdBarrier xbar = xcd_barrier_post((unsigned*)(a.ws + WS_BAR), bst);
    const int vb = (G == 256) ? (bid & 7) * 32 + (bid >> 3) : bid;
#define IN(k) (lo <= (k) && (k) < hi)
#define SEAM(k) do { if (IN(k) && IN((k) + 1)) { if (hi > 1000) cg::this_grid().sync(); else xcd_barrier(xbar); } } while (0)
    pg8::EP ep;
    ep.Q = (bf16*)((unsigned char*)a.out + DO_Q); ep.K = (bf16*)(ws + WS_K); ep.V = (bf16*)((unsigned char*)a.out + DO_V); ep.R = (float*)(ws + WS_R);
    ep.GT2 = (bf16*)(ws + WS_GT2); ep.PQ = (bf16*)(ws + WS_PQ); ep.SGA = (bf16*)(ws + WS_SGA); ep.SGF = (bf16*)(ws + WS_SGF); ep.ON = (bf16*)(ws + WS_ON);
    ep.OG = (bf16*)(ws + WS_OG); ep.MG = (bf16*)(ws + WS_MG); ep.H1B = (bf16*)(ws + WS_H1B); ep.HF = (bf16*)(ws + WS_HF);
    ep.x = a.x; ep.H = a.out; ep.PART1 = (float*)(ws + WS_PART1); ep.gnorm = a.gla_norm;
    const bf16* ALL = (const bf16*)(ws + WS_ALL);

    if (IN(0)) { p0_prologue(a, lds, tid, lane, wave, bid, G); }
    SEAM(0);
    if (IN(1)) { pg8::Gemm g{ALL, ALL, 0, 0, 1024}; pg8::Sched S{1, 845, G, vb, 0, 0, 0}; pg8::Epi<1> E{ep};
        pg8::gemm_phase<pg8::Epi<1>, pg8::Sched, true, true>(lds, g, S, E);
        if (G == 256) { if (vb >= 77) gen_cs_tab(a, lds, tid, vb - 77, 256 - 77); }
        else gen_cs_tab(a, lds, tid, bid, G); }
    SEAM(1);
    if (IN(2)) { p2_sym_rem(a, tid, lane, wave, bid, G); }
    SEAM(2);
    if (IN(3)) { pg8::Gemm g{(const bf16*)(ws + WS_CS), (const bf16*)(ws + WS_EOT), 0, 0, KH}; pg8::Sched S{2, 256, G, vb, 0, 0, 0}; pg8::Epi<2> E{ep};
        pg8::gemm_phase<pg8::Epi<2>, pg8::Sched, true, true>(lds, g, S, E); }
    SEAM(3);
    if (IN(4)) { p4_gla_prep(a, lds, tid, lane, wave, bid, G); p4_combine(a, tid, bid, G); }
    SEAM(4);
    if (IN(5)) { p5_scan(a, lds, tid, lane, wave, vb, G); }
    SEAM(5);
    if (IN(6)) { p6_post(a, lane, wave, bid, G);
        pg8::Gemm g{ALL, ALL, 0, 0, 1024}; pg8::Sched S{3, 512, G, vb, 8, 0, 82}; pg8::Epi<3> E{ep};
        pg8::gemm_phase<pg8::Epi<3>, pg8::Sched, true, true>(lds, g, S, E); }
    SEAM(6);
    if (IN(7)) {
        { pg8::Gemm g{ALL, ALL, 0, 0, 1024}; pg8::Sched S{3, 256, G, vb, 4, 0, 78}; pg8::Epi<4> E{ep};
          pg8::gemm_phase<pg8::Epi<4>, pg8::Sched, true, true>(lds, g, S, E); }
        { pg8::Gemm g{(const bf16*)(ws + WS_FN), (const bf16*)(ws + WS_WFT), 0, 0, 512}; pg8::Sched S{3, 256, G, vb, 4, 0, 0}; pg8::Epi<5> E{ep};
          pg8::gemm_phase<pg8::Epi<5>, pg8::Sched, true, true>(lds, g, S, E); }
    }
    SEAM(7);
    if (IN(8)) { pg8::Gemm g{(const bf16*)(ws + WS_OG), (const bf16*)(ws + WS_WOT), 0, 0, 1024}; pg8::Sched S{3, 256, G, vb, 4, 0, 0}; pg8::Epi<6> E{ep};
        pg8::gemm_phase<pg8::Epi<6>, pg8::Sched, true, true>(lds, g, S, E); }
    SEAM(8);
    if (IN(9)) { pg8::Gemm g{(const bf16*)(ws + WS_MG), (const bf16*)(ws + WS_WOUTT), 0, 0, 1024}; pg8::Sched S{3, 256, G, vb, 4, 0, 0}; pg8::Epi<7> E{ep};
        pg8::gemm_phase<pg8::Epi<7>, pg8::Sched, true, true>(lds, g, S, E); }
    SEAM(9);
    if (IN(10)) { pg8::Gemm g{(const bf16*)(ws + WS_H1B), (const bf16*)(ws + WS_W1T), 0, 0, 1024}; pg8::Sched S{3, 1024, G, vb, 16, 0, 0}; pg8::Epi<8> E{ep};
        pg8::gemm_phase<pg8::Epi<8>, pg8::Sched, true, true>(lds, g, S, E); }
    SEAM(10);
    if (IN(11)) { pg8::Gemm g{(const bf16*)(ws + WS_HF), (const bf16*)(ws + WS_W2T), 0, 0, 4096}; pg8::Sched S{3, 256, G, vb, 4, 0, 0}; pg8::Epi<9> E{ep};
        pg8::gemm_phase<pg8::Epi<9>, pg8::Sched, true, true>(lds, g, S, E); }
    SEAM(11);
    if (IN(12)) { p11_final(a, lane, wave, bid, G); }
#ifdef PROBE_REP
    if (IN(13)) { pg8::Gemm g{(const bf16*)(ws + WS_HF), (const bf16*)(ws + WS_W2T), 0, 0, 4096}; pg8::Sched S{3, 256, G, vb, 4, 0, 0}; pg8::Epi<10> E{ep};
        pg8::gemm_phase<pg8::Epi<10>, pg8::Sched, true, true>(lds, g, S, E); }
    if (IN(14)) { const int gw = bid * NWAVES + wave, NGW = G * NWAVES;
        for (int row = gw; row < NREAL; row += NGW) { f32x4* xr = (f32x4*)(a.out + (size_t)row * D) + lane; float s = 0.f;
            for (int j = 0; j < 4; ++j) { const f32x4 v = xr[64 * j]; s += v.x + v.y + v.z + v.w; }
            if (wave_sum(s) == 123456.789f) xr[0] = (f32x4){s, s, s, s}; } }
#endif
#undef IN
#undef SEAM
}

extern "C" void kernel_launch(void* const* d_in, const int* in_sizes, int n_in, void* d_out, int out_size, void* d_ws, size_t ws_size, hipStream_t stream) {
    static int grid = 0;
    if (grid == 0) {
        int dev = 0, cus = 0, per_cu = 0;
        (void)hipGetDevice(&dev); (void)hipDeviceGetAttribute(&cus, hipDeviceAttributeMultiprocessorCount, dev);
        (void)hipFuncSetAttribute((const void*)fwd_kernel, hipFuncAttributeMaxDynamicSharedMemorySize, LDS_BYTES);
        (void)hipOccupancyMaxActiveBlocksPerMultiprocessor(&per_cu, (const void*)fwd_kernel, NTHREADS, LDS_BYTES);
        (void)hipGetLastError();
        if (per_cu < 1) { fprintf(stderr, "kernel_launch: occupancy query says %d blocks/CU\n", per_cu); per_cu = 1; }
        grid = cus * 1;
        if (grid > 256) grid = 256;
    }
    (void)hipMemsetAsync((char*)d_ws + WS_BAR, 0, 16384, stream);
    Args a{};
    const float* const* in = (const float* const*)d_in;
    a.x = in[0]; a.meta = in[1]; a.norm_mix = in[2]; a.w_in = in[3]; a.wdf = in[4]; a.bdf = in[5]; a.wdb = in[6]; a.bdb = in[7]; a.gla_norm = in[8];
    a.w_o = in[9]; a.w_fnet = in[10]; a.w_out = in[11]; a.norm_ffn = in[12]; a.w_ff1 = in[13]; a.w_ff2 = in[14]; a.norm_final = in[15];
    a.out = (float*)d_out; a.ws = (unsigned char*)d_ws;
#if ONE_LAUNCH
    a.ph_lo = 0; a.ph_hi = NPH;
    void* args[] = {&a};
    hipError_t e = hipLaunchCooperativeKernel((const void*)fwd_kernel, dim3(grid), dim3(NTHREADS), args, LDS_BYTES, stream);
    if (e != hipSuccess) fprintf(stderr, "cooperative launch failed: %s (grid %d)\n", hipGetErrorString(e), grid);
#else
    for (int p = 0; p < NPH; ++p) { a.ph_lo = p; a.ph_hi = p + 1; hipLaunchKernelGGL(fwd_kernel, dim3(grid), dim3(NTHREADS), LDS_BYTES, stream, a);
#ifdef PROBE_REP
        if (p == PROBE_REP) for (int q = 0; q < PROBE_N; ++q) hipLaunchKernelGGL(fwd_kernel, dim3(grid), dim3(NTHREADS), LDS_BYTES, stream, a);
#ifdef PROBE_DRY
        if (p == PROBE_AFTER) { Args a2 = a; a2.ph_lo = PROBE_DRY; a2.ph_hi = PROBE_DRY + 1; for (int q = 0; q < PROBE_N; ++q) hipLaunchKernelGGL(fwd_kernel, dim3(grid), dim3(NTHREADS), LDS_BYTES, stream, a2); }
#endif
#endif
    }
#endif
}
```

```cpp
#include <hip/hip_runtime.h>
#include <hip/hip_cooperative_groups.h>
#include <cstdio>
#include <cstdint>
namespace cg = cooperative_groups;
namespace pg8 {
#define PG8_LAS __attribute__((address_space(3)))
typedef unsigned short bf16_t;
typedef short bf16x8 __attribute__((ext_vector_type(8)));
typedef float f32x4 __attribute__((ext_vector_type(4)));
typedef unsigned u32x4 __attribute__((ext_vector_type(4)));
constexpr int BM = 256, BK = 64, HALF = 128, HTB = HALF * BK * 2  , STAGE_BYTES = 8 * HTB, NXCD = 8, WGM = 8;

__host__ __device__ __forceinline__ int lds_byte(int r, int c) { const int st = (r >> 4) * 2 + (c >> 5), rr = r & 15, cc = c & 31, ob = rr * 64 + cc * 2; return st * 1024 + (ob ^ (((ob >> 9) & 1) << 5)); }
__host__ __device__ __forceinline__ void stage_rc(int b, int& R, int& C) { const int st = b / 1024, sb = b % 1024, swz = sb ^ (((sb >> 9) & 1) << 5); R = (st >> 1) * 16 + swz / 64; C = (st & 1) * 32 + (swz % 64) / 2; }
__host__ __device__ __forceinline__ int perm32(int rho) { const int n = rho >> 4, i = rho & 15; return 8 * (i >> 2) + 4 * n + (i & 3); }

struct Unit { int pm, pn; };
struct Gemm { const bf16_t* A; const bf16_t* Bt; int M, N, K; };

__device__ __forceinline__ unsigned cvt_pk_bf16(float lo, float hi) { unsigned r; asm volatile("v_cvt_pk_bf16_f32 %0, %1, %2" : "=v"(r) : "v"(lo), "v"(hi)); return r; }
__device__ __forceinline__ float bflo(unsigned w) { return __uint_as_float(w << 16); }
__device__ __forceinline__ float bfhi(unsigned w) { return __uint_as_float(w & 0xffff0000u); }

struct Sched {
    int mode, n, G, c, nN, offM, offN;
    __device__ __forceinline__ bool next(int i, Unit& u) const {
        const int L = i * G + c; if (L >= n) return false;
        if (mode == 1) {
            if (L < 585) { u.pm = L / 9; u.pn = 65 + L % 9; }
            else { const int l2 = L - 585; u.pm = 65 + 9 + (l2 & 3); u.pn = l2 >> 2; }
        } else if (mode == 2) {
            const int grp = L >> 6, r = L & 63; u.pm = grp * 16 + (r >> 2); u.pn = grp * 4 + (r & 3);
        } else {
            const int x = (L & 255) >> 5, ul = (L >> 8) * 32 + (L & 31);
            u.pm = 8 * x + (ul & 7) + offM; u.pn = (ul >> 3) + offN; }
        return true;
    }
    __device__ __forceinline__ void a_ready(const Unit&) const {}
    __device__ __forceinline__ void done(const Unit&) const {}
};

struct EP {
    bf16_t *Q, *K, *V; float* R; bf16_t* GT2; bf16_t* PQ; bf16_t *SGA, *SGF, *ON, *OG, *MG, *H1B, *HF;
    const float* x; float* H; float* PART1; const float* gnorm;
};
constexpr int LDG = 8320;
template <int MODE> struct Epi {
    static constexpr bool PERM = true, AFTER_DRAIN = false;
    EP p;
    __device__ __forceinline__ void operator()(const f32x4 (&acc)[2][2][4][2], const Unit& u, int wr, int wc, int fr, int fq) const {
#pragma unroll
        for (int ai = 0; ai < 2; ++ai)
#pragma unroll
            for (int m = 0; m < 4; ++m) {
                const int r = ai * HALF + wr * 64 + m * 16 + fr;
                float ss = 0.f;
                float rstd = 1.f;
                if (MODE == 8) { const float* pp = p.PART1 + (size_t)(u.pm * BM + r) * 16; float s = 0.f;
#pragma unroll
                    for (int t = 0; t < 4; ++t) { const f32x4 q4 = *(const f32x4*)(pp + 4 * t); s += (q4[0] + q4[1]) + (q4[2] + q4[3]); }
                    rstd = 1.0f / sqrtf(s * (1.0f / 1024.0f) + 1e-6f); }
#pragma unroll
                for (int bj = 0; bj < 2; ++bj) {
                    const int c = bj * HALF + wc * 32 + 8 * fq;
                    f32x4 v0 = acc[ai][bj][m][0], v1 = acc[ai][bj][m][1];
                    if (MODE == 1) {
                        if (u.pm < 65) {
                            const int t = u.pn - 65; const size_t row = (size_t)u.pm * BM + r;
                            if (t < 8) {
                                bf16_t* dst; float sc = 1.f;
                                if (t < 2) { dst = p.Q + row * 512 + t * 256 + c; sc = 0.08838834764831845f; }
                                else if (t < 4) dst = p.K + row * 512 + (t - 2) * 256 + c;
                                else dst = p.V + row * 1024 + (t - 4) * 256 + c;
                                u32x4 w; w.x = cvt_pk_bf16(v0[0] * sc, v0[1] * sc); w.y = cvt_pk_bf16(v0[2] * sc, v0[3] * sc); w.z = cvt_pk_bf16(v1[0] * sc, v1[1] * sc); w.w = cvt_pk_bf16(v1[2] * sc, v1[3] * sc);
                                *(u32x4*)dst = w;
                            } else if (c < 32) { float* dst = p.R + row * 32 + c; *(f32x4*)dst = v0; *(f32x4*)(dst + 4) = v1; }
                        } else {
                            const int gcol = (u.pm - 74) * BM + r, cs = gcol >> 9, col = gcol & 511;
                            u32x4 w; w.x = cvt_pk_bf16(v0[0], v0[1]); w.y = cvt_pk_bf16(v0[2], v0[3]); w.z = cvt_pk_bf16(v1[0], v1[1]); w.w = cvt_pk_bf16(v1[2], v1[3]);
                            if (u.pn < 64) { const int b = u.pn >> 5, l = 16 + (u.pn & 31) * 256 + c;
                                *(u32x4*)(p.GT2 + ((size_t)(b * 512 + col) * 2 + cs) * LDG + l) = w; }
                            else if (c == 48 || c == 56) { const int l = c - 48;
                                *(u32x4*)(p.GT2 + ((size_t)(col) * 2 + cs) * LDG + l) = w; *(u32x4*)(p.GT2 + ((size_t)(512 + col) * 2 + cs) * LDG + l) = w; }
                        }
                    } else if (MODE == 2) {
                        const int grp = u.pm >> 4; const size_t idx = (size_t)(u.pm & 15) * BM + r; const int n = (u.pn & 3) * BM + c;
                        u32x4 w; w.x = cvt_pk_bf16(v0[0], v0[1]); w.y = cvt_pk_bf16(v0[2], v0[3]); w.z = cvt_pk_bf16(v1[0], v1[1]); w.w = cvt_pk_bf16(v1[2], v1[3]);
                        *(u32x4*)(p.PQ + ((size_t)grp * 4096 + idx) * 1024 + n) = w;
                    } else if (MODE == 3) {
                        const int t = u.pn - 82; const size_t row = (size_t)u.pm * BM + r;
                        bf16_t* dst = (t < 4 ? p.SGA : p.SGF) + row * 1024 + (t & 3) * 256 + c;
                        float s[8];
#pragma unroll
                        for (int e = 0; e < 4; ++e) { s[e] = 1.f / (1.f + __expf(-v0[e])); s[4 + e] = 1.f / (1.f + __expf(-v1[e])); }
                        u32x4 w; w.x = cvt_pk_bf16(s[0], s[1]); w.y = cvt_pk_bf16(s[2], s[3]); w.z = cvt_pk_bf16(s[4], s[5]); w.w = cvt_pk_bf16(s[6], s[7]);
                        *(u32x4*)dst = w;
                    } else if (MODE == 4) {
                        const int t = u.pn - 78; const size_t off = ((size_t)u.pm * BM + r) * 1024 + t * 256 + c;
                        const u32x4 o = *(const u32x4*)(p.ON + off);
                        float s[8];
#pragma unroll
                        for (int e = 0; e < 4; ++e) { s[e] = v0[e] / (1.f + __expf(-v0[e])); s[4 + e] = v1[e] / (1.f + __expf(-v1[e])); }
                        u32x4 w; w.x = cvt_pk_bf16(s[0] * bflo(o.x), s[1] * bfhi(o.x)); w.y = cvt_pk_bf16(s[2] * bflo(o.y), s[3] * bfhi(o.y));
                        w.z = cvt_pk_bf16(s[4] * bflo(o.z), s[5] * bfhi(o.z)); w.w = cvt_pk_bf16(s[6] * bflo(o.w), s[7] * bfhi(o.w));
                        *(u32x4*)(p.OG + off) = w;
                    } else if (MODE == 5 || MODE == 6) {
                        const size_t off = ((size_t)u.pm * BM + r) * 1024 + u.pn * BM + c;
                        const u32x4 gt = *(const u32x4*)((MODE == 5 ? p.SGF : p.SGA) + off);
                        float s[8] = {v0[0] * bflo(gt.x), v0[1] * bfhi(gt.x), v0[2] * bflo(gt.y), v0[3] * bfhi(gt.y), v1[0] * bflo(gt.z), v1[1] * bfhi(gt.z), v1[2] * bflo(gt.w), v1[3] * bfhi(gt.w)};
                        if (MODE == 6) { const u32x4 mg = *(const u32x4*)(p.MG + off);
                            s[0] += bflo(mg.x); s[1] += bfhi(mg.x); s[2] += bflo(mg.y); s[3] += bfhi(mg.y); s[4] += bflo(mg.z); s[5] += bfhi(mg.z); s[6] += bflo(mg.w); s[7] += bfhi(mg.w); }
                        u32x4 w; w.x = cvt_pk_bf16(s[0], s[1]); w.y = cvt_pk_bf16(s[2], s[3]); w.z = cvt_pk_bf16(s[4], s[5]); w.w = cvt_pk_bf16(s[6], s[7]);
                        *(u32x4*)(p.MG + off) = w;
                    } else if (MODE == 7) {
                        const size_t off = ((size_t)u.pm * BM + r) * 1024 + u.pn * BM + c;
                        const f32x4 x0 = *(const f32x4*)(p.x + off), x1 = *(const f32x4*)(p.x + off + 4);
                        v0 = v0 + x0; v1 = v1 + x1;
                        u32x4 w; w.x = cvt_pk_bf16(v0[0], v0[1]); w.y = cvt_pk_bf16(v0[2], v0[3]); w.z = cvt_pk_bf16(v1[0], v1[1]); w.w = cvt_pk_bf16(v1[2], v1[3]);
                        *(u32x4*)(p.H1B + off) = w;
                        ss += (v0[0] * v0[0] + v0[1] * v0[1]) + (v0[2] * v0[2] + v0[3] * v0[3]) + (v1[0] * v1[0] + v1[1] * v1[1]) + (v1[2] * v1[2] + v1[3] * v1[3]);
                    } else if (MODE == 8) {
                        const size_t off = ((size_t)u.pm * BM + r) * 4096 + u.pn * BM + c;
                        float s[8];
#pragma unroll
                        for (int e = 0; e < 4; ++e) { float a = fmaxf(v0[e] * rstd, 0.f), b = fmaxf(v1[e] * rstd, 0.f); s[e] = a * a; s[4 + e] = b * b; }
                        u32x4 w; w.x = cvt_pk_bf16(s[0], s[1]); w.y = cvt_pk_bf16(s[2], s[3]); w.z = cvt_pk_bf16(s[4], s[5]); w.w = cvt_pk_bf16(s[6], s[7]);
                        *(u32x4*)(p.HF + off) = w;
                    } else if (MODE == 10) {
                        const size_t off = ((size_t)u.pm * BM + r) * 1024 + u.pn * BM + c;
                        const f32x4 x0 = *(const f32x4*)(p.H + off), x1 = *(const f32x4*)(p.H + off + 4);
                        if (v0[0] + x0[0] + x1[1] + v1[2] == 123456.789f) { *(f32x4*)(p.H + off) = v0 + x0; }
                    } else if (MODE == 9) {
                        const size_t off = ((size_t)u.pm * BM + r) * 1024 + u.pn * BM + c;
                        const u32x4 hb = *(const u32x4*)(p.H1B + off);
                        const f32x4 x0 = {bflo(hb.x), bfhi(hb.x), bflo(hb.y), bfhi(hb.y)}, x1 = {bflo(hb.z), bfhi(hb.z), bflo(hb.w), bfhi(hb.w)};
                        *(f32x4*)(p.H + off) = v0 + x0; *(f32x4*)(p.H + off + 4) = v1 + x1;
                    }
                }
                if (MODE == 7) { ss += __shfl_xor(ss, 16); ss += __shfl_xor(ss, 32);
                    if (fq == 0) p.PART1[(size_t)(u.pm * BM + r) * 16 + u.pn * 4 + wc] = ss; }
            }
    }
};
template <class Epi, class Sched, bool ALIGN_EPI = false, bool SP2 = false>
__device__ __forceinline__ void gemm_phase(PG8_LAS unsigned char* lds, const Gemm g, const Sched& S, const Epi& E) {
    const int tid = threadIdx.x, wid = __builtin_amdgcn_readfirstlane(tid >> 6), lane = tid & 63, wr = wid >> 2, wc = wid & 3, fr = lane & 15, fq = lane >> 4;
    const int K = g.K, nt = K / BK;
    unsigned voffA[2], voffB[2];
#pragma unroll
    for (int i = 0; i < 2; ++i) { int R, C; stage_rc(tid * 16 + i * 8192, R, C); const int Rb = Epi::PERM ? ((R & ~31) + perm32(R & 31)) : R;
        voffA[i] = (unsigned)(R * K + C) * 2u; voffB[i] = (unsigned)(Rb * K + C) * 2u; }
    const size_t kstep = (size_t)(BK * 2);
    const size_t hstep = (size_t)HALF * K * 2;
    const size_t tstep = 2 * hstep;
    const unsigned ldsw = (unsigned)wid * 1024u;
    const int aoff = lds_byte(wr * 64 + fr, fq * 8), boff = lds_byte(wc * 32 + fr, fq * 8);
#define PG8_SA(b, h) (((b) * 2 + (h)) * HTB)
#define PG8_SB(b, h) ((4 + (b) * 2 + (h)) * HTB)
#define PG8_STAGE(bufoff, gbase, voff) do { _Pragma("unroll") for (int _i = 0; _i < 2; ++_i) \
        __builtin_amdgcn_global_load_lds((const unsigned*)((const char*)(gbase) + (voff)[_i]), (PG8_LAS unsigned*)(lds + (bufoff) + ldsw + _i * 8192), 16, 0, 0); } while (0)
#define PG8_LDA(dst, b, h) do { _Pragma("unroll") for (int m = 0; m < 4; ++m) _Pragma("unroll") for (int k = 0; k < 2; ++k) dst[m][k] = *(const PG8_LAS bf16x8*)(lds + PG8_SA(b, h) + aoff + m * 2048 + k * 1024); } while (0)
#define PG8_LDB(dst, b, h) do { _Pragma("unroll") for (int n = 0; n < 2; ++n) _Pragma("unroll") for (int k = 0; k < 2; ++k) dst[n][k] = *(const PG8_LAS bf16x8*)(lds + PG8_SB(b, h) + boff + n * 2048 + k * 1024); } while (0)
#define PG8_MMA(ai, bj, At, Bt) do { __builtin_amdgcn_s_setprio(1); _Pragma("unroll") for (int m = 0; m < 4; ++m) _Pragma("unroll") for (int n = 0; n < 2; ++n) _Pragma("unroll") for (int k = 0; k < 2; ++k) \
        acc[ai][bj][m][n] = __builtin_amdgcn_mfma_f32_16x16x32_bf16(Bt[n][k], At[m][k], acc[ai][bj][m][n], 0, 0, 0); __builtin_amdgcn_s_setprio(0); } while (0)
#define PG8_WAIT_V(n) asm volatile("s_waitcnt vmcnt(" #n ")" ::: "memory")
#define PG8_WAIT_L(n) asm volatile("s_waitcnt lgkmcnt(" #n ")" ::: "memory")
#define PG8_BAR __builtin_amdgcn_s_barrier()
#define PG8_SCHED __builtin_amdgcn_sched_barrier(0)
    Unit cur, nxt; int ui = 0;
    if (!S.next(0, cur)) return;
    f32x4 acc[2][2][4][2];
#pragma unroll
    for (int a = 0; a < 2; ++a)
#pragma unroll
        for (int b = 0; b < 2; ++b)
#pragma unroll
            for (int m = 0; m < 4; ++m)
#pragma unroll
                for (int n = 0; n < 2; ++n) acc[a][b][m][n] = (f32x4){0.f, 0.f, 0.f, 0.f};
    bf16x8 At[4][2], B0[2][2], B1[2][2];
    const char* cA = (const char*)g.A + (size_t)cur.pm * tstep; const char* cB = (const char*)g.Bt + (size_t)cur.pn * tstep;
    S.a_ready(cur);
    if constexpr (SP2) {
        PG8_STAGE(PG8_SB(0, 0), cB, voffB); PG8_STAGE(PG8_SB(0, 1), cB + hstep, voffB); PG8_STAGE(PG8_SA(0, 0), cA, voffA); PG8_STAGE(PG8_SA(0, 1), cA + hstep, voffA);
        if (wr == 1) PG8_BAR;
        PG8_WAIT_V(2); PG8_BAR;
        PG8_STAGE(PG8_SB(1, 0), cB + kstep, voffB); PG8_STAGE(PG8_SA(1, 0), cA + kstep, voffA); PG8_STAGE(PG8_SB(1, 1), cB + hstep + kstep, voffB);
        PG8_WAIT_V(6); PG8_BAR;
    } else {
        PG8_STAGE(PG8_SB(0, 0), cB, voffB); PG8_STAGE(PG8_SA(0, 0), cA, voffA); PG8_STAGE(PG8_SB(0, 1), cB + hstep, voffB); PG8_STAGE(PG8_SA(0, 1), cA + hstep, voffA);
        if (wr == 1) PG8_BAR;
        PG8_WAIT_V(4); PG8_BAR;
        PG8_STAGE(PG8_SB(1, 0), cB + kstep, voffB); PG8_STAGE(PG8_SA(1, 0), cA + kstep, voffA); PG8_STAGE(PG8_SB(1, 1), cB + hstep + kstep, voffB);
        PG8_WAIT_V(6); PG8_BAR;
    }
    for (;;) {
        const bool has_next = S.next(ui + 1, nxt);
        const char* nA = has_next ? (const char*)g.A + (size_t)nxt.pm * tstep : cA; const char* nB = has_next ? (const char*)g.Bt + (size_t)nxt.pn * tstep : cB;
        for (int t = 0; t < nt; t += 2) {
            const bool last = (t == nt - 2);
            const char* a1 = cA + (size_t)(t + 1) * kstep;
            const char* a2 = last ? nA : cA + (size_t)(t + 2) * kstep; const char* b2 = last ? nB : cB + (size_t)(t + 2) * kstep;
            const char* a3 = a2 + kstep; const char* b3 = b2 + kstep;
            if (last && has_next) S.a_ready(nxt);
            if constexpr (SP2) {
            PG8_LDB(B0, 0, 0); PG8_LDB(B1, 0, 1); PG8_SCHED; PG8_LDA(At, 0, 0); PG8_STAGE(PG8_SA(1, 1), a1 + hstep, voffA);
            PG8_WAIT_V(8); PG8_WAIT_L(0); PG8_BAR; PG8_MMA(0, 0, At, B0); PG8_MMA(0, 1, At, B1); PG8_BAR; PG8_SCHED;
            PG8_LDA(At, 0, 1); PG8_STAGE(PG8_SB(0, 0), b2, voffB); PG8_STAGE(PG8_SB(0, 1), b2 + hstep, voffB); PG8_STAGE(PG8_SA(0, 0), a2, voffA);
            PG8_WAIT_V(8); PG8_WAIT_L(0); PG8_BAR; PG8_MMA(1, 0, At, B0); PG8_MMA(1, 1, At, B1); PG8_BAR; PG8_SCHED;
            PG8_LDB(B0, 1, 0); PG8_LDB(B1, 1, 1); PG8_SCHED; PG8_LDA(At, 1, 0); PG8_STAGE(PG8_SA(0, 1), a2 + hstep, voffA);
            PG8_WAIT_V(8); PG8_WAIT_L(0); PG8_BAR; PG8_MMA(0, 0, At, B0); PG8_MMA(0, 1, At, B1); PG8_BAR; PG8_SCHED;
            PG8_LDA(At, 1, 1); PG8_STAGE(PG8_SB(1, 0), b3, voffB); PG8_STAGE(PG8_SB(1, 1), b3 + hstep, voffB); PG8_STAGE(PG8_SA(1, 0), a3, voffA);
            PG8_WAIT_V(8); PG8_WAIT_L(0); PG8_BAR; PG8_MMA(1, 0, At, B0); PG8_MMA(1, 1, At, B1); PG8_BAR; PG8_SCHED;
            } else {
            PG8_LDB(B0, 0, 0); PG8_SCHED; PG8_LDA(At, 0, 0); PG8_STAGE(PG8_SA(1, 1), a1 + hstep, voffA);
            PG8_WAIT_L(8); PG8_BAR; PG8_WAIT_L(0); PG8_MMA(0, 0, At, B0); PG8_BAR; PG8_SCHED;
            PG8_LDB(B1, 0, 1); PG8_STAGE(PG8_SB(0, 0), b2, voffB);
            PG8_BAR; PG8_WAIT_L(0); PG8_MMA(0, 1, At, B1); PG8_BAR;
            PG8_LDA(At, 0, 1); PG8_STAGE(PG8_SA(0, 0), a2, voffA);
            PG8_BAR; PG8_WAIT_L(0); PG8_MMA(1, 0, At, B0); PG8_BAR; PG8_SCHED;
            PG8_STAGE(PG8_SB(0, 1), b2 + hstep, voffB);
            PG8_WAIT_V(6); PG8_BAR; PG8_MMA(1, 1, At, B1); PG8_BAR;
            PG8_LDB(B0, 1, 0); PG8_SCHED; PG8_LDA(At, 1, 0); PG8_STAGE(PG8_SA(0, 1), a2 + hstep, voffA);
            PG8_WAIT_L(8); PG8_BAR; PG8_WAIT_L(0); PG8_MMA(0, 0, At, B0); PG8_BAR; PG8_SCHED;
            PG8_LDB(B1, 1, 1); PG8_STAGE(PG8_SB(1, 0), b3, voffB);
            PG8_BAR; PG8_WAIT_L(0); PG8_MMA(0, 1, At, B1); PG8_BAR;
            PG8_LDA(At, 1, 1); PG8_STAGE(PG8_SA(1, 0), a3, voffA);
            PG8_BAR; PG8_WAIT_L(0); PG8_MMA(1, 0, At, B0); PG8_BAR; PG8_SCHED;
            PG8_STAGE(PG8_SB(1, 1), b3 + hstep, voffB);
            PG8_WAIT_V(6); PG8_BAR; PG8_MMA(1, 1, At, B1); PG8_BAR;
            }
        }
        if constexpr (ALIGN_EPI) { if (wr == 0) PG8_BAR; }
        if constexpr (!Epi::AFTER_DRAIN) { E(acc, cur, wr, wc, fr, fq); S.done(cur); }
        if (!has_next) break;
#pragma unroll
        for (int a = 0; a < 2; ++a)
#pragma unroll
            for (int b = 0; b < 2; ++b)
#pragma unroll
                for (int m = 0; m < 4; ++m)
#pragma unroll
                    for (int n = 0; n < 2; ++n) acc[a][b][m][n] = (f32x4){0.f, 0.f, 0.f, 0.f};
        cur = nxt; cA = nA; cB = nB; ++ui;
        if constexpr (ALIGN_EPI) { if (wr == 1) PG8_BAR; }
    }
    PG8_WAIT_V(0);
    if constexpr (!ALIGN_EPI) { if (wr == 0) PG8_BAR; }
    PG8_BAR;
    if constexpr (Epi::AFTER_DRAIN) { E.fused(acc, cur, wr, wc, fr, fq, lds, wid, lane); S.done(cur); }
#undef PG8_SA
#undef PG8_SB
#undef PG8_STAGE
#undef PG8_LDA
#undef PG8_LDB
#undef PG8_MMA
#undef PG8_WAIT_V
#undef PG8_WAIT_L
#undef PG8_BAR
#undef PG8_SCHED
}
}
#define LAS __attribute__((address_space(3)))
#define DI __device__ __forceinline__
typedef unsigned short bf16;
typedef unsigned v4u __attribute__((ext_vector_type(4)));
typedef unsigned v2u __attribute__((ext_vector_type(2)));
typedef float f32x4 __attribute__((ext_vector_type(4)));
typedef short bf16x8 __attribute__((ext_vector_type(8)));
constexpr int NTHREADS = 512, NWAVES = 8;
constexpr int D = 1024, NREAL = 16384, MROWS = 16640, LSEQ = 8208, FF = 4096, DIN = 5664, NCHUNK = 129;
constexpr int LDG = 8320, KH = 2176;
constexpr size_t MiB = 1u << 20;
constexpr size_t WS_PART1 = 0;
constexpr size_t WS_ALL = 1 * MiB;
constexpr size_t WS_WOT = 46 * MiB, WS_WFT = 48 * MiB, WS_WOUTT = 49 * MiB, WS_W1T = 51 * MiB, WS_W2T = 59 * MiB;
constexpr size_t WS_TAB = 67 * MiB;
constexpr size_t WS_CS = 68 * MiB + 512 * 1024;
constexpr size_t WS_GT2 = 136 * MiB + 512 * 1024;
constexpr size_t WS_EOT = 169 * MiB;
constexpr size_t WS_REMP = 186 * MiB;
constexpr size_t WS_PQ = 189 * MiB;
constexpr size_t WS_K = 221 * MiB;
constexpr size_t WS_R = 237 * MiB + 512 * 1024;
constexpr size_t WS_FN = 240 * MiB;
constexpr size_t DO_V = 0, DO_Q = 33 * MiB, DO_OB = 0;
constexpr size_t WS_REC = 69 * MiB;
constexpr size_t REC_BYTES = 43008, REC_KDT = 16384, REC_PM = 32768, REC_DEC = 40960;
constexpr size_t WS_QI_UNUSED = 69 * MiB;
constexpr size_t WS_KDT = 102 * MiB;
constexpr size_t WS_VT = 153 * MiB + 768 * 1024;
constexpr size_t WS_PM = 168 * MiB;
constexpr size_t WS_DEC = 184 * MiB + 512 * 1024;
constexpr size_t WS_OF = 189 * MiB;
constexpr size_t WS_ON = 69 * MiB, WS_SGA = 101 * MiB, WS_SGF = 133 * MiB, WS_OG = 165 * MiB, WS_MG = 197 * MiB;
constexpr size_t WS_H1B = 69 * MiB, WS_HF = 101 * MiB;
constexpr int LDS_BYTES = 155648;
struct Args {
    const float *x, *meta, *norm_mix, *w_in, *wdf, *bdf, *wdb, *bdb, *gla_norm, *w_o, *w_fnet, *w_out, *norm_ffn, *w_ff1, *w_ff2, *norm_final;
    float* out; unsigned char* ws; int ph_lo, ph_hi;
};
DI unsigned f2bf(float f) { unsigned u = __builtin_bit_cast(unsigned, f); return (u + 0x7fffu + ((u >> 16) & 1u)) >> 16; }
DI unsigned pk2(float lo, float hi) { return f2bf(lo) | (f2bf(hi) << 16); }
typedef float f32x2_t __attribute__((ext_vector_type(2)));
typedef __bf16 bf16x2_t __attribute__((ext_vector_type(2)));
DI unsigned cvtpk(float lo, float hi) { f32x2_t v = {lo, hi}; bf16x2_t b = __builtin_convertvector(v, bf16x2_t); return __builtin_bit_cast(unsigned, b); }
DI float bf2f(unsigned h) { return __uint_as_float(h << 16); }
DI float wave_sum(float v) {
#pragma unroll
    for (int o = 1; o < 64; o <<= 1) v += __shfl_xor(v, o);
    return v;
}
DI void transpose_item(const float* W, int pitch, int K, int ncols, bf16* WT, int row_off, LAS float* scr, int item, int lane, const float* kscale) {
    const int nblk = ncols / 32, kb = item / nblk, nb = item % nblk, k0 = 64 * kb, n0 = 32 * nb;
#pragma unroll 8
    for (int i = 0; i < 32; ++i) { const int kk = 2 * i + (lane >> 5); float v = W[(size_t)(k0 + kk) * pitch + n0 + (lane & 31)]; if (kscale) v *= kscale[k0 + kk]; scr[kk * 33 + (lane & 31)] = v; }
    asm volatile("s_waitcnt lgkmcnt(0)" ::: "memory");
    const int c = lane & 7;
#pragma unroll
    for (int j = 0; j < 4; ++j) { const int n = (lane >> 3) + 8 * j; const LAS float* s = scr + (8 * c) * 33 + n;
        v4u o; o.x = pk2(s[0 * 33], s[1 * 33]); o.y = pk2(s[2 * 33], s[3 * 33]); o.z = pk2(s[4 * 33], s[5 * 33]); o.w = pk2(s[6 * 33], s[7 * 33]);
        *(v4u*)(WT + (size_t)(row_off + n0 + n) * K + k0 + 8 * c) = o; }
    asm volatile("s_waitcnt lgkmcnt(0)" ::: "memory");
}
DI void rms_row_to_bf16(const float* xrow, const float* gain, bf16* orow, int lane) {
    const f32x4* xr = (const f32x4*)xrow + lane; const f32x4* gr = (const f32x4*)gain + lane;
    f32x4 v[4]; float s = 0.f;
#pragma unroll
    for (int j = 0; j < 4; ++j) { v[j] = xr[64 * j]; s += (v[j].x * v[j].x + v[j].y * v[j].y) + (v[j].z * v[j].z + v[j].w * v[j].w); }
    const float rstd = 1.f / sqrtf(wave_sum(s) * (1.f / 1024.f) + 1e-6f);
    unsigned long long* o8 = (unsigned long long*)orow + lane;
#pragma unroll
    for (int j = 0; j < 4; ++j) { const f32x4 g = gr[64 * j];
        o8[64 * j] = (unsigned long long)pk2(v[j].x * rstd * g.x, v[j].y * rstd * g.y) | ((unsigned long long)pk2(v[j].z * rstd * g.z, v[j].w * rstd * g.w) << 32); }
}

DI void gen_cs_tab(const Args& a, LAS unsigned char* lds, int tid, int vbi, int nb) {
    unsigned char* ws = a.ws;
    const int gt = vbi * NTHREADS + tid, NGT = nb * NTHREADS;
    LAS float* tabc = (LAS float*)lds; LAS float* tabs = tabc + LSEQ;
    __syncthreads();
    for (int j = tid; j < LSEQ; j += NTHREADS) { const float ang = 6.283185307179586f * (float)j / (float)LSEQ; tabc[j] = __cosf(ang); tabs[j] = __sinf(ang); }
    __syncthreads();
    {
        bf16* CS = (bf16*)(ws + WS_CS);
        const int nchunk = 4 * 4096 * (KH / 8);
        for (int ch = gt; ch < nchunk; ch += NGT) {
            const int k8 = ch % (KH / 8); const int rest = ch / (KH / 8); const int idx = rest & 4095, grp = rest >> 12, cs = grp >> 1, kh = grp & 1;
            const int m = idx + 9, l0 = kh * KH + k8 * 8;
            unsigned j = ((unsigned)l0 * (unsigned)m) % (unsigned)LSEQ;
            float v[8];
#pragma unroll
            for (int e = 0; e < 8; ++e) { v[e] = (l0 + e <= 4104) ? (cs ? tabs[j] : tabc[j]) : 0.f; j += m; if (j >= (unsigned)LSEQ) j -= LSEQ; }
            v4u o; o.x = pk2(v[0], v[1]); o.y = pk2(v[2], v[3]); o.z = pk2(v[4], v[5]); o.w = pk2(v[6], v[7]);
            *(v4u*)(CS + (size_t)ch * 8) = o;
        }
        bf16* TAB = (bf16*)(ws + WS_TAB);
        const int nch2 = 32 * 2 * (LDG / 8);
        for (int ch = gt; ch < nch2; ch += NGT) {
            const int l8 = ch % (LDG / 8); const int rest = ch / (LDG / 8); const int cs = rest & 1, rho = rest >> 1;
            const int lp = 8200 + rho, l0 = l8 * 8;
            unsigned j = ((unsigned)l0 * (unsigned)lp) % (unsigned)LSEQ;
            float v[8];
#pragma unroll
            for (int e = 0; e < 8; ++e) { v[e] = (rho < 8 && l0 + e < LSEQ) ? (cs ? -tabs[j] : tabc[j]) : 0.f; j += lp; while (j >= (unsigned)LSEQ) j -= LSEQ; }
            v4u o; o.x = pk2(v[0], v[1]); o.y = pk2(v[2], v[3]); o.z = pk2(v[4], v[5]); o.w = pk2(v[6], v[7]);
            *(v4u*)(TAB + (size_t)ch * 8) = o;
        }
    }
    __syncthreads();
}

DI void p0_prologue(const Args& a, LAS unsigned char* lds, int tid, int lane, int wave, int bid, int G) {
    unsigned char* ws = a.ws;
    bf16* ALL = (bf16*)(ws + WS_ALL);
    const int gw = bid * NWAVES + wave, NGW = G * NWAVES;
    const int gt = bid * NTHREADS + tid, NGT = G * NTHREADS;
    {
        LAS float* Wl = (LAS float*)lds;
        LAS float* c128 = Wl + 64 * 128; LAS float* s128 = c128 + 128;
        if (tid < 128) { const float ang = 6.283185307179586f * (float)tid / 128.f; c128[tid] = __cosf(ang); s128[tid] = __sinf(ang); }
        for (int item = bid; item < 256; item += G) {
            const int kb = item >> 4, g = (item >> 2) & 3, nq = item & 3;
            __syncthreads();
            for (int idx = tid; idx < 64 * 128; idx += NTHREADS) { const int kk = idx >> 7, c = idx & 127; Wl[idx] = a.w_in[(size_t)(kb * 64 + kk) * DIN + 3104 + g * 128 + c]; }
            __syncthreads();
            const int n = nq * 32 + (tid & 31), kg = tid >> 5;
            float ac[4] = {0.f, 0.f, 0.f, 0.f}, as[4] = {0.f, 0.f, 0.f, 0.f};
            const LAS float* w0 = Wl + (kg * 4) * 128;
#pragma unroll 4
            for (int c = 0; c < 128; ++c) { const int j = (c * n) & 127; const float cc = c128[j], ss = s128[j];
#pragma unroll
                for (int q = 0; q < 4; ++q) { const float w = w0[q * 128 + c]; ac[q] += w * cc; as[q] += w * ss; } }
            bf16* dc = ALL + (size_t)(74 * 256 + g * 128 + n) * D + kb * 64 + kg * 4;
            bf16* ds = ALL + (size_t)(76 * 256 + g * 128 + n) * D + kb * 64 + kg * 4;
            *(v2u*)dc = (v2u){pk2(ac[0], ac[1]), pk2(ac[2], ac[3])}; *(v2u*)ds = (v2u){pk2(as[0], as[1]), pk2(as[2], as[3])};
        }
        __syncthreads();
    }
    {
        LAS float* scr = (LAS float*)(lds + wave * 16384);
        bf16* WT = ALL + (size_t)65 * 256 * D;
        const int I_Q = 16 * 16, I_V = 16 * 32, I_R = 16 * 1, I_G = 16 * 32;
        const int I_O = 16 * 32, I_F = 8 * 32, I_1 = 16 * 128, I_2 = 64 * 32;
        const int NIT = 2 * I_Q + I_V + I_R + 3 * I_G + 2 * I_O + I_F + I_1 + I_2;
        for (int it = gw; it < NIT; it += NGW) {
            int r = it;
            if (r < I_Q) { transpose_item(a.w_in + 0, DIN, D, 512, WT, 0, scr, r, lane, nullptr); continue; } r -= I_Q;
            if (r < I_Q) { transpose_item(a.w_in + 512, DIN, D, 512, WT, 512, scr, r, lane, nullptr); continue; } r -= I_Q;
            if (r < I_V) { transpose_item(a.w_in + 1024, DIN, D, 1024, WT, 1024, scr, r, lane, nullptr); continue; } r -= I_V;
            if (r < I_R) { transpose_item(a.w_in + 3072, DIN, D, 32, WT, 2048, scr, r, lane, nullptr); continue; } r -= I_R;
            if (r < I_G) { transpose_item(a.w_in + 2048, DIN, D, 1024, WT, 13 * 256, scr, r, lane, nullptr); continue; } r -= I_G;
            if (r < I_G) { transpose_item(a.w_in + 3616, DIN, D, 1024, WT, 17 * 256, scr, r, lane, nullptr); continue; } r -= I_G;
            if (r < I_G) { transpose_item(a.w_in + 4640, DIN, D, 1024, WT, 21 * 256, scr, r, lane, nullptr); continue; } r -= I_G;
            if (r < I_O) { transpose_item(a.w_o, D, D, 1024, (bf16*)(ws + WS_WOT), 0, scr, r, lane, nullptr); continue; } r -= I_O;
            if (r < I_O) { transpose_item(a.w_out, D, D, 1024, (bf16*)(ws + WS_WOUTT), 0, scr, r, lane, nullptr); continue; } r -= I_O;
            if (r < I_F) { transpose_item(a.w_fnet, D, 512, 1024, (bf16*)(ws + WS_WFT), 0, scr, r, lane, nullptr); continue; } r -= I_F;
            if (r < I_1) { transpose_item(a.w_ff1, FF, D, FF, (bf16*)(ws + WS_W1T), 0, scr, r, lane, a.norm_ffn); continue; } r -= I_1;
            transpose_item(a.w_ff2, D, FF, 1024, (bf16*)(ws + WS_W2T), 0, scr, r, lane, nullptr);
        }
    }
    {
        bf16* t8 = ALL + (size_t)(73 * 256 + 32) * D;
        for (int i = gt; i < 224 * D / 8; i += NGT) *(v4u*)(t8 + (size_t)i * 8) = (v4u){0u, 0u, 0u, 0u};
        bf16* x64 = ALL + (size_t)16384 * D;
        for (int i = gt; i < 256 * D / 8; i += NGT) { const int row = i / (D / 8); if (row < 48 || row >= 64) *(v4u*)(x64 + (size_t)i * 8) = (v4u){0u, 0u, 0u, 0u}; }
        bf16* GT2 = (bf16*)(ws + WS_GT2);
        for (int i = gt; i < 2048 * 14; i += NGT) { const int row = i / 14, c = i % 14; *(v4u*)(GT2 + (size_t)row * LDG + LSEQ + c * 8) = (v4u){0u, 0u, 0u, 0u}; }
    }
    for (int m = gw; m < NREAL + 16; m += NGW) {
        if (m < NREAL) rms_row_to_bf16(a.x + (size_t)m * D, a.norm_mix, ALL + (size_t)m * D, lane);
        else rms_row_to_bf16(a.meta + (size_t)(m - NREAL) * D, a.norm_mix, ALL + (size_t)(NREAL + 48 + (m - NREAL)) * D, lane);
    }
}
DI void p2_sym_rem(const Args& a, int tid, int lane, int wave, int bid, int G) {
    unsigned char* ws = a.ws;
    const bf16* GT2 = (const bf16*)(ws + WS_GT2);
    bf16* EOT = (bf16*)(ws + WS_EOT);
    const int gt = bid * NTHREADS + tid, NGT = G * NTHREADS;
    const int nchunk = 4 * 1024 * (KH / 8);
    for (int ch = gt; ch < nchunk; ch += NGT) {
        const int k8 = ch % (KH / 8); const int rest = ch / (KH / 8); const int n = rest & 1023, grp = rest >> 10, cs = grp >> 1, kh = grp & 1;
        const int l0 = kh * KH + k8 * 8;
        const bf16* src = GT2 + ((size_t)n * 2 + cs) * LDG;
        float v[8];
        if (l0 > 4104) {
#pragma unroll
            for (int e = 0; e < 8; ++e) v[e] = 0.f;
        } else {
            const v4u f = *(const v4u*)(src + l0);
            const float fw[8] = {bf2f(f.x & 0xffffu), bf2f(f.x >> 16), bf2f(f.y & 0xffffu), bf2f(f.y >> 16), bf2f(f.z & 0xffffu), bf2f(f.z >> 16), bf2f(f.w & 0xffffu), bf2f(f.w >> 16)};
            const v4u mch = *(const v4u*)(src + (LSEQ - 8 - l0));
            const float mw[8] = {bf2f(mch.x & 0xffffu), bf2f(mch.x >> 16), bf2f(mch.y & 0xffffu), bf2f(mch.y >> 16), bf2f(mch.z & 0xffffu), bf2f(mch.z >> 16), bf2f(mch.w & 0xffffu), bf2f(mch.w >> 16)};
            const float m0 = (l0 == 0) ? 0.f : bf2f((unsigned)src[LSEQ - l0]);
#pragma unroll
            for (int e = 0; e < 8; ++e) { const int l = l0 + e;
                if (l > 4104) v[e] = 0.f;
                else if (l == 0 || l == 4104) v[e] = cs ? 0.f : fw[e];
                else { const float mir = (e == 0) ? m0 : mw[8 - e]; v[e] = cs ? fw[e] - mir : fw[e] + mir; } }
        }
        v4u o; o.x = pk2(v[0], v[1]); o.y = pk2(v[2], v[3]); o.z = pk2(v[4], v[5]); o.w = pk2(v[6], v[7]);
        *(v4u*)(EOT + (size_t)ch * 8) = o;
    }
    typedef float f32x16 __attribute__((ext_vector_type(16)));
    const bf16* TAB = (const bf16*)(ws + WS_TAB);
    float* REMP = (float*)(ws + WS_REMP);
    const int gw = bid * NWAVES + wave, NGW = G * NWAVES;
    for (int task = gw; task < 32 * 65; task += NGW) {
        const int nt = task & 31, ks = task >> 5; const int r = lane & 31, h = lane >> 5;
        f32x16 acc; for (int i = 0; i < 16; ++i) acc[i] = 0.f;
        const bf16* ap = TAB + (size_t)r * (2 * LDG) + ks * 256 + 8 * h;
        const bf16* bp = GT2 + (size_t)(nt * 32 + r) * (2 * LDG) + ks * 256 + 8 * h;
#pragma unroll 4
        for (int kk = 0; kk < 16; ++kk) { const bf16x8 af = *(const bf16x8*)(ap + kk * 16), bfr = *(const bf16x8*)(bp + kk * 16);
            acc = __builtin_amdgcn_mfma_f32_32x32x16_bf16(af, bfr, acc, 0, 0, 0); }
#pragma unroll
        for (int i = 0; i < 4; ++i) REMP[((size_t)ks * 8 + i + 4 * h) * 1024 + nt * 32 + r] = acc[i];
    }
}

DI void p4_combine(const Args& a, int tid, int bid, int G) {
    unsigned char* ws = a.ws;
    const bf16* PQ = (const bf16*)(ws + WS_PQ); const float* REMP = (const float*)(ws + WS_REMP); bf16* FN = (bf16*)(ws + WS_FN);
    const float scale = 0.0009756003f;
    const int gt = bid * NTHREADS + tid, NGT = G * NTHREADS;
    for (int ch = gt; ch < NREAL * 64; ch += NGT) {
        const int c8 = ch & 63, row = ch >> 6, b = row >> 13, s = row & 8191, l = s + 16, n = b * 512 + c8 * 8;
        float v[8];
        if (l >= 8200) { const int rho = l - 8200;
#pragma unroll
            for (int e = 0; e < 8; ++e) v[e] = 0.f;
            for (int ks = 0; ks < 65; ++ks) { const f32x4 p0 = *(const f32x4*)(REMP + ((size_t)ks * 8 + rho) * 1024 + n), p1 = *(const f32x4*)(REMP + ((size_t)ks * 8 + rho) * 1024 + n + 4);
                v[0] += p0[0]; v[1] += p0[1]; v[2] += p0[2]; v[3] += p0[3]; v[4] += p1[0]; v[5] += p1[1]; v[6] += p1[2]; v[7] += p1[3]; }
        } else {
            const bool mir = l > 4104; const int idx = (mir ? LSEQ - l : l) - 9; const float sg = mir ? 1.f : -1.f;
            const size_t off = (size_t)idx * 1024 + n;
            const v4u p0 = *(const v4u*)(PQ + off), p1 = *(const v4u*)(PQ + (size_t)4096 * 1024 + off), q0 = *(const v4u*)(PQ + (size_t)2 * 4096 * 1024 + off), q1 = *(const v4u*)(PQ + (size_t)3 * 4096 * 1024 + off);
            const unsigned pp0[4] = {p0.x, p0.y, p0.z, p0.w}, pp1[4] = {p1.x, p1.y, p1.z, p1.w}, qq0[4] = {q0.x, q0.y, q0.z, q0.w}, qq1[4] = {q1.x, q1.y, q1.z, q1.w};
#pragma unroll
            for (int e = 0; e < 4; ++e) {
                v[2 * e] = (bf2f(pp0[e] & 0xffffu) + bf2f(pp1[e] & 0xffffu)) + sg * (bf2f(qq0[e] & 0xffffu) + bf2f(qq1[e] & 0xffffu));
                v[2 * e + 1] = (bf2f(pp0[e] >> 16) + bf2f(pp1[e] >> 16)) + sg * (bf2f(qq0[e] >> 16) + bf2f(qq1[e] >> 16)); }
        }
        v4u o; o.x = pk2(v[0] * scale, v[1] * scale); o.y = pk2(v[2] * scale, v[3] * scale); o.z = pk2(v[4] * scale, v[5] * scale); o.w = pk2(v[6] * scale, v[7] * scale);
        *(v4u*)(FN + (size_t)row * 512 + c8 * 8) = o;
    }
}

DI void p6_post(const Args& a, int lane, int wave, int bid, int G) {
    unsigned char* ws = a.ws;
    const bf16* OF = (const bf16*)(ws + WS_OF); const bf16* OB = (const bf16*)((unsigned char*)a.out + DO_OB); bf16* ON = (bf16*)(ws + WS_ON);
    const int gw = bid * NWAVES + wave, NGW = G * NWAVES;
    const int c0 = lane * 16;
    float gn[16];
#pragma unroll
    for (int e = 0; e < 16; ++e) gn[e] = a.gla_norm[(c0 & 255) + e];
    for (int row = gw; row < NREAL; row += NGW) {
        const size_t off = (size_t)row * 1024 + c0;
        const v4u f0 = *(const v4u*)(OF + off), f1 = *(const v4u*)(OF + off + 8), b0 = *(const v4u*)(OB + off), b1 = *(const v4u*)(OB + off + 8);
        const unsigned fw[8] = {f0.x, f0.y, f0.z, f0.w, f1.x, f1.y, f1.z, f1.w}, bw[8] = {b0.x, b0.y, b0.z, b0.w, b1.x, b1.y, b1.z, b1.w};
        float v[16]; float ss = 0.f;
#pragma unroll
        for (int e = 0; e < 8; ++e) { v[2 * e] = bf2f(fw[e] & 0xffffu) + bf2f(bw[e] & 0xffffu); v[2 * e + 1] = bf2f(fw[e] >> 16) + bf2f(bw[e] >> 16); ss += v[2 * e] * v[2 * e] + v[2 * e + 1] * v[2 * e + 1]; }
        ss += __shfl_xor(ss, 1); ss += __shfl_xor(ss, 2); ss += __shfl_xor(ss, 4); ss += __shfl_xor(ss, 8);
        const float rstd = 1.f / sqrtf(ss * (1.f / 256.f) + 1e-6f);
        unsigned w[8];
#pragma unroll
        for (int e = 0; e < 8; ++e) w[e] = pk2(v[2 * e] * rstd * gn[2 * e], v[2 * e + 1] * rstd * gn[2 * e + 1]);
        *(v4u*)(ON + off) = (v4u){w[0], w[1], w[2], w[3]}; *(v4u*)(ON + off + 8) = (v4u){w[4], w[5], w[6], w[7]};
    }
}

DI void p11_final(const Args& a, int lane, int wave, int bid, int G) {
    const int gw = bid * NWAVES + wave, NGW = G * NWAVES;
    for (int row = gw; row < NREAL; row += NGW) {
        f32x4* xr = (f32x4*)(a.out + (size_t)row * D) + lane; const f32x4* gr = (const f32x4*)a.norm_final + lane;
        f32x4 v[4]; float s = 0.f;
#pragma unroll
        for (int j = 0; j < 4; ++j) { v[j] = xr[64 * j]; s += (v[j].x * v[j].x + v[j].y * v[j].y) + (v[j].z * v[j].z + v[j].w * v[j].w); }
        const float rstd = 1.f / sqrtf(wave_sum(s) * (1.f / 1024.f) + 1e-6f);
#pragma unroll
        for (int j = 0; j < 4; ++j) { const f32x4 g = gr[64 * j]; xr[64 * j] = (f32x4){v[j].x * rstd * g.x, v[j].y * rstd * g.y, v[j].z * rstd * g.z, v[j].w * rstd * g.w}; }
    }
}
DI float logsig(float x) { return fminf(x, 0.f) - __logf(1.f + __expf(-fabsf(x))); }
DI size_t tile_idx(int dir, int b, int h, int c) { return (size_t)((dir * 2 + b) * 4 + h) * NCHUNK + c; }
DI void p4_gla_prep(const Args& a, LAS unsigned char* lds, int tid, int lane, int wave, int bid, int G) {
    unsigned char* ws = a.ws;
    const bf16* Qg = (const bf16*)((unsigned char*)a.out + DO_Q); const bf16* Kg = (const bf16*)(ws + WS_K); const bf16* Vg = (const bf16*)((unsigned char*)a.out + DO_V);
    const float* Rg = (const float*)(ws + WS_R);
    unsigned char* REC = ws + WS_REC; bf16* VT = (bf16*)(ws + WS_VT);
    LAS float* BF = (LAS float*)lds; LAS float* BB = BF + 64 * 128;
    LAS unsigned char* QF = lds + 65536; LAS unsigned char* KF = QF + 17408; LAS unsigned char* QB = KF + 17408; LAS unsigned char* KB = QB + 17408;
    LAS unsigned char* KRAW = lds + 135168;
    LAS float* RS = (LAS float*)QF; LAS float* WD = RS + 64 * 32;
    LAS unsigned char* VS = lds;
    f32x4 rq; v4u q8p[2], k8p[2], v8p[4];
#define PREP_ROW0(t) ((((t) >> 2) % NCHUNK == 0) ? NREAL : ((t) >> 2) / NCHUNK * 8192 + 64 * ((((t) >> 2) % NCHUNK) - 1))
#define PREP_LOAD_QKR(t) do { const int r0_ = PREP_ROW0(t), h_ = (t) & 3; rq = *(const f32x4*)(Rg + (size_t)r0_ * 32 + tid * 4); \
        _Pragma("unroll") for (int rep = 0; rep < 2; ++rep) { const int g_ = tid + NTHREADS * rep, i_ = g_ >> 4, d0_ = (g_ & 15) * 8; \
            q8p[rep] = *(const v4u*)(Qg + (size_t)(r0_ + i_) * 512 + h_ * 128 + d0_); k8p[rep] = *(const v4u*)(Kg + (size_t)(r0_ + i_) * 512 + h_ * 128 + d0_); } } while (0)
#define PREP_LOAD_V(t) do { const int r0_ = PREP_ROW0(t), h_ = (t) & 3; \
        _Pragma("unroll") for (int rep = 0; rep < 4; ++rep) { const int idx_ = tid + NTHREADS * rep, i_ = idx_ >> 5, u_ = idx_ & 31; v8p[rep] = *(const v4u*)(Vg + (size_t)(r0_ + i_) * 1024 + h_ * 256 + u_ * 8); } } while (0)
    if (bid < 2 * NCHUNK * 4) { PREP_LOAD_QKR(bid); PREP_LOAD_V(bid); }
    for (int task = bid; task < 2 * NCHUNK * 4; task += G) {
        const int h = task & 3, c = (task >> 2) % NCHUNK, b = (task >> 2) / NCHUNK;
        const int row0 = (c == 0) ? NREAL : b * 8192 + 64 * (c - 1);
        const bool has_next = task + G < 2 * NCHUNK * 4;
        {
            const int d = tid & 127, part = tid >> 7;
            float wf[16], wb[16];
#pragma unroll
            for (int j = 0; j < 16; ++j) { wf[j] = a.wdf[j * 512 + h * 128 + d]; wb[j] = a.wdb[j * 512 + h * 128 + d]; }
            const float bfw = a.bdf[h * 128 + d], bbw = a.bdb[h * 128 + d];
            *(LAS f32x4*)(RS + tid * 4) = rq;
            __syncthreads();
            float laf[16], lab[16];
#pragma unroll
            for (int ii = 0; ii < 16; ++ii) { const int i = part * 16 + ii; float lf = bfw, lb = bbw;
#pragma unroll
                for (int j4 = 0; j4 < 4; ++j4) { const f32x4 rf = *(const LAS f32x4*)(RS + i * 32 + 4 * j4), rb = *(const LAS f32x4*)(RS + i * 32 + 16 + 4 * j4);
                    lf += rf[0] * wf[4 * j4] + rf[1] * wf[4 * j4 + 1] + rf[2] * wf[4 * j4 + 2] + rf[3] * wf[4 * j4 + 3];
                    lb += rb[0] * wb[4 * j4] + rb[1] * wb[4 * j4 + 1] + rb[2] * wb[4 * j4 + 2] + rb[3] * wb[4 * j4 + 3]; }
                laf[ii] = logsig(lf) * 0.0625f; lab[ii] = logsig(lb) * 0.0625f;
                if (c == 0 && i < 48) { laf[ii] = 0.f; lab[ii] = 0.f; } }
#pragma unroll
            for (int ii = 1; ii < 16; ++ii) laf[ii] += laf[ii - 1];
#pragma unroll
            for (int ii = 14; ii >= 0; --ii) lab[ii] += lab[ii + 1];
            LAS float* TOT = WD;
            TOT[part * 128 + d] = laf[15]; TOT[512 + part * 128 + d] = lab[0];
            __syncthreads();
            float of = 0.f, ob = 0.f;
#pragma unroll
            for (int q = 0; q < 4; ++q) { if (q < part) of += TOT[q * 128 + d]; if (q > part) ob += TOT[512 + q * 128 + d]; }
#pragma unroll
            for (int ii = 0; ii < 16; ++ii) { const int i = part * 16 + ii; BF[i * 128 + d] = laf[ii] + of; BB[i * 128 + d] = lab[ii] + ob; }
            if (part == 3) ((float*)(REC + tile_idx(0, b, h, c) * REC_BYTES + REC_DEC))[d] = __expf(laf[15] + of);
            if (part == 0) ((float*)(REC + tile_idx(1, b, h, c) * REC_BYTES + REC_DEC))[d] = __expf(lab[0] + ob);
        }
        __syncthreads();
#pragma unroll
        for (int rep = 0; rep < 2; ++rep) {
            const int g = tid + NTHREADS * rep, i = g >> 4, d0 = (g & 15) * 8;
            const v4u q8 = q8p[rep], k8 = k8p[rep];
            const unsigned qw[4] = {q8.x, q8.y, q8.z, q8.w}, kw[4] = {k8.x, k8.y, k8.z, k8.w};
            float qf[8], kf[8], qb[8], kb[8], qif[8], qib[8];
#pragma unroll
            for (int e = 0; e < 8; ++e) {
                const int d = d0 + e; const float q = bf2f((e & 1) ? (qw[e >> 1] >> 16) : (qw[e >> 1] & 0xffffu)), k = bf2f((e & 1) ? (kw[e >> 1] >> 16) : (kw[e >> 1] & 0xffffu));
                const float ef = BF[i * 128 + d], eb = BB[i * 128 + d], f31 = BF[31 * 128 + d], b32 = BB[32 * 128 + d];
                qf[e] = q * __expf(ef - f31); kf[e] = k * __expf(f31 - ef); qb[e] = q * __expf(eb - b32); kb[e] = k * __expf(b32 - eb);
                qif[e] = q * __expf(ef); qib[e] = q * __expf(eb);
            }
            *(LAS v4u*)(QF + i * 272 + d0 * 2) = (v4u){pk2(qf[0], qf[1]), pk2(qf[2], qf[3]), pk2(qf[4], qf[5]), pk2(qf[6], qf[7])};
            *(LAS v4u*)(KF + i * 272 + d0 * 2) = (v4u){pk2(kf[0], kf[1]), pk2(kf[2], kf[3]), pk2(kf[4], kf[5]), pk2(kf[6], kf[7])};
            *(LAS v4u*)(QB + i * 272 + d0 * 2) = (v4u){pk2(qb[0], qb[1]), pk2(qb[2], qb[3]), pk2(qb[4], qb[5]), pk2(qb[6], qb[7])};
            *(LAS v4u*)(KB + i * 272 + d0 * 2) = (v4u){pk2(kb[0], kb[1]), pk2(kb[2], kb[3]), pk2(kb[4], kb[5]), pk2(kb[6], kb[7])};
            *(LAS v4u*)(KRAW + i * 256 + d0 * 2) = k8;
            const int kap = d0 >> 5, u = (d0 & 31) >> 3, pc = 32 * kap + 16 * (u & 1) + 4 * (u >> 1);
            bf16* qi_f = (bf16*)(REC + tile_idx(0, b, h, c) * REC_BYTES) + i * 128 + pc; bf16* qi_b = (bf16*)(REC + tile_idx(1, b, h, c) * REC_BYTES) + i * 128 + pc;
            *(v2u*)qi_f = (v2u){pk2(qif[0], qif[1]), pk2(qif[2], qif[3])}; *(v2u*)(qi_f + 8) = (v2u){pk2(qif[4], qif[5]), pk2(qif[6], qif[7])};
            *(v2u*)qi_b = (v2u){pk2(qib[0], qib[1]), pk2(qib[2], qib[3])}; *(v2u*)(qi_b + 8) = (v2u){pk2(qib[4], qib[5]), pk2(qib[6], qib[7])};
        }
        if (has_next) PREP_LOAD_QKR(task + G);
        __syncthreads();
        {
            const int dir = wave >> 2, tq = wave & 3, fr = lane & 15, g = lane >> 4;
            const LAS unsigned char* QX = dir ? QB : QF; const LAS unsigned char* KX = dir ? KB : KF;
            bf16x8 bq[4];
#pragma unroll
            for (int kap = 0; kap < 4; ++kap) bq[kap] = *(const LAS bf16x8*)(QX + (16 * tq + fr) * 272 + (32 * kap + 8 * g) * 2);
            bf16* pm = (bf16*)(REC + tile_idx(dir, b, h, c) * REC_BYTES + REC_PM);
            const int i = 16 * tq + fr;
#pragma unroll
            for (int tk = 0; tk < 4; ++tk) {
                f32x4 acc = {0.f, 0.f, 0.f, 0.f};
#pragma unroll
                for (int kap = 0; kap < 4; ++kap) { const bf16x8 af = *(const LAS bf16x8*)(KX + (16 * tk + fr) * 272 + (32 * kap + 8 * g) * 2);
                    acc = __builtin_amdgcn_mfma_f32_16x16x32_bf16(af, bq[kap], acc, 0, 0, 0); }
                float s[4];
#pragma unroll
                for (int e = 0; e < 4; ++e) { const int j = 16 * tk + 4 * g + e; const bool keep = dir ? (j >= i) : (j <= i); s[e] = keep ? acc[e] : 0.f; }
                *(v2u*)(pm + i * 64 + 16 * tk + 4 * g) = (v2u){pk2(s[0], s[1]), pk2(s[2], s[3])};
            }
        }
        {
            const int d = tid & 127, blk = tid >> 7, i0 = blk * 16;
            const float f63 = BF[63 * 128 + d], b0 = BB[d];
            unsigned wf[8], wb[8];
#pragma unroll
            for (int e2 = 0; e2 < 8; ++e2) {
                const int ia = i0 + 2 * e2, ib = ia + 1;
                const float ka = bf2f((unsigned)*(const LAS unsigned short*)(KRAW + ia * 256 + d * 2)), kb2 = bf2f((unsigned)*(const LAS unsigned short*)(KRAW + ib * 256 + d * 2));
                wf[e2] = pk2(ka * __expf(f63 - BF[ia * 128 + d]), kb2 * __expf(f63 - BF[ib * 128 + d]));
                wb[e2] = pk2(ka * __expf(b0 - BB[ia * 128 + d]), kb2 * __expf(b0 - BB[ib * 128 + d]));
            }
            bf16* kf_ = (bf16*)(REC + tile_idx(0, b, h, c) * REC_BYTES + REC_KDT) + d * 64 + i0; bf16* kb_ = (bf16*)(REC + tile_idx(1, b, h, c) * REC_BYTES + REC_KDT) + d * 64 + i0;
            *(v4u*)kf_ = (v4u){wf[0], wf[1], wf[2], wf[3]}; *(v4u*)(kf_ + 8) = (v4u){wf[4], wf[5], wf[6], wf[7]};
            *(v4u*)kb_ = (v4u){wb[0], wb[1], wb[2], wb[3]}; *(v4u*)(kb_ + 8) = (v4u){wb[4], wb[5], wb[6], wb[7]};
        }
        __syncthreads();
#pragma unroll
        for (int rep = 0; rep < 4; ++rep) { const int idx = tid + NTHREADS * rep, i = idx >> 5, u = idx & 31;
            *(LAS v4u*)(VS + i * 528 + u * 16) = v8p[rep]; }
        if (has_next) PREP_LOAD_V(task + G);
        __syncthreads();
        {
            const int dv = tid & 255, half = tid >> 8; unsigned w[16];
#pragma unroll
            for (int e2 = 0; e2 < 16; ++e2) { const int ia = 32 * half + 2 * e2;
                w[e2] = (unsigned)*(const LAS unsigned short*)(VS + ia * 528 + dv * 2) | ((unsigned)*(const LAS unsigned short*)(VS + (ia + 1) * 528 + dv * 2) << 16); }
            bf16* vt = VT + ((size_t)(b * 4 + h) * NCHUNK + c) * 16384 + dv * 64 + 32 * half;
#pragma unroll
            for (int q4 = 0; q4 < 4; ++q4) *(v4u*)(vt + 8 * q4) = (v4u){w[4 * q4], w[4 * q4 + 1], w[4 * q4 + 2], w[4 * q4 + 3]};
        }
        __syncthreads();
    }
}

constexpr int SC_QI = 0, SC_KDT = 17408, SC_PM = 35840, SC_DEC = 45056, SC_VT = 45568, SC_BUF = 47872, SC_SA = 3 * SC_BUF, SC_NCH = 2720, SC_IT = 22;
DI void scan_load(v4u (&r)[SC_IT], const unsigned char* rec, const unsigned char* vt, int pl) {
#pragma unroll
    for (int it = 0; it < SC_IT - 1; ++it) r[it] = *(const v4u*)(rec + pl * 16 + it * 2048);
    r[SC_IT - 1] = *(const v4u*)(vt + pl * 16);
}
DI void scan_store(LAS unsigned char* buf, const v4u (&r)[SC_IT], int pl) {
#pragma unroll
    for (int it = 0; it < SC_IT - 1; ++it) { const int cid = pl + 128 * it;
        int dst;
        if (cid < 1024) dst = SC_QI + (cid >> 4) * 272 + (cid & 15) * 16;
        else if (cid < 2048) { const int x = cid - 1024; dst = SC_KDT + (x >> 3) * 144 + (x & 7) * 16; }
        else if (cid < 2560) { const int x = cid - 2048; dst = SC_PM + (x >> 3) * 144 + (x & 7) * 16; }
        else dst = SC_DEC + (cid - 2560) * 16;
        if (cid < 2592) *(LAS v4u*)(buf + dst) = r[it]; }
    *(LAS v4u*)(buf + SC_VT + (pl >> 3) * 144 + (pl & 7) * 16) = r[SC_IT - 1];
}
DI void p5_scan(const Args& a, LAS unsigned char* lds, int tid, int lane, int wave, int bid, int G) {
    unsigned char* ws = a.ws;
    const unsigned char* REC = ws + WS_REC; const unsigned char* VT = ws + WS_VT;
    for (int item = bid; item < 256; item += G) {
        const int sl = item & 15, dir = (item >> 4) & 1, h = (item >> 5) & 3, b = item >> 7;
        bf16* O = dir ? (bf16*)((unsigned char*)a.out + DO_OB) : (bf16*)(ws + WS_OF);
        const size_t t0 = tile_idx(dir, b, h, 0); const size_t v0i = (size_t)(b * 4 + h) * NCHUNK;
        const int fr = lane & 15, g = lane >> 4;
#define SCAN_SRC(step) REC + (t0 + (dir ? 128 - (step) : (step))) * REC_BYTES, VT + (v0i + (dir ? 128 - (step) : (step))) * 32768 + sl * 2048
        const bool loader = (wave >= 1 && wave <= 6);
        const int pr = (wave - 1) >> 1, pl = ((wave - 1) & 1) * 64 + lane;
        v4u r[SC_IT];
        __syncthreads();
        if (loader) { scan_load(r, SCAN_SRC(pr), pl); scan_store(lds + pr * SC_BUF, r, pl); scan_load(r, SCAN_SRC(pr + 3), pl); }
        if (wave == 0) *(LAS v4u*)(lds + SC_SA + 4096 + lane * 16) = (v4u){0u, 0u, 0u, 0u}, *(LAS v4u*)(lds + SC_SA + 4096 + 1024 + lane * 16) = (v4u){0u, 0u, 0u, 0u},
                       *(LAS v4u*)(lds + SC_SA + 4096 + 2048 + lane * 16) = (v4u){0u, 0u, 0u, 0u}, *(LAS v4u*)(lds + SC_SA + 4096 + 3072 + lane * 16) = (v4u){0u, 0u, 0u, 0u};
        __syncthreads();
        if (wave == 0) {
#pragma unroll 1
            for (int s = 0; s < NCHUNK; ++s) {
                LAS unsigned char* cur = lds + (s % 3) * SC_BUF;
                const int cs = dir ? 128 - s : s;
                const LAS unsigned char* sap = lds + SC_SA + ((s + 1) & 1) * 4096 + lane * 16;
                bf16x8 sa[4], vf[2];
#pragma unroll
                for (int kap = 0; kap < 4; ++kap) sa[kap] = *(const LAS bf16x8*)(sap + kap * 1024);
#pragma unroll
                for (int kp = 0; kp < 2; ++kp) vf[kp] = *(const LAS bf16x8*)(cur + SC_VT + fr * 144 + (32 * kp + 8 * g) * 2);
#pragma unroll
                for (int t = 0; t < 4; ++t) {
                    f32x4 o = {0.f, 0.f, 0.f, 0.f};
#pragma unroll
                    for (int kap = 0; kap < 4; ++kap) { const bf16x8 qf = *(const LAS bf16x8*)(cur + SC_QI + (16 * t + fr) * 272 + (32 * kap + 8 * g) * 2);
                        o = __builtin_amdgcn_mfma_f32_16x16x32_bf16(sa[kap], qf, o, 0, 0, 0); }
#pragma unroll
                    for (int kp = 0; kp < 2; ++kp) { const bf16x8 pf = *(const LAS bf16x8*)(cur + SC_PM + (16 * t + fr) * 144 + (32 * kp + 8 * g) * 2);
                        o = __builtin_amdgcn_mfma_f32_16x16x32_bf16(vf[kp], pf, o, 0, 0, 0); }
                    if (cs != 0) { const size_t row = (size_t)b * 8192 + 64 * (cs - 1) + 16 * t + fr;
                        *(v2u*)(O + row * 1024 + h * 256 + 16 * sl + 4 * g) = (v2u){cvtpk(o[0], o[1]), cvtpk(o[2], o[3])}; }
                }
                __syncthreads();
            }
        } else if (wave == 7) {
            f32x4 S[8];
#pragma unroll
            for (int j = 0; j < 8; ++j) S[j] = (f32x4){0.f, 0.f, 0.f, 0.f};
#pragma unroll 1
            for (int s = 0; s < NCHUNK; ++s) {
                LAS unsigned char* cur = lds + (s % 3) * SC_BUF;
                bf16x8 vf[2];
#pragma unroll
                for (int kp = 0; kp < 2; ++kp) vf[kp] = *(const LAS bf16x8*)(cur + SC_VT + fr * 144 + (32 * kp + 8 * g) * 2);
#pragma unroll
                for (int j = 0; j < 8; ++j) { const f32x4 dc = *(const LAS f32x4*)(cur + SC_DEC + (16 * j + 4 * g) * 4); S[j] = S[j] * dc; }
#pragma unroll
                for (int j = 0; j < 8; ++j)
#pragma unroll
                    for (int kp = 0; kp < 2; ++kp) { const bf16x8 kf = *(const LAS bf16x8*)(cur + SC_KDT + (16 * j + fr) * 144 + (32 * kp + 8 * g) * 2);
                        S[j] = __builtin_amdgcn_mfma_f32_16x16x32_bf16(kf, vf[kp], S[j], 0, 0, 0); }
                LAS unsigned char* sap = lds + SC_SA + (s & 1) * 4096 + lane * 16;
#pragma unroll
                for (int kap = 0; kap < 4; ++kap) { const f32x4 lo = S[2 * kap], hi = S[2 * kap + 1];
                    *(LAS v4u*)(sap + kap * 1024) = (v4u){cvtpk(lo[0], lo[1]), cvtpk(lo[2], lo[3]), cvtpk(hi[0], hi[1]), cvtpk(hi[2], hi[3])}; }
                __syncthreads();
            }
        } else {
#pragma unroll 1
            for (int s = 0; s < NCHUNK; ++s) {
                if (s >= 1 && s + 2 < NCHUNK && (s + 2) % 3 == pr) { scan_store(lds + ((s + 2) % 3) * SC_BUF, r, pl); if (s + 5 < NCHUNK) scan_load(r, SCAN_SRC(s + 5), pl); }
                __syncthreads();
            }
        }
#undef SCAN_SRC
    }
}
constexpr size_t WS_BAR = 68 * MiB + 256 * 1024;
#define XB_TMO      128
#define XB_XCNT(j)  (256  + 64 * (j))
#define XB_XSUB(j)  (1280 + 64 * (j))
#define XB_XGEN(j)  (2304 + 64 * (j))
#define XB_TOP      3328
#define XB_TOPGEN   3392
#define XCD_BAR_WORDS 3456
#define XB_SPIN_CAP (1u << 18)

__device__ __forceinline__ unsigned xb_ld(unsigned* p)              { return __hip_atomic_load(p, __ATOMIC_RELAXED, __HIP_MEMORY_SCOPE_AGENT); }
__device__ __forceinline__ unsigned xb_add(unsigned* p, unsigned v) { return __hip_atomic_fetch_add(p, v, __ATOMIC_RELAXED, __HIP_MEMORY_SCOPE_AGENT); }
__device__ __forceinline__ unsigned xb_xcc_id() { return (unsigned)__builtin_amdgcn_s_getreg((3 << 11) | 20) & 0xFu; }
#define XB_SPIN(cond, bar) do { unsigned _sp = 0; while (cond) { __builtin_amdgcn_s_sleep(1); \
    if ((++_sp & 255u) == 0u) { if (xb_ld(&(bar)[XB_TMO])) break; if (_sp > XB_SPIN_CAP) { atomicAdd(&(bar)[XB_TMO], 1u); break; } } } } while (0)

struct XcdBarrier {
    unsigned* bar; unsigned x;
    volatile LAS unsigned* st;
};

__device__ __forceinline__ XcdBarrier xcd_barrier_post(unsigned* bar, volatile LAS unsigned* st) {
    XcdBarrier b; b.bar = bar; b.x = xb_xcc_id(); b.st = st;
    if (threadIdx.x == 0) (void)xb_add(&bar[XB_XCNT(b.x)], 1u);
    return b;
}
__device__ __forceinline__ void xcd_barrier_complete(unsigned* bar, unsigned x, unsigned& nloc, unsigned& nx) {
    const unsigned G = gridDim.x * gridDim.y * gridDim.z;
    unsigned sum, cnt, mine, sp = 0u;
    for (;;) {
        sum = 0u; cnt = 0u; mine = 0u;
#pragma unroll
        for (unsigned j = 0; j < 16; ++j) { const unsigned c = xb_ld(&bar[XB_XCNT(j)]); sum += c; cnt += (c > 0u) ? 1u : 0u; mine = (j == x) ? c : mine; }
        if (sum == G) break;
        __builtin_amdgcn_s_sleep(1);
        if ((++sp & 255u) == 0u) { if (xb_ld(&bar[XB_TMO])) break; if (sp > XB_SPIN_CAP) { atomicAdd(&bar[XB_TMO], 1u); break; } }
    }
    nloc = mine > 0u ? mine : 1u; nx = cnt > 0u ? cnt : 1u;
}

__device__ __forceinline__ void xcd_barrier(const XcdBarrier& b) {
    asm volatile("s_waitcnt vmcnt(0)" ::: "memory");
    __syncthreads();
    if (threadIdx.x == 0) {
        unsigned* bar = b.bar;
        __builtin_amdgcn_s_waitcnt(0);
        unsigned nloc = b.st[0], nx = b.st[1];
        if (nloc == 0u) { xcd_barrier_complete(bar, b.x, nloc, nx); b.st[0] = nloc; b.st[1] = nx; }
        const unsigned old = xb_add(&bar[XB_XSUB(b.x)], 1u);
        const unsigned gen = old / nloc;
        if (old + 1u == (gen + 1u) * nloc) {
            __builtin_amdgcn_fence(__ATOMIC_RELEASE, "agent");
            asm volatile("s_waitcnt vmcnt(0)" ::: "memory");
            const unsigned og = xb_add(&bar[XB_TOP], 1u);
            const unsigned tg = og / nx;
            if (og + 1u == (tg + 1u) * nx) xb_add(&bar[XB_TOPGEN], 1u);
            else XB_SPIN(xb_ld(&bar[XB_TOPGEN]) == tg, bar);
            __builtin_amdgcn_fence(__ATOMIC_ACQUIRE, "agent");
            xb_add(&bar[XB_XGEN(b.x)], 1u);
            asm volatile("s_waitcnt vmcnt(0)" ::: "memory");
        } else {
            XB_SPIN(xb_ld(&bar[XB_XGEN(b.x)]) == gen, bar);
            __builtin_amdgcn_fence(__ATOMIC_ACQUIRE, "agent");
            asm volatile("s_waitcnt vmcnt(0)" ::: "memory");
        }
    }
    __syncthreads();
}

#ifndef ONE_LAUNCH
#define ONE_LAUNCH 1
#endif
constexpr int NPH = 13;
__global__ void __launch_bounds__(NTHREADS, 2) fwd_kernel(Args a) {
    extern __shared__ __attribute__((aligned(16))) unsigned char lds_raw[];
    LAS unsigned char* lds = (LAS unsigned char*)lds_raw;
    const int tid = threadIdx.x, lane = tid & 63, wave = __builtin_amdgcn_readfirstlane(tid >> 6), bid = blockIdx.x, G = gridDim.x;
    unsigned char* ws = a.ws;
    const int lo = a.ph_lo, hi = a.ph_hi;
    volatile LAS unsigned* bst = (volatile LAS unsigned*)(lds + LDS_BYTES - 16);
    if (tid < 2) bst[tid] = 0u;
    __syncthreads();
    XcdBarrier xbar = xcd_barrier_post((unsigned*)(a.ws + WS_BAR), bst);
    const int vb = (G == 256) ? (bid & 7) * 32 + (bid >> 3) : bid;
#define IN(k) (lo <= (k) && (k) < hi)
#define SEAM(k) do { if (IN(k) && IN((k) + 1)) { if (hi > 1000) cg::this_grid().sync(); else xcd_barrier(xbar); } } while (0)
    pg8::EP ep;
    ep.Q = (bf16*)((unsigned char*)a.out + DO_Q); ep.K = (bf16*)(ws + WS_K); ep.V = (bf16*)((unsigned char*)a.out + DO_V); ep.R = (float*)(ws + WS_R);
    ep.GT2 = (bf16*)(ws + WS_GT2); ep.PQ = (bf16*)(ws + WS_PQ); ep.SGA = (bf16*)(ws + WS_SGA); ep.SGF = (bf16*)(ws + WS_SGF); ep.ON = (bf16*)(ws + WS_ON);
    ep.OG = (bf16*)(ws + WS_OG); ep.MG = (bf16*)(ws + WS_MG); ep.H1B = (bf16*)(ws + WS_H1B); ep.HF = (bf16*)(ws + WS_HF);
    ep.x = a.x; ep.H = a.out; ep.PART1 = (float*)(ws + WS_PART1); ep.gnorm = a.gla_norm;
    const bf16* ALL = (const bf16*)(ws + WS_ALL);

    if (IN(0)) { p0_prologue(a, lds, tid, lane, wave, bid, G); }
    SEAM(0);
    if (IN(1)) { pg8::Gemm g{ALL, ALL, 0, 0, 1024}; pg8::Sched S{1, 845, G, vb, 0, 0, 0}; pg8::Epi<1> E{ep};
        pg8::gemm_phase<pg8::Epi<1>, pg8::Sched, true, true>(lds, g, S, E);
        if (G == 256) { if (vb >= 77) gen_cs_tab(a, lds, tid, vb - 77, 256 - 77); }
        else gen_cs_tab(a, lds, tid, bid, G); }
    SEAM(1);
    if (IN(2)) { p2_sym_rem(a, tid, lane, wave, bid, G); }
    SEAM(2);
    if (IN(3)) { pg8::Gemm g{(const bf16*)(ws + WS_CS), (const bf16*)(ws + WS_EOT), 0, 0, KH}; pg8::Sched S{2, 256, G, vb, 0, 0, 0}; pg8::Epi<2> E{ep};
        pg8::gemm_phase<pg8::Epi<2>, pg8::Sched, true, true>(lds, g, S, E); }
    SEAM(3);
    if (IN(4)) { p4_gla_prep(a, lds, tid, lane, wave, bid, G); p4_combine(a, tid, bid, G); }
    SEAM(4);
    if (IN(5)) { p5_scan(a, lds, tid, lane, wave, vb, G); }
    SEAM(5);
    if (IN(6)) { p6_post(a, lane, wave, bid, G);
        pg8::Gemm g{ALL, ALL, 0, 0, 1024}; pg8::Sched S{3, 512, G, vb, 8, 0, 82}; pg8::Epi<3> E{ep};
        pg8::gemm_phase<pg8::Epi<3>, pg8::Sched, true, true>(lds, g, S, E); }
    SEAM(6);
    if (IN(7)) {
        { pg8::Gemm g{ALL, ALL, 0, 0, 1024}; pg8::Sched S{3, 256, G, vb, 4, 0, 78}; pg8::Epi<4> E{ep};
          pg8::gemm_phase<pg8::Epi<4>, pg8::Sched, true, true>(lds, g, S, E); }
        { pg8::Gemm g{(const bf16*)(ws + WS_FN), (const bf16*)(ws + WS_WFT), 0, 0, 512}; pg8::Sched S{3, 256, G, vb, 4, 0, 0}; pg8::Epi<5> E{ep};
          pg8::gemm_phase<pg8::Epi<5>, pg8::Sched, true, true>(lds, g, S, E); }
    }
    SEAM(7);
    if (IN(8)) { pg8::Gemm g{(const bf16*)(ws + WS_OG), (const bf16*)(ws + WS_WOT), 0, 0, 1024}; pg8::Sched S{3, 256, G, vb, 4, 0, 0}; pg8::Epi<6> E{ep};
        pg8::gemm_phase<pg8::Epi<6>, pg8::Sched, true, true>(lds, g, S, E); }
    SEAM(8);
    if (IN(9)) { pg8::Gemm g{(const bf16*)(ws + WS_MG), (const bf16*)(ws + WS_WOUTT), 0, 0, 1024}; pg8::Sched S{3, 256, G, vb, 4, 0, 0}; pg8::Epi<7> E{ep};
        pg8::gemm_phase<pg8::Epi<7>, pg8::Sched, true, true>(lds, g, S, E); }
    SEAM(9);
    if (IN(10)) { pg8::Gemm g{(const bf16*)(ws + WS_H1B), (const bf16*)(ws + WS_W1T), 0, 0, 1024}; pg8::Sched S{3, 1024, G, vb, 16, 0, 0}; pg8::Epi<8> E{ep};
        pg8::gemm_phase<pg8::Epi<8>, pg8::Sched, true, true>(lds, g, S, E); }
    SEAM(10);
    if (IN(11)) { pg8::Gemm g{(const bf16*)(ws + WS_HF), (const bf16*)(ws + WS_W2T), 0, 0, 4096}; pg8::Sched S{3, 256, G, vb, 4, 0, 0}; pg8::Epi<9> E{ep};
        pg8::gemm_phase<pg8::Epi<9>, pg8::Sched, true, true>(lds, g, S, E); }
    SEAM(11);
    if (IN(12)) { p11_final(a, lane, wave, bid, G); }
#ifdef PROBE_REP
    if (IN(13)) { pg8::Gemm g{(const bf16*)(ws + WS_HF), (const bf16*)(ws + WS_W2T), 0, 0, 4096}; pg8::Sched S{3, 256, G, vb, 4, 0, 0}; pg8::Epi<10> E{ep};
        pg8::gemm_phase<pg8::Epi<10>, pg8::Sched, true, true>(lds, g, S, E); }
    if (IN(14)) { const int gw = bid * NWAVES + wave, NGW = G * NWAVES;
        for (int row = gw; row < NREAL; row += NGW) { f32x4* xr = (f32x4*)(a.out + (size_t)row * D) + lane; float s = 0.f;
            for (int j = 0; j < 4; ++j) { const f32x4 v = xr[64 * j]; s += v.x + v.y + v.z + v.w; }
            if (wave_sum(s) == 123456.789f) xr[0] = (f32x4){s, s, s, s}; } }
#endif
#undef IN
#undef SEAM
}

extern "C" void kernel_launch(void* const* d_in, const int* in_sizes, int n_in, void* d_out, int out_size, void* d_ws, size_t ws_size, hipStream_t stream) {
    static int grid = 0;
    if (grid == 0) {
        int dev = 0, cus = 0, per_cu = 0;
        (void)hipGetDevice(&dev); (void)hipDeviceGetAttribute(&cus, hipDeviceAttributeMultiprocessorCount, dev);
        (void)hipFuncSetAttribute((const void*)fwd_kernel, hipFuncAttributeMaxDynamicSharedMemorySize, LDS_BYTES);
        (void)hipOccupancyMaxActiveBlocksPerMultiprocessor(&per_cu, (const void*)fwd_kernel, NTHREADS, LDS_BYTES);
        (void)hipGetLastError();
        if (per_cu < 1) { fprintf(stderr, "kernel_launch: occupancy query says %d blocks/CU\n", per_cu); per_cu = 1; }
        grid = cus * 1;
        if (grid > 256) grid = 256;
    }
    (void)hipMemsetAsync((char*)d_ws + WS_BAR, 0, 16384, stream);
    Args a{};
    const float* const* in = (const float* const*)d_in;
    a.x = in[0]; a.meta = in[1]; a.norm_mix = in[2]; a.w_in = in[3]; a.wdf = in[4]; a.bdf = in[5]; a.wdb = in[6]; a.bdb = in[7]; a.gla_norm = in[8];
    a.w_o = in[9]; a.w_fnet = in[10]; a.w_out = in[11]; a.norm_ffn = in[12]; a.w_ff1 = in[13]; a.w_ff2 = in[14]; a.norm_final = in[15];
    a.out = (float*)d_out; a.ws = (unsigned char*)d_ws;
#if ONE_LAUNCH
    a.ph_lo = 0; a.ph_hi = NPH;
    void* args[] = {&a};
    hipError_t e = hipLaunchCooperativeKernel((const void*)fwd_kernel, dim3(grid), dim3(NTHREADS), args, LDS_BYTES, stream);
    if (e != hipSuccess) fprintf(stderr, "cooperative launch failed: %s (grid %d)\n", hipGetErrorString(e), grid);
#else
    for (int p = 0; p < NPH; ++p) { a.ph_lo = p; a.ph_hi = p + 1; hipLaunchKernelGGL(fwd_kernel, dim3(grid), dim3(NTHREADS), LDS_BYTES, stream, a);
#ifdef PROBE_REP
        if (p == PROBE_REP) for (int q = 0; q < PROBE_N; ++q) hipLaunchKernelGGL(fwd_kernel, dim3(grid), dim3(NTHREADS), LDS_BYTES, stream, a);
#ifdef PROBE_DRY
        if (p == PROBE_AFTER) { Args a2 = a; a2.ph_lo = PROBE_DRY; a2.ph_hi = PROBE_DRY + 1; for (int q = 0; q < PROBE_N; ++q) hipLaunchKernelGGL(fwd_kernel, dim3(grid), dim3(NTHREADS), LDS_BYTES, stream, a2); }
#endif
#endif
    }
#endif
}
```

```cpp
#include <hip/hip_runtime.h>
#include <hip/hip_cooperative_groups.h>
#include <cstdio>
#include <cstdint>
namespace cg = cooperative_groups;
namespace pg8 {
#define PG8_LAS __attribute__((address_space(3)))
typedef unsigned short bf16_t;
typedef short bf16x8 __attribute__((ext_vector_type(8)));
typedef float f32x4 __attribute__((ext_vector_type(4)));
typedef unsigned u32x4 __attribute__((ext_vector_type(4)));
constexpr int BM = 256, BK = 64, HALF = 128, HTB = HALF * BK * 2  , STAGE_BYTES = 8 * HTB, NXCD = 8, WGM = 8;

__host__ __device__ __forceinline__ int lds_byte(int r, int c) { const int st = (r >> 4) * 2 + (c >> 5), rr = r & 15, cc = c & 31, ob = rr * 64 + cc * 2; return st * 1024 + (ob ^ (((ob >> 9) & 1) << 5)); }
__host__ __device__ __forceinline__ void stage_rc(int b, int& R, int& C) { const int st = b / 1024, sb = b % 1024, swz = sb ^ (((sb >> 9) & 1) << 5); R = (st >> 1) * 16 + swz / 64; C = (st & 1) * 32 + (swz % 64) / 2; }
__host__ __device__ __forceinline__ int perm32(int rho) { const int n = rho >> 4, i = rho & 15; return 8 * (i >> 2) + 4 * n + (i & 3); }

struct Unit { int pm, pn; };
struct Gemm { const bf16_t* A; const bf16_t* Bt; int M, N, K; };

__device__ __forceinline__ unsigned cvt_pk_bf16(float lo, float hi) { unsigned r; asm volatile("v_cvt_pk_bf16_f32 %0, %1, %2" : "=v"(r) : "v"(lo), "v"(hi)); return r; }
__device__ __forceinline__ float bflo(unsigned w) { return __uint_as_float(w << 16); }
__device__ __forceinline__ float bfhi(unsigned w) { return __uint_as_float(w & 0xffff0000u); }

struct Sched {
    int mode, n, G, c, nN, offM, offN;
    __device__ __forceinline__ bool next(int i, Unit& u) const {
        const int L = i * G + c; if (L >= n) return false;
        if (mode == 1) {
            if (L < 585) { u.pm = L / 9; u.pn = 65 + L % 9; }
            else { const int l2 = L - 585; u.pm = 65 + 9 + (l2 & 3); u.pn = l2 >> 2; }
        } else if (mode == 2) {
            const int grp = L >> 6, r = L & 63; u.pm = grp * 16 + (r >> 2); u.pn = grp * 4 + (r & 3);
        } else if (mode == 5) {
            const int x = c >> 4, ul = i * 16 + (c & 15);
            if (i * 128 + c >= n) return false;
            u.pm = 8 * x + (ul & 7) + offM; u.pn = (ul >> 3) + offN;
        } else {
            const int x = (L & 255) >> 5, ul = (L >> 8) * 32 + (L & 31);
            u.pm = 8 * x + (ul & 7) + offM; u.pn = (ul >> 3) + offN; }
        return true;
    }
    __device__ __forceinline__ void a_ready(const Unit&) const {}
    __device__ __forceinline__ void done(const Unit&) const {}
};

struct EP {
    bf16_t *Q, *K, *V; float* R; bf16_t* GT2; bf16_t* PQ; bf16_t *SGA, *SGF, *ON, *OG, *MG, *H1B, *HF;
    const float* x; float* H; float* PART1; const float* gnorm; bf16_t* H2B;
};
constexpr int LDG = 8320;
template <int MODE> struct Epi {
    static constexpr bool PERM = true, AFTER_DRAIN = false;
    EP p;
    __device__ __forceinline__ void operator()(const f32x4 (&acc)[2][2][4][2], const Unit& u, int wr, int wc, int fr, int fq) const {
#pragma unroll
        for (int ai = 0; ai < 2; ++ai)
#pragma unroll
            for (int m = 0; m < 4; ++m) {
                const int r = ai * HALF + wr * 64 + m * 16 + fr;
                float ss = 0.f;
                float rstd = 1.f;
                if (MODE == 8) { const float* pp = p.PART1 + (size_t)(u.pm * BM + r) * 16; float s = 0.f;
#pragma unroll
                    for (int t = 0; t < 4; ++t) { const f32x4 q4 = *(const f32x4*)(pp + 4 * t); s += (q4[0] + q4[1]) + (q4[2] + q4[3]); }
                    rstd = 1.0f / sqrtf(s * (1.0f / 1024.0f) + 1e-6f); }
#pragma unroll
                for (int bj = 0; bj < 2; ++bj) {
                    const int c = bj * HALF + wc * 32 + 8 * fq;
                    f32x4 v0 = acc[ai][bj][m][0], v1 = acc[ai][bj][m][1];
                    if (MODE == 1) {
                        if (u.pm < 65) {
                            const int t = u.pn - 65; const size_t row = (size_t)u.pm * BM + r;
                            if (t < 8) {
                                bf16_t* dst; float sc = 1.f;
                                if (t < 2) { dst = p.Q + row * 512 + t * 256 + c; sc = 0.08838834764831845f; }
                                else if (t < 4) dst = p.K + row * 512 + (t - 2) * 256 + c;
                                else dst = p.V + row * 1024 + (t - 4) * 256 + c;
                                u32x4 w; w.x = cvt_pk_bf16(v0[0] * sc, v0[1] * sc); w.y = cvt_pk_bf16(v0[2] * sc, v0[3] * sc); w.z = cvt_pk_bf16(v1[0] * sc, v1[1] * sc); w.w = cvt_pk_bf16(v1[2] * sc, v1[3] * sc);
                                *(u32x4*)dst = w;
                            } else if (c < 32) { float* dst = p.R + row * 32 + c; *(f32x4*)dst = v0; *(f32x4*)(dst + 4) = v1; }
                        } else {
                            const int gcol = (u.pm - 74) * BM + r, cs = gcol >> 9, col = gcol & 511;
                            u32x4 w; w.x = cvt_pk_bf16(v0[0], v0[1]); w.y = cvt_pk_bf16(v0[2], v0[3]); w.z = cvt_pk_bf16(v1[0], v1[1]); w.w = cvt_pk_bf16(v1[2], v1[3]);
                            if (u.pn < 64) { const int b = u.pn >> 5, l = 16 + (u.pn & 31) * 256 + c;
                                *(u32x4*)(p.GT2 + ((size_t)(b * 512 + col) * 2 + cs) * LDG + l) = w; }
                            else if (c == 48 || c == 56) { const int l = c - 48;
                                *(u32x4*)(p.GT2 + ((size_t)(col) * 2 + cs) * LDG + l) = w; *(u32x4*)(p.GT2 + ((size_t)(512 + col) * 2 + cs) * LDG + l) = w; }
                        }
                    } else if (MODE == 2) {
                        const int grp = u.pm >> 4; const size_t idx = (size_t)(u.pm & 15) * BM + r; const int n = (u.pn & 3) * BM + c;
                        u32x4 w; w.x = cvt_pk_bf16(v0[0], v0[1]); w.y = cvt_pk_bf16(v0[2], v0[3]); w.z = cvt_pk_bf16(v1[0], v1[1]); w.w = cvt_pk_bf16(v1[2], v1[3]);
                        *(u32x4*)(p.PQ + ((size_t)grp * 4096 + idx) * 1024 + n) = w;
                    } else if (MODE == 3) {
                        const int t = u.pn - 82; const size_t row = (size_t)u.pm * BM + r;
                        bf16_t* dst = (t < 4 ? p.SGA : p.SGF) + row * 1024 + (t & 3) * 256 + c;
                        float s[8];
#pragma unroll
                        for (int e = 0; e < 4; ++e) { s[e] = 1.f / (1.f + __expf(-v0[e])); s[4 + e] = 1.f / (1.f + __expf(-v1[e])); }
                        u32x4 w; w.x = cvt_pk_bf16(s[0], s[1]); w.y = cvt_pk_bf16(s[2], s[3]); w.z = cvt_pk_bf16(s[4], s[5]); w.w = cvt_pk_bf16(s[6], s[7]);
                        *(u32x4*)dst = w;
                    } else if (MODE == 4) {
                        const int t = u.pn - 78; const size_t off = ((size_t)u.pm * BM + r) * 1024 + t * 256 + c;
                        const u32x4 o = *(const u32x4*)(p.ON + off);
                        float s[8];
#pragma unroll
                        for (int e = 0; e < 4; ++e) { s[e] = v0[e] / (1.f + __expf(-v0[e])); s[4 + e] = v1[e] / (1.f + __expf(-v1[e])); }
                        u32x4 w; w.x = cvt_pk_bf16(s[0] * bflo(o.x), s[1] * bfhi(o.x)); w.y = cvt_pk_bf16(s[2] * bflo(o.y), s[3] * bfhi(o.y));
                        w.z = cvt_pk_bf16(s[4] * bflo(o.z), s[5] * bfhi(o.z)); w.w = cvt_pk_bf16(s[6] * bflo(o.w), s[7] * bfhi(o.w));
                        *(u32x4*)(p.OG + off) = w;
                    } else if (MODE == 5 || MODE == 6) {
                        const size_t off = ((size_t)u.pm * BM + r) * 1024 + u.pn * BM + c;
                        const u32x4 gt = *(const u32x4*)((MODE == 5 ? p.SGF : p.SGA) + off);
                        float s[8] = {v0[0] * bflo(gt.x), v0[1] * bfhi(gt.x), v0[2] * bflo(gt.y), v0[3] * bfhi(gt.y), v1[0] * bflo(gt.z), v1[1] * bfhi(gt.z), v1[2] * bflo(gt.w), v1[3] * bfhi(gt.w)};
                        if (MODE == 6) { const u32x4 mg = *(const u32x4*)(p.MG + off);
                            s[0] += bflo(mg.x); s[1] += bfhi(mg.x); s[2] += bflo(mg.y); s[3] += bfhi(mg.y); s[4] += bflo(mg.z); s[5] += bfhi(mg.z); s[6] += bflo(mg.w); s[7] += bfhi(mg.w); }
                        u32x4 w; w.x = cvt_pk_bf16(s[0], s[1]); w.y = cvt_pk_bf16(s[2], s[3]); w.z = cvt_pk_bf16(s[4], s[5]); w.w = cvt_pk_bf16(s[6], s[7]);
                        *(u32x4*)(p.MG + off) = w;
                    } else if (MODE == 7) {
                        const size_t off = ((size_t)u.pm * BM + r) * 1024 + u.pn * BM + c;
                        const f32x4 x0 = *(const f32x4*)(p.x + off), x1 = *(const f32x4*)(p.x + off + 4);
                        v0 = v0 + x0; v1 = v1 + x1;
                        u32x4 w; w.x = cvt_pk_bf16(v0[0], v0[1]); w.y = cvt_pk_bf16(v0[2], v0[3]); w.z = cvt_pk_bf16(v1[0], v1[1]); w.w = cvt_pk_bf16(v1[2], v1[3]);
                        *(u32x4*)(p.H1B + off) = w;
                        ss += (v0[0] * v0[0] + v0[1] * v0[1]) + (v0[2] * v0[2] + v0[3] * v0[3]) + (v1[0] * v1[0] + v1[1] * v1[1]) + (v1[2] * v1[2] + v1[3] * v1[3]);
                    } else if (MODE == 8) {
                        const size_t off = ((size_t)u.pm * BM + r) * 4224 + u.pn * BM + c;
                        float s[8];
#pragma unroll
                        for (int e = 0; e < 4; ++e) { float a = fmaxf(v0[e] * rstd, 0.f), b = fmaxf(v1[e] * rstd, 0.f); s[e] = a * a; s[4 + e] = b * b; }
                        u32x4 w; w.x = cvt_pk_bf16(s[0], s[1]); w.y = cvt_pk_bf16(s[2], s[3]); w.z = cvt_pk_bf16(s[4], s[5]); w.w = cvt_pk_bf16(s[6], s[7]);
                        __builtin_nontemporal_store(w, (u32x4*)(p.HF + off));
                    } else if (MODE == 10) {
                        const size_t off = ((size_t)u.pm * BM + r) * 1024 + u.pn * BM + c;
                        const f32x4 x0 = *(const f32x4*)(p.H + off), x1 = *(const f32x4*)(p.H + off + 4);
                        if (v0[0] + x0[0] + x1[1] + v1[2] == 123456.789f) { *(f32x4*)(p.H + off) = v0 + x0; }
                    } else if (MODE == 9) {
                        const size_t off = ((size_t)u.pm * BM + r) * 1024 + u.pn * BM + c;
                        const u32x4 hb = *(const u32x4*)(p.H1B + off);
                        const f32x4 x0 = {bflo(hb.x), bfhi(hb.x), bflo(hb.y), bfhi(hb.y)}, x1 = {bflo(hb.z), bfhi(hb.z), bflo(hb.w), bfhi(hb.w)};
                        v0 = v0 + x0; v1 = v1 + x1;
                        u32x4 w; w.x = cvt_pk_bf16(v0[0], v0[1]); w.y = cvt_pk_bf16(v0[2], v0[3]); w.z = cvt_pk_bf16(v1[0], v1[1]); w.w = cvt_pk_bf16(v1[2], v1[3]);
                        *(u32x4*)(p.H2B + off) = w;
                        ss += (v0[0] * v0[0] + v0[1] * v0[1]) + (v0[2] * v0[2] + v0[3] * v0[3]) + (v1[0] * v1[0] + v1[1] * v1[1]) + (v1[2] * v1[2] + v1[3] * v1[3]);
                    }
                }
                if (MODE == 7 || MODE == 9) { ss += __shfl_xor(ss, 16); ss += __shfl_xor(ss, 32);
                    if (fq == 0) p.PART1[(size_t)(u.pm * BM + r) * 16 + u.pn * 4 + wc] = ss; }
            }
    }
};
template <class Epi, class Sched, bool ALIGN_EPI = false, bool SP2 = false>
__device__ __forceinline__ void gemm_phase(PG8_LAS unsigned char* lds, const Gemm g, const Sched& S, const Epi& E) {
    const int tid = threadIdx.x, wid = __builtin_amdgcn_readfirstlane(tid >> 6), lane = tid & 63, wr = wid >> 2, wc = wid & 3, fr = lane & 15, fq = lane >> 4;
    const int K = g.K, nt = K / BK;
    const int lda = g.M > 0 ? g.M : K, ldb = g.N > 0 ? g.N : K;
    unsigned voffA[2], voffB[2];
#pragma unroll
    for (int i = 0; i < 2; ++i) { int R, C; stage_rc(tid * 16 + i * 8192, R, C); const int Rb = Epi::PERM ? ((R & ~31) + perm32(R & 31)) : R;
        voffA[i] = (unsigned)(R * lda + C) * 2u; voffB[i] = (unsigned)(Rb * ldb + C) * 2u; }
    const size_t kstep = (size_t)(BK * 2);
    const size_t hstepA = (size_t)HALF * lda * 2, hstepB = (size_t)HALF * ldb * 2;
    const size_t tstepA = 2 * hstepA, tstepB = 2 * hstepB;
    const unsigned ldsw = (unsigned)wid * 1024u;
    const int aoff = lds_byte(wr * 64 + fr, fq * 8), boff = lds_byte(wc * 32 + fr, fq * 8);
#define PG8_SA(b, h) (((b) * 2 + (h)) * HTB)
#define PG8_SB(b, h) ((4 + (b) * 2 + (h)) * HTB)
#define PG8_STAGE(bufoff, gbase, voff) do { _Pragma("unroll") for (int _i = 0; _i < 2; ++_i) \
        __builtin_amdgcn_global_load_lds((const unsigned*)((const char*)(gbase) + (voff)[_i]), (PG8_LAS unsigned*)(lds + (bufoff) + ldsw + _i * 8192), 16, 0, 0); } while (0)
#define PG8_LDA(dst, b, h) do { _Pragma("unroll") for (int m = 0; m < 4; ++m) _Pragma("unroll") for (int k = 0; k < 2; ++k) dst[m][k] = *(const PG8_LAS bf16x8*)(lds + PG8_SA(b, h) + aoff + m * 2048 + k * 1024); } while (0)
#define PG8_LDB(dst, b, h) do { _Pragma("unroll") for (int n = 0; n < 2; ++n) _Pragma("unroll") for (int k = 0; k < 2; ++k) dst[n][k] = *(const PG8_LAS bf16x8*)(lds + PG8_SB(b, h) + boff + n * 2048 + k * 1024); } while (0)
#define PG8_MMA(ai, bj, At, Bt) do { __builtin_amdgcn_s_setprio(1); _Pragma("unroll") for (int m = 0; m < 4; ++m) _Pragma("unroll") for (int n = 0; n < 2; ++n) _Pragma("unroll") for (int k = 0; k < 2; ++k) \
        acc[ai][bj][m][n] = __builtin_amdgcn_mfma_f32_16x16x32_bf16(Bt[n][k], At[m][k], acc[ai][bj][m][n], 0, 0, 0); __builtin_amdgcn_s_setprio(0); } while (0)
#define PG8_WAIT_V(n) asm volatile("s_waitcnt vmcnt(" #n ")" ::: "memory")
#define PG8_WAIT_L(n) asm volatile("s_waitcnt lgkmcnt(" #n ")" ::: "memory")
#define PG8_BAR __builtin_amdgcn_s_barrier()
#define PG8_SCHED __builtin_amdgcn_sched_barrier(0)
    Unit cur, nxt; int ui = 0;
    if (!S.next(0, cur)) return;
    f32x4 acc[2][2][4][2];
#pragma unroll
    for (int a = 0; a < 2; ++a)
#pragma unroll
        for (int b = 0; b < 2; ++b)
#pragma unroll
            for (int m = 0; m < 4; ++m)
#pragma unroll
                for (int n = 0; n < 2; ++n) acc[a][b][m][n] = (f32x4){0.f, 0.f, 0.f, 0.f};
    bf16x8 At[4][2], B0[2][2], B1[2][2];
    const char* cA = (const char*)g.A + (size_t)cur.pm * tstepA; const char* cB = (const char*)g.Bt + (size_t)cur.pn * tstepB;
    S.a_ready(cur);
    if constexpr (SP2) {
        PG8_STAGE(PG8_SB(0, 0), cB, voffB); PG8_STAGE(PG8_SB(0, 1), cB + hstepB, voffB); PG8_STAGE(PG8_SA(0, 0), cA, voffA); PG8_STAGE(PG8_SA(0, 1), cA + hstepA, voffA);
        if (wr == 1) PG8_BAR;
        PG8_WAIT_V(2); PG8_BAR;
        PG8_STAGE(PG8_SB(1, 0), cB + kstep, voffB); PG8_STAGE(PG8_SA(1, 0), cA + kstep, voffA); PG8_STAGE(PG8_SB(1, 1), cB + hstepB + kstep, voffB);
        PG8_WAIT_V(6); PG8_BAR;
    } else {
        PG8_STAGE(PG8_SB(0, 0), cB, voffB); PG8_STAGE(PG8_SA(0, 0), cA, voffA); PG8_STAGE(PG8_SB(0, 1), cB + hstepB, voffB); PG8_STAGE(PG8_SA(0, 1), cA + hstepA, voffA);
        if (wr == 1) PG8_BAR;
        PG8_WAIT_V(4); PG8_BAR;
        PG8_STAGE(PG8_SB(1, 0), cB + kstep, voffB); PG8_STAGE(PG8_SA(1, 0), cA + kstep, voffA); PG8_STAGE(PG8_SB(1, 1), cB + hstepB + kstep, voffB);
        PG8_WAIT_V(6); PG8_BAR;
    }
    for (;;) {
        const bool has_next = S.next(ui + 1, nxt);
        const char* nA = has_next ? (const char*)g.A + (size_t)nxt.pm * tstepA : cA; const char* nB = has_next ? (const char*)g.Bt + (size_t)nxt.pn * tstepB : cB;
        for (int t = 0; t < nt; t += 2) {
            const bool last = (t == nt - 2);
            const char* a1 = cA + (size_t)(t + 1) * kstep;
            const char* a2 = last ? nA : cA + (size_t)(t + 2) * kstep; const char* b2 = last ? nB : cB + (size_t)(t + 2) * kstep;
            const char* a3 = a2 + kstep; const char* b3 = b2 + kstep;
            if (last && has_next) S.a_ready(nxt);
            if constexpr (SP2) {
            PG8_LDB(B0, 0, 0); PG8_LDB(B1, 0, 1); PG8_SCHED; PG8_LDA(At, 0, 0); PG8_STAGE(PG8_SA(1, 1), a1 + hstepA, voffA);
            PG8_WAIT_V(8); PG8_WAIT_L(0); PG8_BAR; PG8_MMA(0, 0, At, B0); PG8_MMA(0, 1, At, B1); PG8_BAR; PG8_SCHED;
            PG8_LDA(At, 0, 1); PG8_STAGE(PG8_SB(0, 0), b2, voffB); PG8_STAGE(PG8_SB(0, 1), b2 + hstepB, voffB); PG8_STAGE(PG8_SA(0, 0), a2, voffA);
            PG8_WAIT_V(8); PG8_WAIT_L(0); PG8_BAR; PG8_MMA(1, 0, At, B0); PG8_MMA(1, 1, At, B1); PG8_BAR; PG8_SCHED;
            PG8_LDB(B0, 1, 0); PG8_LDB(B1, 1, 1); PG8_SCHED; PG8_LDA(At, 1, 0); PG8_STAGE(PG8_SA(0, 1), a2 + hstepA, voffA);
            PG8_WAIT_V(8); PG8_WAIT_L(0); PG8_BAR; PG8_MMA(0, 0, At, B0); PG8_MMA(0, 1, At, B1); PG8_BAR; PG8_SCHED;
            PG8_LDA(At, 1, 1); PG8_STAGE(PG8_SB(1, 0), b3, voffB); PG8_STAGE(PG8_SB(1, 1), b3 + hstepB, voffB); PG8_STAGE(PG8_SA(1, 0), a3, voffA);
            PG8_WAIT_V(8); PG8_WAIT_L(0); PG8_BAR; PG8_MMA(1, 0, At, B0); PG8_MMA(1, 1, At, B1); PG8_BAR; PG8_SCHED;
            } else {
            PG8_LDB(B0, 0, 0); PG8_SCHED; PG8_LDA(At, 0, 0); PG8_STAGE(PG8_SA(1, 1), a1 + hstepA, voffA);
            PG8_WAIT_L(8); PG8_BAR; PG8_WAIT_L(0); PG8_MMA(0, 0, At, B0); PG8_BAR; PG8_SCHED;
            PG8_LDB(B1, 0, 1); PG8_STAGE(PG8_SB(0, 0), b2, voffB);
            PG8_BAR; PG8_WAIT_L(0); PG8_MMA(0, 1, At, B1); PG8_BAR;
            PG8_LDA(At, 0, 1); PG8_STAGE(PG8_SA(0, 0), a2, voffA);
            PG8_BAR; PG8_WAIT_L(0); PG8_MMA(1, 0, At, B0); PG8_BAR; PG8_SCHED;
            PG8_STAGE(PG8_SB(0, 1), b2 + hstepB, voffB);
            PG8_WAIT_V(6); PG8_BAR; PG8_MMA(1, 1, At, B1); PG8_BAR;
            PG8_LDB(B0, 1, 0); PG8_SCHED; PG8_LDA(At, 1, 0); PG8_STAGE(PG8_SA(0, 1), a2 + hstepA, voffA);
            PG8_WAIT_L(8); PG8_BAR; PG8_WAIT_L(0); PG8_MMA(0, 0, At, B0); PG8_BAR; PG8_SCHED;
            PG8_LDB(B1, 1, 1); PG8_STAGE(PG8_SB(1, 0), b3, voffB);
            PG8_BAR; PG8_WAIT_L(0); PG8_MMA(0, 1, At, B1); PG8_BAR;
            PG8_LDA(At, 1, 1); PG8_STAGE(PG8_SA(1, 0), a3, voffA);
            PG8_BAR; PG8_WAIT_L(0); PG8_MMA(1, 0, At, B0); PG8_BAR; PG8_SCHED;
            PG8_STAGE(PG8_SB(1, 1), b3 + hstepB, voffB);
            PG8_WAIT_V(6); PG8_BAR; PG8_MMA(1, 1, At, B1); PG8_BAR;
            }
        }
        if constexpr (ALIGN_EPI) { if (wr == 0) PG8_BAR; }
        if constexpr (!Epi::AFTER_DRAIN) { E(acc, cur, wr, wc, fr, fq); S.done(cur); }
        if (!has_next) break;
#pragma unroll
        for (int a = 0; a < 2; ++a)
#pragma unroll
            for (int b = 0; b < 2; ++b)
#pragma unroll
                for (int m = 0; m < 4; ++m)
#pragma unroll
                    for (int n = 0; n < 2; ++n) acc[a][b][m][n] = (f32x4){0.f, 0.f, 0.f, 0.f};
        cur = nxt; cA = nA; cB = nB; ++ui;
        if constexpr (ALIGN_EPI) { if (wr == 1) PG8_BAR; }
    }
    PG8_WAIT_V(0);
    if constexpr (!ALIGN_EPI) { if (wr == 0) PG8_BAR; }
    PG8_BAR;
    if constexpr (Epi::AFTER_DRAIN) { E.fused(acc, cur, wr, wc, fr, fq, lds, wid, lane); S.done(cur); }
#undef PG8_SA
#undef PG8_SB
#undef PG8_STAGE
#undef PG8_LDA
#undef PG8_LDB
#undef PG8_MMA
#undef PG8_WAIT_V
#undef PG8_WAIT_L
#undef PG8_BAR
#undef PG8_SCHED
}
}
#define LAS __attribute__((address_space(3)))
#define DI __device__ __forceinline__
typedef unsigned short bf16;
typedef unsigned v4u __attribute__((ext_vector_type(4)));
typedef unsigned v2u __attribute__((ext_vector_type(2)));
typedef float f32x4 __attribute__((ext_vector_type(4)));
typedef short bf16x8 __attribute__((ext_vector_type(8)));
constexpr int NTHREADS = 512, NWAVES = 8;
constexpr int D = 1024, NREAL = 16384, MROWS = 16640, LSEQ = 8208, FF = 4096, DIN = 5664, NCHUNK = 129;
constexpr int LDG = 8320, KH = 2176;
constexpr size_t MiB = 1u << 20;
constexpr size_t WS_PART1 = 0;
constexpr size_t WS_ALL = 1 * MiB;
constexpr size_t WS_WOT = 46 * MiB, WS_WFT = 48 * MiB, WS_WOUTT = 49 * MiB, WS_W1T = 51 * MiB, WS_W2T = 59 * MiB;
constexpr size_t WS_TAB = 67 * MiB + 512 * 1024;
constexpr size_t WS_CS = 69 * MiB;
constexpr size_t WS_GT2 = 137 * MiB;
constexpr size_t WS_EOT = 169 * MiB + 512 * 1024;
constexpr size_t WS_REMP = 186 * MiB + 512 * 1024;
constexpr size_t WS_PQ = 189 * MiB;
constexpr size_t WS_K = 221 * MiB;
constexpr size_t WS_R = 237 * MiB + 512 * 1024;
constexpr size_t WS_FN = 240 * MiB;
constexpr size_t DO_V = 0, DO_Q = 33 * MiB, DO_OB = 0;
constexpr size_t WS_REC = 69 * MiB;
constexpr size_t REC_BYTES = 43008, REC_KDT = 16384, REC_PM = 32768, REC_DEC = 40960;
constexpr size_t WS_QI_UNUSED = 69 * MiB;
constexpr size_t WS_KDT = 102 * MiB;
constexpr size_t WS_VT = 153 * MiB + 768 * 1024;
constexpr size_t WS_PM = 168 * MiB;
constexpr size_t WS_DEC = 184 * MiB + 512 * 1024;
constexpr size_t WS_OF = 189 * MiB;
constexpr size_t WS_ON = 69 * MiB, WS_SGA = 101 * MiB, WS_SGF = 133 * MiB, WS_OG = 165 * MiB, WS_MG = 197 * MiB;
constexpr size_t WS_H1B = 69 * MiB, WS_HF = 101 * MiB;
constexpr size_t WS_H2B = 1 * MiB;
constexpr size_t WS_BAR_OFF = 239 * MiB + 768 * 1024;
constexpr int LDS_BYTES = 155648;
struct Args {
    const float *x, *meta, *norm_mix, *w_in, *wdf, *bdf, *wdb, *bdb, *gla_norm, *w_o, *w_fnet, *w_out, *norm_ffn, *w_ff1, *w_ff2, *norm_final;
    float* out; unsigned char* ws; int ph_lo, ph_hi;
};
DI unsigned f2bf(float f) { unsigned u = __builtin_bit_cast(unsigned, f); return (u + 0x7fffu + ((u >> 16) & 1u)) >> 16; }
DI unsigned pk2(float lo, float hi) { return f2bf(lo) | (f2bf(hi) << 16); }
typedef float f32x2_t __attribute__((ext_vector_type(2)));
typedef __bf16 bf16x2_t __attribute__((ext_vector_type(2)));
DI unsigned cvtpk(float lo, float hi) { f32x2_t v = {lo, hi}; bf16x2_t b = __builtin_convertvector(v, bf16x2_t); return __builtin_bit_cast(unsigned, b); }
DI float bf2f(unsigned h) { return __uint_as_float(h << 16); }
DI float wave_sum(float v) {
#pragma unroll
    for (int o = 1; o < 64; o <<= 1) v += __shfl_xor(v, o);
    return v;
}
DI void transpose_item(const float* W, int pitch, int K, int ncols, bf16* WT, int row_off, LAS float* scr, int item, int lane, const float* kscale, int ldo = 0) {
    if (ldo == 0) ldo = K;
    const int nblk = ncols / 32, kb = item / nblk, nb = item % nblk, k0 = 64 * kb, n0 = 32 * nb;
#pragma unroll 8
    for (int i = 0; i < 32; ++i) { const int kk = 2 * i + (lane >> 5); float v = W[(size_t)(k0 + kk) * pitch + n0 + (lane & 31)]; if (kscale) v *= kscale[k0 + kk]; scr[kk * 33 + (lane & 31)] = v; }
    asm volatile("s_waitcnt lgkmcnt(0)" ::: "memory");
    const int c = lane & 7;
#pragma unroll
    for (int j = 0; j < 4; ++j) { const int n = (lane >> 3) + 8 * j; const LAS float* s = scr + (8 * c) * 33 + n;
        v4u o; o.x = pk2(s[0 * 33], s[1 * 33]); o.y = pk2(s[2 * 33], s[3 * 33]); o.z = pk2(s[4 * 33], s[5 * 33]); o.w = pk2(s[6 * 33], s[7 * 33]);
        *(v4u*)(WT + (size_t)(row_off + n0 + n) * ldo + k0 + 8 * c) = o; }
    asm volatile("s_waitcnt lgkmcnt(0)" ::: "memory");
}
DI void rms_row_to_bf16(const float* xrow, const float* gain, bf16* orow, int lane) {
    const f32x4* xr = (const f32x4*)xrow + lane; const f32x4* gr = (const f32x4*)gain + lane;
    f32x4 v[4]; float s = 0.f;
#pragma unroll
    for (int j = 0; j < 4; ++j) { v[j] = xr[64 * j]; s += (v[j].x * v[j].x + v[j].y * v[j].y) + (v[j].z * v[j].z + v[j].w * v[j].w); }
    const float rstd = 1.f / sqrtf(wave_sum(s) * (1.f / 1024.f) + 1e-6f);
    unsigned long long* o8 = (unsigned long long*)orow + lane;
#pragma unroll
    for (int j = 0; j < 4; ++j) { const f32x4 g = gr[64 * j];
        o8[64 * j] = (unsigned long long)pk2(v[j].x * rstd * g.x, v[j].y * rstd * g.y) | ((unsigned long long)pk2(v[j].z * rstd * g.z, v[j].w * rstd * g.w) << 32); }
}

DI void gen_cs_tab(const Args& a, LAS unsigned char* lds, int tid, int vbi, int nb) {
    unsigned char* ws = a.ws;
    const int gt = vbi * NTHREADS + tid, NGT = nb * NTHREADS;
    LAS float* tabc = (LAS float*)lds; LAS float* tabs = tabc + LSEQ;
    __syncthreads();
    for (int j = tid; j < LSEQ; j += NTHREADS) { const float ang = 6.283185307179586f * (float)j / (float)LSEQ; tabc[j] = __cosf(ang); tabs[j] = __sinf(ang); }
    __syncthreads();
    {
        bf16* CS = (bf16*)(ws + WS_CS);
        const int nchunk = 4 * 4096 * (KH / 8);
        for (int ch = gt; ch < nchunk; ch += NGT) {
            const int k8 = ch % (KH / 8); const int rest = ch / (KH / 8); const int idx = rest & 4095, grp = rest >> 12, cs = grp >> 1, kh = grp & 1;
            const int m = idx + 9, l0 = kh * KH + k8 * 8;
            unsigned j = ((unsigned)l0 * (unsigned)m) % (unsigned)LSEQ;
            float v[8];
#pragma unroll
            for (int e = 0; e < 8; ++e) { v[e] = (l0 + e <= 4104) ? (cs ? tabs[j] : tabc[j]) : 0.f; j += m; if (j >= (unsigned)LSEQ) j -= LSEQ; }
            v4u o; o.x = pk2(v[0], v[1]); o.y = pk2(v[2], v[3]); o.z = pk2(v[4], v[5]); o.w = pk2(v[6], v[7]);
            *(v4u*)(CS + (size_t)ch * 8) = o;
        }
        bf16* TAB = (bf16*)(ws + WS_TAB);
        const int nch2 = 32 * 2 * (LDG / 8);
        for (int ch = gt; ch < nch2; ch += NGT) {
            const int l8 = ch % (LDG / 8); const int rest = ch / (LDG / 8); const int cs = rest & 1, rho = rest >> 1;
            const int lp = 8200 + rho, l0 = l8 * 8;
            unsigned j = ((unsigned)l0 * (unsigned)lp) % (unsigned)LSEQ;
            float v[8];
#pragma unroll
            for (int e = 0; e < 8; ++e) { v[e] = (rho < 8 && l0 + e < LSEQ) ? (cs ? -tabs[j] : tabc[j]) : 0.f; j += lp; while (j >= (unsigned)LSEQ) j -= LSEQ; }
            v4u o; o.x = pk2(v[0], v[1]); o.y = pk2(v[2], v[3]); o.z = pk2(v[4], v[5]); o.w = pk2(v[6], v[7]);
            *(v4u*)(TAB + (size_t)ch * 8) = o;
        }
    }
    __syncthreads();
}

DI void p0_prologue(const Args& a, LAS unsigned char* lds, int tid, int lane, int wave, int bid, int G) {
    unsigned char* ws = a.ws;
    bf16* ALL = (bf16*)(ws + WS_ALL);
    const int gw = bid * NWAVES + wave, NGW = G * NWAVES;
    const int gt = bid * NTHREADS + tid, NGT = G * NTHREADS;
    {
        LAS float* Wl = (LAS float*)lds;
        LAS float* c128 = Wl + 64 * 128; LAS float* s128 = c128 + 128;
        if (tid < 128) { const float ang = 6.283185307179586f * (float)tid / 128.f; c128[tid] = __cosf(ang); s128[tid] = __sinf(ang); }
        for (int item = bid; item < 256; item += G) {
            const int kb = item >> 4, g = (item >> 2) & 3, nq = item & 3;
            __syncthreads();
            for (int idx = tid; idx < 64 * 128; idx += NTHREADS) { const int kk = idx >> 7, c = idx & 127; Wl[idx] = a.w_in[(size_t)(kb * 64 + kk) * DIN + 3104 + g * 128 + c]; }
            __syncthreads();
            const int n = nq * 32 + (tid & 31), kg = tid >> 5;
            float ac[4] = {0.f, 0.f, 0.f, 0.f}, as[4] = {0.f, 0.f, 0.f, 0.f};
            const LAS float* w0 = Wl + (kg * 4) * 128;
#pragma unroll 4
            for (int c = 0; c < 128; ++c) { const int j = (c * n) & 127; const float cc = c128[j], ss = s128[j];
#pragma unroll
                for (int q = 0; q < 4; ++q) { const float w = w0[q * 128 + c]; ac[q] += w * cc; as[q] += w * ss; } }
            bf16* dc = ALL + (size_t)(74 * 256 + g * 128 + n) * D + kb * 64 + kg * 4;
            bf16* ds = ALL + (size_t)(76 * 256 + g * 128 + n) * D + kb * 64 + kg * 4;
            *(v2u*)dc = (v2u){pk2(ac[0], ac[1]), pk2(ac[2], ac[3])}; *(v2u*)ds = (v2u){pk2(as[0], as[1]), pk2(as[2], as[3])};
        }
        __syncthreads();
    }
    {
        LAS float* scr = (LAS float*)(lds + wave * 16384);
        bf16* WT = ALL + (size_t)65 * 256 * D;
        const int I_Q = 16 * 16, I_V = 16 * 32, I_R = 16 * 1, I_G = 16 * 32;
        const int I_O = 16 * 32, I_F = 8 * 32, I_1 = 16 * 128, I_2 = 64 * 32;
        const int NIT = 2 * I_Q + I_V + I_R + 3 * I_G + 2 * I_O + I_F + I_1 + I_2;
        for (int it = gw; it < NIT; it += NGW) {
            int r = it;
            if (r < I_Q) { transpose_item(a.w_in + 0, DIN, D, 512, WT, 0, scr, r, lane, nullptr); continue; } r -= I_Q;
            if (r < I_Q) { transpose_item(a.w_in + 512, DIN, D, 512, WT, 512, scr, r, lane, nullptr); continue; } r -= I_Q;
            if (r < I_V) { transpose_item(a.w_in + 1024, DIN, D, 1024, WT, 1024, scr, r, lane, nullptr); continue; } r -= I_V;
            if (r < I_R) { transpose_item(a.w_in + 3072, DIN, D, 32, WT, 2048, scr, r, lane, nullptr); continue; } r -= I_R;
            if (r < I_G) { transpose_item(a.w_in + 2048, DIN, D, 1024, WT, 13 * 256, scr, r, lane, nullptr); continue; } r -= I_G;
            if (r < I_G) { transpose_item(a.w_in + 3616, DIN, D, 1024, WT, 17 * 256, scr, r, lane, nullptr); continue; } r -= I_G;
            if (r < I_G) { transpose_item(a.w_in + 4640, DIN, D, 1024, WT, 21 * 256, scr, r, lane, nullptr); continue; } r -= I_G;
            if (r < I_O) { transpose_item(a.w_o, D, D, 1024, (bf16*)(ws + WS_WOT), 0, scr, r, lane, nullptr); continue; } r -= I_O;
            if (r < I_O) { transpose_item(a.w_out, D, D, 1024, (bf16*)(ws + WS_WOUTT), 0, scr, r, lane, nullptr); continue; } r -= I_O;
            if (r < I_F) { transpose_item(a.w_fnet, D, 512, 1024, (bf16*)(ws + WS_WFT), 0, scr, r, lane, nullptr); continue; } r -= I_F;
            if (r < I_1) { transpose_item(a.w_ff1, FF, D, FF, (bf16*)(ws + WS_W1T), 0, scr, r, lane, a.norm_ffn); continue; } r -= I_1;
            transpose_item(a.w_ff2, D, FF, 1024, (bf16*)(ws + WS_W2T), 0, scr, r, lane, nullptr, 4224);
        }
    }
    {
        bf16* t8 = ALL + (size_t)(73 * 256 + 32) * D;
        for (int i = gt; i < 224 * D / 8; i += NGT) *(v4u*)(t8 + (size_t)i * 8) = (v4u){0u, 0u, 0u, 0u};
        bf16* x64 = ALL + (size_t)16384 * D;
        for (int i = gt; i < 256 * D / 8; i += NGT) { const int row = i / (D / 8); if (row < 48 || row >= 64) *(v4u*)(x64 + (size_t)i * 8) = (v4u){0u, 0u, 0u, 0u}; }
        bf16* GT2 = (bf16*)(ws + WS_GT2);
        for (int i = gt; i < 2048 * 14; i += NGT) { const int row = i / 14, c = i % 14; *(v4u*)(GT2 + (size_t)row * LDG + LSEQ + c * 8) = (v4u){0u, 0u, 0u, 0u}; }
    }
    for (int m = gw; m < NREAL + 16; m += NGW) {
        if (m < NREAL) rms_row_to_bf16(a.x + (size_t)m * D, a.norm_mix, ALL + (size_t)m * D, lane);
        else rms_row_to_bf16(a.meta + (size_t)(m - NREAL) * D, a.norm_mix, ALL + (size_t)(NREAL + 48 + (m - NREAL)) * D, lane);
    }
}
DI void p2_sym_rem(const Args& a, int tid, int lane, int wave, int bid, int G) {
    unsigned char* ws = a.ws;
    const bf16* GT2 = (const bf16*)(ws + WS_GT2);
    bf16* EOT = (bf16*)(ws + WS_EOT);
    const int gt = bid * NTHREADS + tid, NGT = G * NTHREADS;
    const int nchunk = 4 * 1024 * (KH / 8);
    for (int ch = gt; ch < nchunk; ch += NGT) {
        const int k8 = ch % (KH / 8); const int rest = ch / (KH / 8); const int n = rest & 1023, grp = rest >> 10, cs = grp >> 1, kh = grp & 1;
        const int l0 = kh * KH + k8 * 8;
        const bf16* src = GT2 + ((size_t)n * 2 + cs) * LDG;
        float v[8];
        if (l0 > 4104) {
#pragma unroll
            for (int e = 0; e < 8; ++e) v[e] = 0.f;
        } else {
            const v4u f = *(const v4u*)(src + l0);
            const float fw[8] = {bf2f(f.x & 0xffffu), bf2f(f.x >> 16), bf2f(f.y & 0xffffu), bf2f(f.y >> 16), bf2f(f.z & 0xffffu), bf2f(f.z >> 16), bf2f(f.w & 0xffffu), bf2f(f.w >> 16)};
            const v4u mch = *(const v4u*)(src + (LSEQ - 8 - l0));
            const float mw[8] = {bf2f(mch.x & 0xffffu), bf2f(mch.x >> 16), bf2f(mch.y & 0xffffu), bf2f(mch.y >> 16), bf2f(mch.z & 0xffffu), bf2f(mch.z >> 16), bf2f(mch.w & 0xffffu), bf2f(mch.w >> 16)};
            const float m0 = (l0 == 0) ? 0.f : bf2f((unsigned)src[LSEQ - l0]);
#pragma unroll
            for (int e = 0; e < 8; ++e) { const int l = l0 + e;
                if (l > 4104) v[e] = 0.f;
                else if (l == 0 || l == 4104) v[e] = cs ? 0.f : fw[e];
                else { const float mir = (e == 0) ? m0 : mw[8 - e]; v[e] = cs ? fw[e] - mir : fw[e] + mir; } }
        }
        v4u o; o.x = pk2(v[0], v[1]); o.y = pk2(v[2], v[3]); o.z = pk2(v[4], v[5]); o.w = pk2(v[6], v[7]);
        *(v4u*)(EOT + (size_t)ch * 8) = o;
    }
    typedef float f32x16 __attribute__((ext_vector_type(16)));
    const bf16* TAB = (const bf16*)(ws + WS_TAB);
    float* REMP = (float*)(ws + WS_REMP);
    const int gw = bid * NWAVES + wave, NGW = G * NWAVES;
    for (int task = gw; task < 32 * 65; task += NGW) {
        const int nt = task & 31, ks = task >> 5; const int r = lane & 31, h = lane >> 5;
        f32x16 acc; for (int i = 0; i < 16; ++i) acc[i] = 0.f;
        const bf16* ap = TAB + (size_t)r * (2 * LDG) + ks * 256 + 8 * h;
        const bf16* bp = GT2 + (size_t)(nt * 32 + r) * (2 * LDG) + ks * 256 + 8 * h;
#pragma unroll 4
        for (int kk = 0; kk < 16; ++kk) { const bf16x8 af = *(const bf16x8*)(ap + kk * 16), bfr = *(const bf16x8*)(bp + kk * 16);
            acc = __builtin_amdgcn_mfma_f32_32x32x16_bf16(af, bfr, acc, 0, 0, 0); }
#pragma unroll
        for (int i = 0; i < 4; ++i) REMP[((size_t)ks * 8 + i + 4 * h) * 1024 + nt * 32 + r] = acc[i];
    }
}

DI void p4_combine(const Args& a, int tid, int bid, int G) {
    unsigned char* ws = a.ws;
    const bf16* PQ = (const bf16*)(ws + WS_PQ); const float* REMP = (const float*)(ws + WS_REMP); bf16* FN = (bf16*)(ws + WS_FN);
    const float scale = 0.0009756003f;
    const int nb5 = (G == 256) ? 8 : 0;
    if (bid < nb5) return;
    const int gt = (bid - nb5) * NTHREADS + tid, NGT = (G - nb5) * NTHREADS;
    for (int ch = gt; ch < NREAL * 64; ch += NGT) {
        const int c8 = ch & 63, row = ch >> 6, b = row >> 13, s = row & 8191, l = s + 16, n = b * 512 + c8 * 8;
        float v[8];
        if (l >= 8200) { const int rho = l - 8200;
#pragma unroll
            for (int e = 0; e < 8; ++e) v[e] = 0.f;
            for (int ks = 0; ks < 65; ++ks) { const f32x4 p0 = *(const f32x4*)(REMP + ((size_t)ks * 8 + rho) * 1024 + n), p1 = *(const f32x4*)(REMP + ((size_t)ks * 8 + rho) * 1024 + n + 4);
                v[0] += p0[0]; v[1] += p0[1]; v[2] += p0[2]; v[3] += p0[3]; v[4] += p1[0]; v[5] += p1[1]; v[6] += p1[2]; v[7] += p1[3]; }
        } else {
            const bool mir = l > 4104; const int idx = (mir ? LSEQ - l : l) - 9; const float sg = mir ? 1.f : -1.f;
            const size_t off = (size_t)idx * 1024 + n;
            const v4u p0 = *(const v4u*)(PQ + off), p1 = *(const v4u*)(PQ + (size_t)4096 * 1024 + off), q0 = *(const v4u*)(PQ + (size_t)2 * 4096 * 1024 + off), q1 = *(const v4u*)(PQ + (size_t)3 * 4096 * 1024 + off);
            const unsigned pp0[4] = {p0.x, p0.y, p0.z, p0.w}, pp1[4] = {p1.x, p1.y, p1.z, p1.w}, qq0[4] = {q0.x, q0.y, q0.z, q0.w}, qq1[4] = {q1.x, q1.y, q1.z, q1.w};
#pragma unroll
            for (int e = 0; e < 4; ++e) {
                v[2 * e] = (bf2f(pp0[e] & 0xffffu) + bf2f(pp1[e] & 0xffffu)) + sg * (bf2f(qq0[e] & 0xffffu) + bf2f(qq1[e] & 0xffffu));
                v[2 * e + 1] = (bf2f(pp0[e] >> 16) + bf2f(pp1[e] >> 16)) + sg * (bf2f(qq0[e] >> 16) + bf2f(qq1[e] >> 16)); }
        }
        v4u o; o.x = pk2(v[0] * scale, v[1] * scale); o.y = pk2(v[2] * scale, v[3] * scale); o.z = pk2(v[4] * scale, v[5] * scale); o.w = pk2(v[6] * scale, v[7] * scale);
        *(v4u*)(FN + (size_t)row * 512 + c8 * 8) = o;
    }
}

DI void p6_post(const Args& a, int lane, int wave, int bid, int G) {
    unsigned char* ws = a.ws;
    const bf16* OF = (const bf16*)(ws + WS_OF); const bf16* OB = (const bf16*)((unsigned char*)a.out + DO_OB); bf16* ON = (bf16*)(ws + WS_ON);
    const int gw = bid * NWAVES + wave, NGW = G * NWAVES;
    const int c0 = lane * 16;
    float gn[16];
#pragma unroll
    for (int e = 0; e < 16; ++e) gn[e] = a.gla_norm[(c0 & 255) + e];
    for (int row = gw; row < NREAL; row += NGW) {
        const size_t off = (size_t)row * 1024 + c0;
        const v4u f0 = *(const v4u*)(OF + off), f1 = *(const v4u*)(OF + off + 8), b0 = *(const v4u*)(OB + off), b1 = *(const v4u*)(OB + off + 8);
        const unsigned fw[8] = {f0.x, f0.y, f0.z, f0.w, f1.x, f1.y, f1.z, f1.w}, bw[8] = {b0.x, b0.y, b0.z, b0.w, b1.x, b1.y, b1.z, b1.w};
        float v[16]; float ss = 0.f;
#pragma unroll
        for (int e = 0; e < 8; ++e) { v[2 * e] = bf2f(fw[e] & 0xffffu) + bf2f(bw[e] & 0xffffu); v[2 * e + 1] = bf2f(fw[e] >> 16) + bf2f(bw[e] >> 16); ss += v[2 * e] * v[2 * e] + v[2 * e + 1] * v[2 * e + 1]; }
        ss += __shfl_xor(ss, 1); ss += __shfl_xor(ss, 2); ss += __shfl_xor(ss, 4); ss += __shfl_xor(ss, 8);
        const float rstd = 1.f / sqrtf(ss * (1.f / 256.f) + 1e-6f);
        unsigned w[8];
#pragma unroll
        for (int e = 0; e < 8; ++e) w[e] = pk2(v[2 * e] * rstd * gn[2 * e], v[2 * e + 1] * rstd * gn[2 * e + 1]);
        *(v4u*)(ON + off) = (v4u){w[0], w[1], w[2], w[3]}; *(v4u*)(ON + off + 8) = (v4u){w[4], w[5], w[6], w[7]};
    }
}

DI void p11_final(const Args& a, int lane, int wave, int bid, int G) {
    const int gw = bid * NWAVES + wave, NGW = G * NWAVES;
    const bf16* H2B = (const bf16*)(a.ws + WS_H2B); const float* PART = (const float*)(a.ws + WS_PART1);
    f32x4 gn[2][2];
#pragma unroll
    for (int j = 0; j < 2; ++j) { gn[j][0] = *(const f32x4*)(a.norm_final + j * 512 + lane * 8); gn[j][1] = *(const f32x4*)(a.norm_final + j * 512 + lane * 8 + 4); }
    for (int row = gw; row < NREAL; row += NGW) {
        const float* pp = PART + (size_t)row * 16; float s = 0.f;
#pragma unroll
        for (int t = 0; t < 4; ++t) { const f32x4 q4 = *(const f32x4*)(pp + 4 * t); s += (q4[0] + q4[1]) + (q4[2] + q4[3]); }
        const float rstd = 1.f / sqrtf(s * (1.f / 1024.f) + 1e-6f);
#pragma unroll
        for (int j = 0; j < 2; ++j) { const v4u w = *(const v4u*)(H2B + (size_t)row * D + j * 512 + lane * 8);
            float* o = a.out + (size_t)row * D + j * 512 + lane * 8;
            *(f32x4*)o = (f32x4){bf2f(w.x & 0xffffu) * rstd * gn[j][0][0], bf2f(w.x >> 16) * rstd * gn[j][0][1], bf2f(w.y & 0xffffu) * rstd * gn[j][0][2], bf2f(w.y >> 16) * rstd * gn[j][0][3]};
            *(f32x4*)(o + 4) = (f32x4){bf2f(w.z & 0xffffu) * rstd * gn[j][1][0], bf2f(w.z >> 16) * rstd * gn[j][1][1], bf2f(w.w & 0xffffu) * rstd * gn[j][1][2], bf2f(w.w >> 16) * rstd * gn[j][1][3]}; }
    }
}
DI float logsig(float x) { return fminf(x, 0.f) - __logf(1.f + __expf(-fabsf(x))); }
DI size_t tile_idx(int dir, int b, int h, int c) { return (size_t)((dir * 2 + b) * 4 + h) * NCHUNK + c; }
DI void p4_gla_prep(const Args& a, LAS unsigned char* lds, int tid, int lane, int wave, int bid, int G) {
    unsigned char* ws = a.ws;
    const bf16* Qg = (const bf16*)((unsigned char*)a.out + DO_Q); const bf16* Kg = (const bf16*)(ws + WS_K); const bf16* Vg = (const bf16*)((unsigned char*)a.out + DO_V);
    const float* Rg = (const float*)(ws + WS_R);
    unsigned char* REC = ws + WS_REC; bf16* VT = (bf16*)(ws + WS_VT);
    LAS float* BF = (LAS float*)lds; LAS float* BB = BF + 64 * 128;
    LAS unsigned char* QF = lds + 65536; LAS unsigned char* KF = QF + 17408; LAS unsigned char* QB = KF + 17408; LAS unsigned char* KB = QB + 17408;
    LAS unsigned char* KRAW = lds + 135168;
    LAS float* RS = (LAS float*)QF; LAS float* WD = RS + 64 * 32;
    LAS unsigned char* VS = lds;
    f32x4 rq; v4u q8p[2], k8p[2], v8p[4];
#define PREP_ROW0(t) ((((t) >> 2) % NCHUNK == 0) ? NREAL : ((t) >> 2) / NCHUNK * 8192 + 64 * ((((t) >> 2) % NCHUNK) - 1))
#define PREP_LOAD_QKR(t) do { const int r0_ = PREP_ROW0(t), h_ = (t) & 3; rq = *(const f32x4*)(Rg + (size_t)r0_ * 32 + tid * 4); \
        _Pragma("unroll") for (int rep = 0; rep < 2; ++rep) { const int g_ = tid + NTHREADS * rep, i_ = g_ >> 4, d0_ = (g_ & 15) * 8; \
            q8p[rep] = *(const v4u*)(Qg + (size_t)(r0_ + i_) * 512 + h_ * 128 + d0_); k8p[rep] = *(const v4u*)(Kg + (size_t)(r0_ + i_) * 512 + h_ * 128 + d0_); } } while (0)
#define PREP_LOAD_V(t) do { const int r0_ = PREP_ROW0(t), h_ = (t) & 3; \
        _Pragma("unroll") for (int rep = 0; rep < 4; ++rep) { const int idx_ = tid + NTHREADS * rep, i_ = idx_ >> 5, u_ = idx_ & 31; v8p[rep] = *(const v4u*)(Vg + (size_t)(r0_ + i_) * 1024 + h_ * 256 + u_ * 8); } } while (0)
    bf16x8 wfh = {}, wbh = {}; float bfw = 0.f, bbw = 0.f; int hload = -1;
    if (bid < 2 * NCHUNK * 4) { PREP_LOAD_QKR(bid); PREP_LOAD_V(bid); }
    for (int task = bid; task < 2 * NCHUNK * 4; task += G) {
        const int h = task & 3, c = (task >> 2) % NCHUNK, b = (task >> 2) / NCHUNK;
        const int row0 = (c == 0) ? NREAL : b * 8192 + 64 * (c - 1);
        const bool has_next = task + G < 2 * NCHUNK * 4;
        {
            const int fr = lane & 15, g = lane >> 4, dcol = 16 * wave + fr;
            if (h != hload) {
                float wv[8];
#pragma unroll
                for (int e = 0; e < 8; ++e) wv[e] = (g < 2) ? a.wdf[(8 * g + e) * 512 + h * 128 + dcol] : a.wdb[(8 * (g - 2) + e) * 512 + h * 128 + dcol];
                const v4u z4 = {0u, 0u, 0u, 0u}, vh = {pk2(wv[0], wv[1]), pk2(wv[2], wv[3]), pk2(wv[4], wv[5]), pk2(wv[6], wv[7])};
                wfh = __builtin_bit_cast(bf16x8, g < 2 ? vh : z4); wbh = __builtin_bit_cast(bf16x8, g < 2 ? z4 : vh);
                bfw = a.bdf[h * 128 + dcol]; bbw = a.bdb[h * 128 + dcol]; hload = h; }
            *(LAS f32x4*)(RS + tid * 4) = rq;
            __syncthreads();
#pragma unroll 1
            for (int dirp = 0; dirp < 2; ++dirp) {
                const bf16x8 wh = dirp ? wbh : wfh; const float bias = dirp ? bbw : bfw;
                LAS float* BX = dirp ? BB : BF;
                float offs = 0.f;
#pragma unroll 1
                for (int tt = 0; tt < 4; ++tt) {
                    const int t = dirp ? 3 - tt : tt;
                    const LAS float* rp = RS + (16 * t + fr) * 32 + 8 * g;
                    const f32x4 r0 = *(const LAS f32x4*)rp, r1 = *(const LAS f32x4*)(rp + 4);
                    const float rv[8] = {r0[0], r0[1], r0[2], r0[3], r1[0], r1[1], r1[2], r1[3]};
                    unsigned hi[4], lo[4];
#pragma unroll
                    for (int e2 = 0; e2 < 4; ++e2) { const float h0 = bf2f(f2bf(rv[2 * e2])), h1 = bf2f(f2bf(rv[2 * e2 + 1])); hi[e2] = pk2(h0, h1); lo[e2] = pk2(rv[2 * e2] - h0, rv[2 * e2 + 1] - h1); }
                    f32x4 acc = {0.f, 0.f, 0.f, 0.f};
                    acc = __builtin_amdgcn_mfma_f32_16x16x32_bf16(__builtin_bit_cast(bf16x8, (v4u){hi[0], hi[1], hi[2], hi[3]}), wh, acc, 0, 0, 0);
                    acc = __builtin_amdgcn_mfma_f32_16x16x32_bf16(__builtin_bit_cast(bf16x8, (v4u){lo[0], lo[1], lo[2], lo[3]}), wh, acc, 0, 0, 0);
                    float la[4];
#pragma unroll
                    for (int i = 0; i < 4; ++i) { const bool padrow = (c == 0) && (16 * t + 4 * g + i < 48); la[i] = padrow ? 0.f : logsig(acc[i] + bias) * 0.0625f; }
                    float T, inc;
                    if (dirp == 0) {
                        la[1] += la[0]; la[2] += la[1]; la[3] += la[2]; T = la[3];
                        const float u1 = __shfl_up(T, 16); const float s1 = T + (g >= 1 ? u1 : 0.f);
                        const float u2 = __shfl_up(s1, 32); inc = s1 + (g >= 2 ? u2 : 0.f);
                    } else {
                        la[2] += la[3]; la[1] += la[2]; la[0] += la[1]; T = la[0];
                        const float u1 = __shfl_down(T, 16); const float s1 = T + (g <= 2 ? u1 : 0.f);
                        const float u2 = __shfl_down(s1, 32); inc = s1 + (g <= 1 ? u2 : 0.f);
                    }
                    const float base = offs + (inc - T);
#pragma unroll
                    for (int i = 0; i < 4; ++i) BX[(16 * t + 4 * g + i) * 128 + dcol] = base + la[i];
                    offs += __shfl(inc, dirp ? fr : fr + 48);
                }
                if (g == 0) ((float*)(REC + tile_idx(dirp, b, h, c) * REC_BYTES + REC_DEC))[dcol] = __expf(offs);
            }
        }
        __syncthreads();
#pragma unroll
        for (int rep = 0; rep < 2; ++rep) {
            const int g = tid + NTHREADS * rep, i = g >> 4, d0 = (g & 15) * 8;
            const v4u q8 = q8p[rep], k8 = k8p[rep];
            *(LAS v4u*)(KRAW + i * 256 + d0 * 2) = k8;
            if (c == 0) continue;
            const unsigned qw[4] = {q8.x, q8.y, q8.z, q8.w}, kw[4] = {k8.x, k8.y, k8.z, k8.w};
            float qf[8], kf[8], qb[8], kb[8], qif[8], qib[8];
#pragma unroll
            for (int e = 0; e < 8; ++e) {
                const int d = d0 + e; const float q = bf2f((e & 1) ? (qw[e >> 1] >> 16) : (qw[e >> 1] & 0xffffu)), k = bf2f((e & 1) ? (kw[e >> 1] >> 16) : (kw[e >> 1] & 0xffffu));
                const float ef = BF[i * 128 + d], eb = BB[i * 128 + d], f31 = BF[31 * 128 + d], b32 = BB[32 * 128 + d];
                qf[e] = q * __expf(ef - f31); kf[e] = k * __expf(f31 - ef); qb[e] = q * __expf(eb - b32); kb[e] = k * __expf(b32 - eb);
                qif[e] = q * __expf(ef); qib[e] = q * __expf(eb);
            }
            *(LAS v4u*)(QF + i * 272 + d0 * 2) = (v4u){pk2(qf[0], qf[1]), pk2(qf[2], qf[3]), pk2(qf[4], qf[5]), pk2(qf[6], qf[7])};
            *(LAS v4u*)(KF + i * 272 + d0 * 2) = (v4u){pk2(kf[0], kf[1]), pk2(kf[2], kf[3]), pk2(kf[4], kf[5]), pk2(kf[6], kf[7])};
            *(LAS v4u*)(QB + i * 272 + d0 * 2) = (v4u){pk2(qb[0], qb[1]), pk2(qb[2], qb[3]), pk2(qb[4], qb[5]), pk2(qb[6], qb[7])};
            *(LAS v4u*)(KB + i * 272 + d0 * 2) = (v4u){pk2(kb[0], kb[1]), pk2(kb[2], kb[3]), pk2(kb[4], kb[5]), pk2(kb[6], kb[7])};
            const int kap = d0 >> 5, u = (d0 & 31) >> 3, g0 = 2 * (u & 1), e0 = 4 * (u >> 1);
            const size_t qoff = ((size_t)(((i >> 4) * 4 + kap) * 64 + g0 * 16 + (i & 15))) * 8 + e0;
            bf16* qi_f = (bf16*)(REC + tile_idx(0, b, h, c) * REC_BYTES) + qoff; bf16* qi_b = (bf16*)(REC + tile_idx(1, b, h, c) * REC_BYTES) + qoff;
            *(v2u*)qi_f = (v2u){pk2(qif[0], qif[1]), pk2(qif[2], qif[3])}; *(v2u*)(qi_f + 128) = (v2u){pk2(qif[4], qif[5]), pk2(qif[6], qif[7])};
            *(v2u*)qi_b = (v2u){pk2(qib[0], qib[1]), pk2(qib[2], qib[3])}; *(v2u*)(qi_b + 128) = (v2u){pk2(qib[4], qib[5]), pk2(qib[6], qib[7])};
        }
        if (has_next) PREP_LOAD_QKR(task + G);
        __syncthreads();
        if (c != 0) {
            const int dir = wave >> 2, tq = wave & 3, fr = lane & 15, g = lane >> 4;
            const LAS unsigned char* QX = dir ? QB : QF; const LAS unsigned char* KX = dir ? KB : KF;
            bf16x8 bq[4];
#pragma unroll
            for (int kap = 0; kap < 4; ++kap) bq[kap] = *(const LAS bf16x8*)(QX + (16 * tq + fr) * 272 + (32 * kap + 8 * g) * 2);
            bf16* pm = (bf16*)(REC + tile_idx(dir, b, h, c) * REC_BYTES + REC_PM);
            const int i = 16 * tq + fr;
#pragma unroll
            for (int tk = 0; tk < 4; ++tk) {
                f32x4 acc = {0.f, 0.f, 0.f, 0.f};
#pragma unroll
                for (int kap = 0; kap < 4; ++kap) { const bf16x8 af = *(const LAS bf16x8*)(KX + (16 * tk + fr) * 272 + (32 * kap + 8 * g) * 2);
                    acc = __builtin_amdgcn_mfma_f32_16x16x32_bf16(af, bq[kap], acc, 0, 0, 0); }
                float s[4];
#pragma unroll
                for (int e = 0; e < 4; ++e) { const int j = 16 * tk + 4 * g + e; const bool keep = dir ? (j >= i) : (j <= i); s[e] = keep ? acc[e] : 0.f; }
                *(v2u*)(pm + (size_t)((tq * 2 + (tk >> 1)) * 64 + (2 * (tk & 1) + (g >> 1)) * 16 + fr) * 8 + 4 * (g & 1)) = (v2u){pk2(s[0], s[1]), pk2(s[2], s[3])};
            }
        }
        {
            const int d = tid & 127, blk = tid >> 7, i0 = blk * 16;
            const float f63 = BF[63 * 128 + d], b0 = BB[d];
            unsigned wf[8], wb[8];
#pragma unroll
            for (int e2 = 0; e2 < 8; ++e2) {
                const int ia = i0 + 2 * e2, ib = ia + 1;
                const float ka = bf2f((unsigned)*(const LAS unsigned short*)(KRAW + ia * 256 + d * 2)), kb2 = bf2f((unsigned)*(const LAS unsigned short*)(KRAW + ib * 256 + d * 2));
                wf[e2] = pk2(ka * __expf(f63 - BF[ia * 128 + d]), kb2 * __expf(f63 - BF[ib * 128 + d]));
                wb[e2] = pk2(ka * __expf(b0 - BB[ia * 128 + d]), kb2 * __expf(b0 - BB[ib * 128 + d]));
            }
            const size_t koff = (size_t)((((d >> 4) * 2 + (blk >> 1)) * 64 + (2 * (blk & 1)) * 16 + (d & 15))) * 8;
            bf16* kf_ = (bf16*)(REC + tile_idx(0, b, h, c) * REC_BYTES + REC_KDT) + koff; bf16* kb_ = (bf16*)(REC + tile_idx(1, b, h, c) * REC_BYTES + REC_KDT) + koff;
            *(v4u*)kf_ = (v4u){wf[0], wf[1], wf[2], wf[3]}; *(v4u*)(kf_ + 128) = (v4u){wf[4], wf[5], wf[6], wf[7]};
            *(v4u*)kb_ = (v4u){wb[0], wb[1], wb[2], wb[3]}; *(v4u*)(kb_ + 128) = (v4u){wb[4], wb[5], wb[6], wb[7]};
        }
        __syncthreads();
#pragma unroll
        for (int rep = 0; rep < 4; ++rep) { const int idx = tid + NTHREADS * rep, i = idx >> 5, u = idx & 31;
            *(LAS v4u*)(VS + i * 528 + u * 16) = v8p[rep]; }
        if (has_next) PREP_LOAD_V(task + G);
        __syncthreads();
        {
            const int dv = tid & 255, half = tid >> 8; unsigned w[16];
#pragma unroll
            for (int e2 = 0; e2 < 16; ++e2) { const int ia = 32 * half + 2 * e2;
                w[e2] = (unsigned)*(const LAS unsigned short*)(VS + ia * 528 + dv * 2) | ((unsigned)*(const LAS unsigned short*)(VS + (ia + 1) * 528 + dv * 2) << 16); }
            bf16* vt = VT + ((size_t)(b * 4 + h) * NCHUNK + c) * 16384 + (size_t)((dv >> 4) * 2 + half) * 512 + (dv & 15) * 8;
#pragma unroll
            for (int q4 = 0; q4 < 4; ++q4) *(v4u*)(vt + q4 * 128) = (v4u){w[4 * q4], w[4 * q4 + 1], w[4 * q4 + 2], w[4 * q4 + 3]};
        }
        __syncthreads();
    }
}

constexpr int SX_SA = 0, SX_VX = 16384;
struct OSet { bf16x8 q[4], p[2]; };
struct SSet { bf16x8 k[4], v; f32x4 dc[2]; };
DI void o_load(OSet& x, const unsigned char* rec, int t, int lane) {
    const unsigned char* qb = rec + (t * 4 * 64 + lane) * 16;
#pragma unroll
    for (int kap = 0; kap < 4; ++kap) x.q[kap] = *(const bf16x8*)(qb + kap * 1024);
    const unsigned char* pb = rec + REC_PM + (t * 2 * 64 + lane) * 16;
    x.p[0] = *(const bf16x8*)pb; x.p[1] = *(const bf16x8*)(pb + 1024);
}
DI void s_load(SSet& x, const unsigned char* rec, const unsigned char* vt, int jj, int lane, int g) {
    const unsigned char* kb = rec + REC_KDT + (jj * 4 * 64 + lane) * 16;
#pragma unroll
    for (int f = 0; f < 4; ++f) x.k[f] = *(const bf16x8*)(kb + f * 1024);
    const unsigned char* db = rec + REC_DEC + (32 * jj + 4 * g) * 4;
    x.dc[0] = *(const f32x4*)db; x.dc[1] = *(const f32x4*)(db + 64);
    x.v = *(const bf16x8*)(vt + jj * 1024 + lane * 16);
}
DI void o_step(const OSet& x, const LAS unsigned char* sab, const LAS unsigned char* vxb, int lane, bf16* optr, bool st) {
    bf16x8 sa[2][4], v[2][2];
#pragma unroll
    for (int q = 0; q < 2; ++q) {
#pragma unroll
        for (int kap = 0; kap < 4; ++kap) sa[q][kap] = *(const LAS bf16x8*)(sab + (q * 4 + kap) * 1024 + lane * 16);
        v[q][0] = *(const LAS bf16x8*)(vxb + (q * 2) * 1024 + lane * 16); v[q][1] = *(const LAS bf16x8*)(vxb + (q * 2 + 1) * 1024 + lane * 16);
    }
    asm volatile("s_waitcnt lgkmcnt(0)" ::: "memory");
    f32x4 o0[2], o1[2];
#pragma unroll
    for (int q = 0; q < 2; ++q) { o0[q] = (f32x4){0.f, 0.f, 0.f, 0.f}; o1[q] = (f32x4){0.f, 0.f, 0.f, 0.f}; }
#pragma unroll
    for (int q = 0; q < 2; ++q) { o0[q] = __builtin_amdgcn_mfma_f32_16x16x32_bf16(v[q][0], x.p[0], o0[q], 0, 0, 0); o1[q] = __builtin_amdgcn_mfma_f32_16x16x32_bf16(v[q][1], x.p[1], o1[q], 0, 0, 0); }
#pragma unroll
    for (int kk = 0; kk < 2; ++kk)
#pragma unroll
        for (int q = 0; q < 2; ++q) { o0[q] = __builtin_amdgcn_mfma_f32_16x16x32_bf16(sa[q][2 * kk], x.q[2 * kk], o0[q], 0, 0, 0); o1[q] = __builtin_amdgcn_mfma_f32_16x16x32_bf16(sa[q][2 * kk + 1], x.q[2 * kk + 1], o1[q], 0, 0, 0); }
    if (st) {
#pragma unroll
        for (int q = 0; q < 2; ++q) { const f32x4 o = o0[q] + o1[q]; *(v2u*)(optr + 16 * q) = (v2u){cvtpk(o[0], o[1]), cvtpk(o[2], o[3])}; }
    }
}
DI void s_step(f32x4 (&S)[2][2], const SSet& x, const LAS unsigned char* vxb, LAS unsigned char* sab, int jj, int lane) {
    bf16x8 v[2][2];
#pragma unroll
    for (int q = 0; q < 2; ++q) { v[q][0] = *(const LAS bf16x8*)(vxb + (q * 2) * 1024 + lane * 16); v[q][1] = *(const LAS bf16x8*)(vxb + (q * 2 + 1) * 1024 + lane * 16); }
#pragma unroll
    for (int q = 0; q < 2; ++q) { S[q][0] = S[q][0] * x.dc[0]; S[q][1] = S[q][1] * x.dc[1]; }
    asm volatile("s_waitcnt lgkmcnt(0)" ::: "memory");
#pragma unroll
    for (int q = 0; q < 2; ++q) { S[q][0] = __builtin_amdgcn_mfma_f32_16x16x32_bf16(x.k[0], v[q][0], S[q][0], 0, 0, 0); S[q][1] = __builtin_amdgcn_mfma_f32_16x16x32_bf16(x.k[2], v[q][0], S[q][1], 0, 0, 0); }
#pragma unroll
    for (int q = 0; q < 2; ++q) { S[q][0] = __builtin_amdgcn_mfma_f32_16x16x32_bf16(x.k[1], v[q][1], S[q][0], 0, 0, 0); S[q][1] = __builtin_amdgcn_mfma_f32_16x16x32_bf16(x.k[3], v[q][1], S[q][1], 0, 0, 0); }
#pragma unroll
    for (int q = 0; q < 2; ++q)
        *(LAS v4u*)(sab + (q * 4 + jj) * 1024 + lane * 16) = (v4u){cvtpk(S[q][0][0], S[q][0][1]), cvtpk(S[q][0][2], S[q][0][3]), cvtpk(S[q][1][0], S[q][1][1]), cvtpk(S[q][1][2], S[q][1][3])};
}
DI void p5_scan_item(const Args& a, LAS unsigned char* lds, int lane, int wave, int item) {
    unsigned char* ws = a.ws;
    const unsigned char* REC = ws + WS_REC; const unsigned char* VT = ws + WS_VT;
    const int sl32 = item & 7, dir = (item >> 3) & 1, h = (item >> 4) & 3, b = item >> 6;
    bf16* O = dir ? (bf16*)((unsigned char*)a.out + DO_OB) : (bf16*)(ws + WS_OF);
    const size_t t0 = tile_idx(dir, b, h, 0); const size_t v0i = (size_t)(b * 4 + h) * NCHUNK;
    const int fr = lane & 15, g = lane >> 4;
#define SC_CS(step) (dir ? 128 - (step) : (step))
#define SC_REC(step) (REC + (t0 + SC_CS(step)) * REC_BYTES)
#define SC_VT(step) (VT + (v0i + SC_CS(step)) * 32768 + sl32 * 4096)
    __syncthreads();
    if (wave < 4) { *(LAS v4u*)(lds + SX_SA + 8192 + wave * 1024 + lane * 16) = (v4u){0u, 0u, 0u, 0u}; *(LAS v4u*)(lds + SX_SA + 8192 + (4 + wave) * 1024 + lane * 16) = (v4u){0u, 0u, 0u, 0u}; }
    if (wave < 4) {
        const int t = wave;
        OSet A, B, C;
        o_load(A, SC_REC(0), t, lane); o_load(B, SC_REC(1), t, lane); o_load(C, SC_REC(2), t, lane);
        bf16* obase = O + ((size_t)b * 8192 + 16 * t + fr) * 1024 + h * 256 + 32 * sl32 + 4 * g;
        __syncthreads();
#ifdef PROBE_SCAN
#define O_ITER(X, s) do { const unsigned long long q0_ = __builtin_amdgcn_s_memrealtime(); const int cs_ = SC_CS(s); o_step(X, lds + SX_SA + (((s) + 1) & 1) * 8192, lds + SX_VX + ((s) & 1) * 4096, lane, obase + (ptrdiff_t)(cs_ - 1) * 65536, cs_ != 0); \
                          const unsigned long long q1_ = __builtin_amdgcn_s_memrealtime(); if ((s) + 3 < NCHUNK) o_load(X, SC_REC((s) + 3), t, lane); const unsigned long long q2_ = __builtin_amdgcn_s_memrealtime(); __syncthreads(); \
                          const unsigned long long q3_ = __builtin_amdgcn_s_memrealtime(); pa0 += q1_ - q0_; pa1 += q2_ - q1_; pa2 += q3_ - q2_; } while (0)
#else
#define O_ITER(X, s) do { const int cs_ = SC_CS(s); o_step(X, lds + SX_SA + (((s) + 1) & 1) * 8192, lds + SX_VX + ((s) & 1) * 4096, lane, obase + (ptrdiff_t)(cs_ - 1) * 65536, cs_ != 0); \
                          if ((s) + 3 < NCHUNK) o_load(X, SC_REC((s) + 3), t, lane); __syncthreads(); } while (0)
#endif
#ifdef PROBE_SCAN
        unsigned long long pa0 = 0, pa1 = 0, pa2 = 0;
#endif
#pragma unroll 1
        for (int s0 = 0; s0 < NCHUNK; s0 += 3) { O_ITER(A, s0); O_ITER(B, s0 + 1); O_ITER(C, s0 + 2); }
#ifdef PROBE_SCAN
        if (item == 0 && wave == 0 && lane == 0) { unsigned long long* TSW = (unsigned long long*)(a.ws + WS_BAR_OFF + 8192); TSW[20] = pa0; TSW[21] = pa1; TSW[22] = pa2; }
#endif
#undef O_ITER
    } else {
        const int jj = wave - 4;
        SSet A, B, C;
        s_load(A, SC_REC(0), SC_VT(0), jj, lane, g); s_load(B, SC_REC(1), SC_VT(1), jj, lane, g); s_load(C, SC_REC(2), SC_VT(2), jj, lane, g);
        *(LAS bf16x8*)(lds + SX_VX + jj * 1024 + lane * 16) = A.v;
        f32x4 S[2][2] = {{{0.f, 0.f, 0.f, 0.f}, {0.f, 0.f, 0.f, 0.f}}, {{0.f, 0.f, 0.f, 0.f}, {0.f, 0.f, 0.f, 0.f}}};
        __syncthreads();
#ifdef PROBE_SCAN
#define S_ITER(X, Y, s) do { const unsigned long long q0_ = __builtin_amdgcn_s_memrealtime(); s_step(S, X, lds + SX_VX + ((s) & 1) * 4096, lds + SX_SA + ((s) & 1) * 8192, jj, lane); \
                          if ((s) + 1 < NCHUNK) *(LAS bf16x8*)(lds + SX_VX + (((s) + 1) & 1) * 4096 + jj * 1024 + lane * 16) = Y.v; asm volatile("s_waitcnt lgkmcnt(0)" ::: "memory"); \
                          const unsigned long long q1_ = __builtin_amdgcn_s_memrealtime(); if ((s) + 3 < NCHUNK) s_load(X, SC_REC((s) + 3), SC_VT((s) + 3), jj, lane, g); const unsigned long long q2_ = __builtin_amdgcn_s_memrealtime(); __syncthreads(); \
                          const unsigned long long q3_ = __builtin_amdgcn_s_memrealtime(); pa0 += q1_ - q0_; pa1 += q2_ - q1_; pa2 += q3_ - q2_; } while (0)
#else
#define S_ITER(X, Y, s) do { s_step(S, X, lds + SX_VX + ((s) & 1) * 4096, lds + SX_SA + ((s) & 1) * 8192, jj, lane); \
                          if ((s) + 1 < NCHUNK) *(LAS bf16x8*)(lds + SX_VX + (((s) + 1) & 1) * 4096 + jj * 1024 + lane * 16) = Y.v; \
                          if ((s) + 3 < NCHUNK) s_load(X, SC_REC((s) + 3), SC_VT((s) + 3), jj, lane, g); __syncthreads(); } while (0)
#endif
#ifdef PROBE_SCAN
        unsigned long long pa0 = 0, pa1 = 0, pa2 = 0;
#endif
#pragma unroll 1
        for (int s0 = 0; s0 < NCHUNK; s0 += 3) { S_ITER(A, B, s0); S_ITER(B, C, s0 + 1); S_ITER(C, A, s0 + 2); }
#ifdef PROBE_SCAN
        if (item == 0 && wave == 4 && lane == 0) { unsigned long long* TSW = (unsigned long long*)(a.ws + WS_BAR_OFF + 8192); TSW[23] = pa0; TSW[24] = pa1; TSW[25] = pa2; }
#endif
#undef S_ITER
    }
#undef SC_CS
#undef SC_REC
#undef SC_VT
}
DI void o_step1(const OSet& x, const LAS unsigned char* sab, const LAS unsigned char* vxb, int lane, bf16* optr, bool st) {
    bf16x8 sa[4], v[2];
#pragma unroll
    for (int kap = 0; kap < 4; ++kap) sa[kap] = *(const LAS bf16x8*)(sab + kap * 1024 + lane * 16);
    v[0] = *(const LAS bf16x8*)(vxb + lane * 16); v[1] = *(const LAS bf16x8*)(vxb + 1024 + lane * 16);
    asm volatile("s_waitcnt lgkmcnt(0)" ::: "memory");
    f32x4 o0 = {0.f, 0.f, 0.f, 0.f}, o1 = {0.f, 0.f, 0.f, 0.f};
    o0 = __builtin_amdgcn_mfma_f32_16x16x32_bf16(v[0], x.p[0], o0, 0, 0, 0);
    o1 = __builtin_amdgcn_mfma_f32_16x16x32_bf16(v[1], x.p[1], o1, 0, 0, 0);
    o0 = __builtin_amdgcn_mfma_f32_16x16x32_bf16(sa[0], x.q[0], o0, 0, 0, 0);
    o1 = __builtin_amdgcn_mfma_f32_16x16x32_bf16(sa[1], x.q[1], o1, 0, 0, 0);
    o0 = __builtin_amdgcn_mfma_f32_16x16x32_bf16(sa[2], x.q[2], o0, 0, 0, 0);
    o1 = __builtin_amdgcn_mfma_f32_16x16x32_bf16(sa[3], x.q[3], o1, 0, 0, 0);
    if (st) { const f32x4 o = o0 + o1; __builtin_nontemporal_store((v2u){cvtpk(o[0], o[1]), cvtpk(o[2], o[3])}, (v2u*)optr); }
}
DI void s_step1(f32x4 (&S)[2], const SSet& x, const LAS unsigned char* vxb, LAS unsigned char* sab, int jj, int lane) {
    const bf16x8 v0 = *(const LAS bf16x8*)(vxb + lane * 16), v1 = *(const LAS bf16x8*)(vxb + 1024 + lane * 16);
    S[0] = S[0] * x.dc[0]; S[1] = S[1] * x.dc[1];
    asm volatile("s_waitcnt lgkmcnt(0)" ::: "memory");
    S[0] = __builtin_amdgcn_mfma_f32_16x16x32_bf16(x.k[0], v0, S[0], 0, 0, 0);
    S[1] = __builtin_amdgcn_mfma_f32_16x16x32_bf16(x.k[2], v0, S[1], 0, 0, 0);
    S[0] = __builtin_amdgcn_mfma_f32_16x16x32_bf16(x.k[1], v1, S[0], 0, 0, 0);
    S[1] = __builtin_amdgcn_mfma_f32_16x16x32_bf16(x.k[3], v1, S[1], 0, 0, 0);
    *(LAS v4u*)(sab + jj * 1024 + lane * 16) = (v4u){cvtpk(S[0][0], S[0][1]), cvtpk(S[0][2], S[0][3]), cvtpk(S[1][0], S[1][1]), cvtpk(S[1][2], S[1][3])};
}
DI void s_load1(SSet& x, const unsigned char* rec, const unsigned char* vt, int jj, int lane, int g) {
    const unsigned char* kb = rec + REC_KDT + (jj * 4 * 64 + lane) * 16;
#pragma unroll
    for (int f = 0; f < 4; ++f) x.k[f] = *(const bf16x8*)(kb + f * 1024);
    const unsigned char* db = rec + REC_DEC + (32 * jj + 4 * g) * 4;
    x.dc[0] = *(const f32x4*)db; x.dc[1] = *(const f32x4*)(db + 64);
    if (jj < 2) x.v = *(const bf16x8*)(vt + jj * 1024 + lane * 16);
}
DI void p5_scan_item1(const Args& a, LAS unsigned char* lds, int lane, int wave, int item) {
    unsigned char* ws = a.ws;
    const unsigned char* REC = ws + WS_REC; const unsigned char* VT = ws + WS_VT;
    const int sl = item & 15, dir = (item >> 4) & 1, h = (item >> 5) & 3, b = item >> 7;
    bf16* O = dir ? (bf16*)((unsigned char*)a.out + DO_OB) : (bf16*)(ws + WS_OF);
    const size_t t0 = tile_idx(dir, b, h, 0); const size_t v0i = (size_t)(b * 4 + h) * NCHUNK;
    const int fr = lane & 15, g = lane >> 4;
#define SC_CS(step) (dir ? 128 - (step) : (step))
#define SC_REC(step) (REC + (t0 + SC_CS(step)) * REC_BYTES)
#define SC_VT(step) (VT + (v0i + SC_CS(step)) * 32768 + sl * 2048)
    __syncthreads();
    if (wave < 4) *(LAS v4u*)(lds + 4096 + wave * 1024 + lane * 16) = (v4u){0u, 0u, 0u, 0u};
    if (wave < 4) {
        const int t = wave;
        OSet A, B, C;
        o_load(A, SC_REC(0), t, lane); o_load(B, SC_REC(1), t, lane); o_load(C, SC_REC(2), t, lane);
        bf16* obase = O + ((size_t)b * 8192 + 16 * t + fr) * 1024 + h * 256 + 16 * sl + 4 * g;
        __syncthreads();
#define O_ITER(X, s) do { const int cs_ = SC_CS(s); o_step1(X, lds + (((s) + 1) & 1) * 4096, lds + 16384 + ((s) & 1) * 2048, lane, obase + (ptrdiff_t)(cs_ - 1) * 65536, cs_ != 0); \
                          if ((s) + 3 < NCHUNK) o_load(X, SC_REC((s) + 3), t, lane); __syncthreads(); } while (0)
#pragma unroll 1
        for (int s0 = 0; s0 < NCHUNK; s0 += 3) { O_ITER(A, s0); O_ITER(B, s0 + 1); O_ITER(C, s0 + 2); }
#undef O_ITER
    } else {
        const int jj = wave - 4;
        SSet A, B, C;
        s_load1(A, SC_REC(0), SC_VT(0), jj, lane, g); s_load1(B, SC_REC(1), SC_VT(1), jj, lane, g); s_load1(C, SC_REC(2), SC_VT(2), jj, lane, g);
        if (jj < 2) *(LAS bf16x8*)(lds + 16384 + jj * 1024 + lane * 16) = A.v;
        f32x4 S[2] = {{0.f, 0.f, 0.f, 0.f}, {0.f, 0.f, 0.f, 0.f}};
        __syncthreads();
#define S_ITER(X, Y, s) do { s_step1(S, X, lds + 16384 + ((s) & 1) * 2048, lds + ((s) & 1) * 4096, jj, lane); \
                          if (jj < 2 && (s) + 1 < NCHUNK) *(LAS bf16x8*)(lds + 16384 + (((s) + 1) & 1) * 2048 + jj * 1024 + lane * 16) = Y.v; \
                          if ((s) + 3 < NCHUNK) s_load1(X, SC_REC((s) + 3), SC_VT((s) + 3), jj, lane, g); __syncthreads(); } while (0)
#pragma unroll 1
        for (int s0 = 0; s0 < NCHUNK; s0 += 3) { S_ITER(A, B, s0); S_ITER(B, C, s0 + 1); S_ITER(C, A, s0 + 2); }
#undef S_ITER
    }
#undef SC_CS
#undef SC_REC
#undef SC_VT
}
constexpr size_t WS_BAR = 239 * MiB + 768 * 1024;
#define XB_TMO      128
#define XB_XCNT(j)  (256  + 64 * (j))
#define XB_XSUB(j)  (1280 + 64 * (j))
#define XB_XGEN(j)  (2304 + 64 * (j))
#define XB_TOP      3328
#define XB_TOPGEN   3392
#define XCD_BAR_WORDS 3456
#define XB_SPIN_CAP (1u << 18)

__device__ __forceinline__ unsigned xb_ld(unsigned* p)              { return __hip_atomic_load(p, __ATOMIC_RELAXED, __HIP_MEMORY_SCOPE_AGENT); }
__device__ __forceinline__ unsigned xb_add(unsigned* p, unsigned v) { return __hip_atomic_fetch_add(p, v, __ATOMIC_RELAXED, __HIP_MEMORY_SCOPE_AGENT); }
__device__ __forceinline__ unsigned xb_xcc_id() { return (unsigned)__builtin_amdgcn_s_getreg((3 << 11) | 20) & 0xFu; }
#define XB_SPIN(cond, bar) do { unsigned _sp = 0; while (cond) { __builtin_amdgcn_s_sleep(1); \
    if ((++_sp & 255u) == 0u) { if (xb_ld(&(bar)[XB_TMO])) break; if (_sp > XB_SPIN_CAP) { atomicAdd(&(bar)[XB_TMO], 1u); break; } } } } while (0)

struct XcdBarrier {
    unsigned* bar; unsigned x;
    volatile LAS unsigned* st;
};

__device__ __forceinline__ XcdBarrier xcd_barrier_post(unsigned* bar, volatile LAS unsigned* st) {
    XcdBarrier b; b.bar = bar; b.x = xb_xcc_id(); b.st = st;
    if (threadIdx.x == 0) (void)xb_add(&bar[XB_XCNT(b.x)], 1u);
    return b;
}
__device__ __forceinline__ void xcd_barrier_complete(unsigned* bar, unsigned x, unsigned& nloc, unsigned& nx) {
    const unsigned G = gridDim.x * gridDim.y * gridDim.z;
    unsigned sum, cnt, mine, sp = 0u;
    for (;;) {
        sum = 0u; cnt = 0u; mine = 0u;
#pragma unroll
        for (unsigned j = 0; j < 16; ++j) { const unsigned c = xb_ld(&bar[XB_XCNT(j)]); sum += c; cnt += (c > 0u) ? 1u : 0u; mine = (j == x) ? c : mine; }
        if (sum == G) break;
        __builtin_amdgcn_s_sleep(1);
        if ((++sp & 255u) == 0u) { if (xb_ld(&bar[XB_TMO])) break; if (sp > XB_SPIN_CAP) { atomicAdd(&bar[XB_TMO], 1u); break; } }
    }
    nloc = mine > 0u ? mine : 1u; nx = cnt > 0u ? cnt : 1u;
}

__device__ __forceinline__ void xcd_barrier(const XcdBarrier& b) {
    asm volatile("s_waitcnt vmcnt(0)" ::: "memory");
    __syncthreads();
    if (threadIdx.x == 0) {
        unsigned* bar = b.bar;
        __builtin_amdgcn_s_waitcnt(0);
        unsigned nloc = b.st[0], nx = b.st[1];
        if (nloc == 0u) { xcd_barrier_complete(bar, b.x, nloc, nx); b.st[0] = nloc; b.st[1] = nx; }
        const unsigned old = xb_add(&bar[XB_XSUB(b.x)], 1u);
        const unsigned gen = old / nloc;
        if (old + 1u == (gen + 1u) * nloc) {
            __builtin_amdgcn_fence(__ATOMIC_RELEASE, "agent");
            asm volatile("s_waitcnt vmcnt(0)" ::: "memory");
            const unsigned og = xb_add(&bar[XB_TOP], 1u);
            const unsigned tg = og / nx;
            if (og + 1u == (tg + 1u) * nx) xb_add(&bar[XB_TOPGEN], 1u);
            else XB_SPIN(xb_ld(&bar[XB_TOPGEN]) == tg, bar);
            __builtin_amdgcn_fence(__ATOMIC_ACQUIRE, "agent");
            xb_add(&bar[XB_XGEN(b.x)], 1u);
            asm volatile("s_waitcnt vmcnt(0)" ::: "memory");
        } else {
            XB_SPIN(xb_ld(&bar[XB_XGEN(b.x)]) == gen, bar);
            __builtin_amdgcn_fence(__ATOMIC_ACQUIRE, "agent");
            asm volatile("s_waitcnt vmcnt(0)" ::: "memory");
        }
    }
    __syncthreads();
}

#ifndef ONE_LAUNCH
#define ONE_LAUNCH 1
#endif
constexpr int NPH = 13;
__global__ void __launch_bounds__(NTHREADS, 2) fwd_kernel(Args a) {
    extern __shared__ __attribute__((aligned(16))) unsigned char lds_raw[];
    LAS unsigned char* lds = (LAS unsigned char*)lds_raw;
    const int tid = threadIdx.x, lane = tid & 63, wave = __builtin_amdgcn_readfirstlane(tid >> 6), bid = blockIdx.x, G = gridDim.x;
    unsigned char* ws = a.ws;
    const int lo = a.ph_lo, hi = a.ph_hi;
    volatile LAS unsigned* bst = (volatile LAS unsigned*)(lds + LDS_BYTES - 16);
    if (tid < 2) bst[tid] = 0u;
    __syncthreads();
    XcdBarrier xbar = xcd_barrier_post((unsigned*)(a.ws + WS_BAR), bst);
    const int vb = (G == 256) ? (bid & 7) * 32 + (bid >> 3) : bid;
#define IN(k) (lo <= (k) && (k) < hi)
#ifdef PROBE_TS
    unsigned long long* TSW = (unsigned long long*)(a.ws + WS_BAR + 8192);
    if (bid == 0 && tid == 0) TSW[0] = __builtin_amdgcn_s_memrealtime();
#define SEAM(k) do { if (IN(k) && IN((k) + 1)) { xcd_barrier(xbar); if (bid == 0 && tid == 0) TSW[(k) + 1] = __builtin_amdgcn_s_memrealtime(); } } while (0)
#else
#define SEAM(k) do { if (IN(k) && IN((k) + 1)) { if (hi > 1000) cg::this_grid().sync(); else xcd_barrier(xbar); } } while (0)
#endif
    pg8::EP ep;
    ep.Q = (bf16*)((unsigned char*)a.out + DO_Q); ep.K = (bf16*)(ws + WS_K); ep.V = (bf16*)((unsigned char*)a.out + DO_V); ep.R = (float*)(ws + WS_R);
    ep.GT2 = (bf16*)(ws + WS_GT2); ep.PQ = (bf16*)(ws + WS_PQ); ep.SGA = (bf16*)((unsigned char*)a.out + 32 * MiB);     ep.SGF = (bf16*)(ws + WS_SGF); ep.ON = (bf16*)(ws + WS_ON);
    ep.OG = (bf16*)(ws + WS_OG); ep.MG = (bf16*)(ws + WS_MG); ep.H1B = (bf16*)(ws + WS_H1B); ep.HF = (bf16*)(ws + WS_HF);
    ep.H2B = (bf16*)(ws + WS_H2B); ep.x = a.x; ep.H = a.out; ep.PART1 = (float*)(ws + WS_PART1); ep.gnorm = a.gla_norm;
    const bf16* ALL = (const bf16*)(ws + WS_ALL);

    if (IN(0)) { p0_prologue(a, lds, tid, lane, wave, bid, G); }
    SEAM(0);
    if (IN(1)) { pg8::Gemm g{ALL, ALL, 0, 0, 1024}; pg8::Sched S{1, 845, G, vb, 0, 0, 0}; pg8::Epi<1> E{ep};
        pg8::gemm_phase<pg8::Epi<1>, pg8::Sched, true, true>(lds, g, S, E);
        if (G == 256) { if (vb >= 77) gen_cs_tab(a, lds, tid, vb - 77, 256 - 77); }
        else gen_cs_tab(a, lds, tid, bid, G); }
    SEAM(1);
    if (IN(2)) { p2_sym_rem(a, tid, lane, wave, bid, G); }
    SEAM(2);
    if (IN(3)) { pg8::Gemm g{(const bf16*)(ws + WS_CS), (const bf16*)(ws + WS_EOT), 0, 0, KH}; pg8::Sched S{2, 256, G, vb, 0, 0, 0}; pg8::Epi<2> E{ep};
        pg8::gemm_phase<pg8::Epi<2>, pg8::Sched, true, true>(lds, g, S, E); }
    SEAM(3);
    if (IN(4)) { p4_gla_prep(a, lds, tid, lane, wave, bid, G); p4_combine(a, tid, bid, G); }
    SEAM(4);
    if (IN(5)) {
        for (int item = vb; item < 256; item += G) p5_scan_item1(a, lds, lane, wave, item);
    }
    SEAM(5);
    if (IN(6)) { p6_post(a, lane, wave, bid, G);
        pg8::Gemm g{ALL, ALL, 0, 0, 1024}; pg8::Sched S{3, 512, G, vb, 8, 0, 82}; pg8::Epi<3> E{ep};
        pg8::gemm_phase<pg8::Epi<3>, pg8::Sched, true, true>(lds, g, S, E); }
    SEAM(6);
    if (IN(7)) {
        { pg8::Gemm g{ALL, ALL, 0, 0, 1024}; pg8::Sched S{3, 256, G, vb, 4, 0, 78}; pg8::Epi<4> E{ep};
          pg8::gemm_phase<pg8::Epi<4>, pg8::Sched, true, true>(lds, g, S, E); }
        { pg8::Gemm g{(const bf16*)(ws + WS_FN), (const bf16*)(ws + WS_WFT), 0, 0, 512}; pg8::Sched S{3, 256, G, vb, 4, 0, 0}; pg8::Epi<5> E{ep};
          pg8::gemm_phase<pg8::Epi<5>, pg8::Sched, true, true>(lds, g, S, E); }
    }
    SEAM(7);
    if (IN(8)) { pg8::Gemm g{(const bf16*)(ws + WS_OG), (const bf16*)(ws + WS_WOT), 0, 0, 1024}; pg8::Sched S{3, 256, G, vb, 4, 0, 0}; pg8::Epi<6> E{ep};
        pg8::gemm_phase<pg8::Epi<6>, pg8::Sched, true, true>(lds, g, S, E); }
    SEAM(8);
    if (IN(9)) { pg8::Gemm g{(const bf16*)(ws + WS_MG), (const bf16*)(ws + WS_WOUTT), 0, 0, 1024}; pg8::Sched S{3, 256, G, vb, 4, 0, 0}; pg8::Epi<7> E{ep};
        pg8::gemm_phase<pg8::Epi<7>, pg8::Sched, true, true>(lds, g, S, E); }
    SEAM(9);
    if (IN(10)) { pg8::Gemm g{(const bf16*)(ws + WS_H1B), (const bf16*)(ws + WS_W1T), 0, 0, 1024}; pg8::Sched S{3, 1024, G, vb, 16, 0, 0}; pg8::Epi<8> E{ep};
        pg8::gemm_phase<pg8::Epi<8>, pg8::Sched, true, true>(lds, g, S, E); }
    SEAM(10);
    if (IN(11)) { pg8::Gemm g{(const bf16*)(ws + WS_HF), (const bf16*)(ws + WS_W2T), 4224, 4224, 4096}; pg8::Sched S{3, 256, G, vb, 4, 0, 0}; pg8::Epi<9> E{ep};
        pg8::gemm_phase<pg8::Epi<9>, pg8::Sched, true, true>(lds, g, S, E); }
    SEAM(11);
    if (IN(12)) { p11_final(a, lane, wave, bid, G); }
#ifdef PROBE_TS
    if (bid == 0) {
        if (tid == 0) TSW[13] = __builtin_amdgcn_s_memrealtime();
        __syncthreads();
#ifdef PROBE_IDX
        const float t_us = (float)TSW[PROBE_IDX] * 0.01f;
#else
        const float t_us = (float)(TSW[PROBE_TS + 1] - TSW[PROBE_TS]) * 0.01f;
#endif
        const float delta = sqrtf(t_us * 2.048e-5f);
        float* row = a.out + (size_t)wave * D;
        for (int c = lane; c < D; c += 64) row[c] += delta;
    }
#endif
#ifdef PROBE_REP
    if (IN(13)) { pg8::Gemm g{(const bf16*)(ws + WS_HF), (const bf16*)(ws + WS_W2T), 4224, 4224, 4096}; pg8::Sched S{3, 256, G, vb, 4, 0, 0}; pg8::Epi<10> E{ep};
        pg8::gemm_phase<pg8::Epi<10>, pg8::Sched, true, true>(lds, g, S, E); }
    if (IN(14)) { const int gw = bid * NWAVES + wave, NGW = G * NWAVES;
        for (int row = gw; row < NREAL; row += NGW) { f32x4* xr = (f32x4*)(a.out + (size_t)row * D) + lane; float s = 0.f;
            for (int j = 0; j < 4; ++j) { const f32x4 v = xr[64 * j]; s += v.x + v.y + v.z + v.w; }
            if (wave_sum(s) == 123456.789f) xr[0] = (f32x4){s, s, s, s}; } }
#endif
#undef IN
#undef SEAM
}

extern "C" void kernel_launch(void* const* d_in, const int* in_sizes, int n_in, void* d_out, int out_size, void* d_ws, size_t ws_size, hipStream_t stream) {
    static int grid = 0;
    if (grid == 0) {
        int dev = 0, cus = 0, per_cu = 0;
        (void)hipGetDevice(&dev); (void)hipDeviceGetAttribute(&cus, hipDeviceAttributeMultiprocessorCount, dev);
        (void)hipFuncSetAttribute((const void*)fwd_kernel, hipFuncAttributeMaxDynamicSharedMemorySize, LDS_BYTES);
        (void)hipOccupancyMaxActiveBlocksPerMultiprocessor(&per_cu, (const void*)fwd_kernel, NTHREADS, LDS_BYTES);
        (void)hipGetLastError();
        if (per_cu < 1) { fprintf(stderr, "kernel_launch: occupancy query says %d blocks/CU\n", per_cu); per_cu = 1; }
        grid = cus * 1;
        if (grid > 256) grid = 256;
    }
    (void)hipMemsetAsync((char*)d_ws + WS_BAR, 0, 16384, stream);
    Args a{};
    const float* const* in = (const float* const*)d_in;
    a.x = in[0]; a.meta = in[1]; a.norm_mix = in[2]; a.w_in = in[3]; a.wdf = in[4]; a.bdf = in[5]; a.wdb = in[6]; a.bdb = in[7]; a.gla_norm = in[8];
    a.w_o = in[9]; a.w_fnet = in[10]; a.w_out = in[11]; a.norm_ffn = in[12]; a.w_ff1 = in[13]; a.w_ff2 = in[14]; a.norm_final = in[15];
    a.out = (float*)d_out; a.ws = (unsigned char*)d_ws;
#if ONE_LAUNCH
    a.ph_lo = 0; a.ph_hi = NPH;
    void* args[] = {&a};
    hipError_t e = hipLaunchCooperativeKernel((const void*)fwd_kernel, dim3(grid), dim3(NTHREADS), args, LDS_BYTES, stream);
    if (e != hipSuccess) fprintf(stderr, "cooperative launch failed: %s (grid %d)\n", hipGetErrorString(e), grid);
#else
    for (int p = 0; p < NPH; ++p) { a.ph_lo = p; a.ph_hi = p + 1; hipLaunchKernelGGL(fwd_kernel, dim3(grid), dim3(NTHREADS), LDS_BYTES, stream, a);
#ifdef PROBE_REP
        if (p == PROBE_REP) for (int q = 0; q < PROBE_N; ++q) hipLaunchKernelGGL(fwd_kernel, dim3(grid), dim3(NTHREADS), LDS_BYTES, stream, a);
#ifdef PROBE_DRY
        if (p == PROBE_AFTER) { Args a2 = a; a2.ph_lo = PROBE_DRY; a2.ph_hi = PROBE_DRY + 1; for (int q = 0; q < PROBE_N; ++q) hipLaunchKernelGGL(fwd_kernel, dim3(grid), dim3(NTHREADS), LDS_BYTES, stream, a2); }
#endif
#endif
    }
#endif
}
```

```cpp
#include <hip/hip_runtime.h>
#include <hip/hip_cooperative_groups.h>
#include <cstdio>
#include <cstdint>
namespace cg = cooperative_groups;
namespace pg8 {
#define PG8_LAS __attribute__((address_space(3)))
typedef unsigned short bf16_t;
typedef short bf16x8 __attribute__((ext_vector_type(8)));
typedef float f32x4 __attribute__((ext_vector_type(4)));
typedef unsigned u32x4 __attribute__((ext_vector_type(4)));
constexpr int BM = 256, BK = 64, HALF = 128, HTB = HALF * BK * 2  , STAGE_BYTES = 8 * HTB, NXCD = 8, WGM = 8;

__host__ __device__ __forceinline__ int lds_byte(int r, int c) { const int st = (r >> 4) * 2 + (c >> 5), rr = r & 15, cc = c & 31, ob = rr * 64 + cc * 2; return st * 1024 + (ob ^ (((ob >> 9) & 1) << 5)); }
__host__ __device__ __forceinline__ void stage_rc(int b, int& R, int& C) { const int st = b / 1024, sb = b % 1024, swz = sb ^ (((sb >> 9) & 1) << 5); R = (st >> 1) * 16 + swz / 64; C = (st & 1) * 32 + (swz % 64) / 2; }
__host__ __device__ __forceinline__ int perm32(int rho) { const int n = rho >> 4, i = rho & 15; return 8 * (i >> 2) + 4 * n + (i & 3); }

struct Unit { int pm, pn; };
struct Gemm { const bf16_t* A; const bf16_t* Bt; int M, N, K; };

__device__ __forceinline__ unsigned cvt_pk_bf16(float lo, float hi) { unsigned r; asm volatile("v_cvt_pk_bf16_f32 %0, %1, %2" : "=v"(r) : "v"(lo), "v"(hi)); return r; }
__device__ __forceinline__ float bflo(unsigned w) { return __uint_as_float(w << 16); }
__device__ __forceinline__ float bfhi(unsigned w) { return __uint_as_float(w & 0xffff0000u); }

struct Sched {
    int mode, n, G, c, nN, offM, offN;
    __device__ __forceinline__ bool next(int i, Unit& u) const {
        const int L = i * G + c; if (L >= n) return false;
        if (mode == 1) {
            if (L < 585) { u.pm = L / 9; u.pn = 65 + L % 9; }
            else { const int l2 = L - 585; u.pm = 65 + 9 + (l2 & 3); u.pn = l2 >> 2; }
        } else if (mode == 2) {
            const int grp = L >> 6, r = L & 63; u.pm = grp * 16 + (r >> 2); u.pn = grp * 4 + (r & 3);
        } else if (mode == 5) {
            const int x = c >> 4, ul = i * 16 + (c & 15);
            if (i * 128 + c >= n) return false;
            u.pm = 8 * x + (ul & 7) + offM; u.pn = (ul >> 3) + offN;
        } else {
            const int x = (L & 255) >> 5, ul = (L >> 8) * 32 + (L & 31);
            u.pm = 8 * x + (ul & 7) + offM; u.pn = (ul >> 3) + offN; }
        return true;
    }
    __device__ __forceinline__ void a_ready(const Unit&) const {}
    __device__ __forceinline__ void done(const Unit&) const {}
};

struct EP {
    bf16_t *Q, *K, *V; float* R; bf16_t* GT2; bf16_t* PQ; bf16_t *SGA, *SGF, *ON, *OG, *MG, *H1B, *HF;
    const float* x; float* H; float* PART1; const float* gnorm; bf16_t* H2B;
};
constexpr int LDG = 8320;
template <int MODE> struct Epi {
    static constexpr bool PERM = true, AFTER_DRAIN = false;
    EP p;
    __device__ __forceinline__ void operator()(const f32x4 (&acc)[2][2][4][2], const Unit& u, int wr, int wc, int fr, int fq) const {
#pragma unroll
        for (int ai = 0; ai < 2; ++ai)
#pragma unroll
            for (int m = 0; m < 4; ++m) {
                const int r = ai * HALF + wr * 64 + m * 16 + fr;
                float ss = 0.f;
                float rstd = 1.f;
                if (MODE == 8) { const float* pp = p.PART1 + (size_t)(u.pm * BM + r) * 16; float s = 0.f;
#pragma unroll
                    for (int t = 0; t < 4; ++t) { const f32x4 q4 = *(const f32x4*)(pp + 4 * t); s += (q4[0] + q4[1]) + (q4[2] + q4[3]); }
                    rstd = 1.0f / sqrtf(s * (1.0f / 1024.0f) + 1e-6f); }
#pragma unroll
                for (int bj = 0; bj < 2; ++bj) {
                    const int c = bj * HALF + wc * 32 + 8 * fq;
                    f32x4 v0 = acc[ai][bj][m][0], v1 = acc[ai][bj][m][1];
                    if (MODE == 1) {
                        if (u.pm < 65) {
                            const int t = u.pn - 65; const size_t row = (size_t)u.pm * BM + r;
                            if (t < 8) {
                                bf16_t* dst; float sc = 1.f;
                                if (t < 2) { dst = p.Q + row * 512 + t * 256 + c; sc = 0.08838834764831845f; }
                                else if (t < 4) dst = p.K + row * 512 + (t - 2) * 256 + c;
                                else dst = p.V + row * 1024 + (t - 4) * 256 + c;
                                u32x4 w; w.x = cvt_pk_bf16(v0[0] * sc, v0[1] * sc); w.y = cvt_pk_bf16(v0[2] * sc, v0[3] * sc); w.z = cvt_pk_bf16(v1[0] * sc, v1[1] * sc); w.w = cvt_pk_bf16(v1[2] * sc, v1[3] * sc);
                                *(u32x4*)dst = w;
                            } else if (c < 32) { float* dst = p.R + row * 32 + c; *(f32x4*)dst = v0; *(f32x4*)(dst + 4) = v1; }
                        } else {
                            const int gcol = (u.pm - 74) * BM + r, cs = gcol >> 9, col = gcol & 511;
                            u32x4 w; w.x = cvt_pk_bf16(v0[0], v0[1]); w.y = cvt_pk_bf16(v0[2], v0[3]); w.z = cvt_pk_bf16(v1[0], v1[1]); w.w = cvt_pk_bf16(v1[2], v1[3]);
                            if (u.pn < 64) { const int b = u.pn >> 5, l = 16 + (u.pn & 31) * 256 + c;
                                *(u32x4*)(p.GT2 + ((size_t)(b * 512 + col) * 2 + cs) * LDG + l) = w; }
                            else if (c == 48 || c == 56) { const int l = c - 48;
                                *(u32x4*)(p.GT2 + ((size_t)(col) * 2 + cs) * LDG + l) = w; *(u32x4*)(p.GT2 + ((size_t)(512 + col) * 2 + cs) * LDG + l) = w; }
                        }
                    } else if (MODE == 2) {
                        const int grp = u.pm >> 4; const size_t idx = (size_t)(u.pm & 15) * BM + r; const int n = (u.pn & 3) * BM + c;
                        u32x4 w; w.x = cvt_pk_bf16(v0[0], v0[1]); w.y = cvt_pk_bf16(v0[2], v0[3]); w.z = cvt_pk_bf16(v1[0], v1[1]); w.w = cvt_pk_bf16(v1[2], v1[3]);
                        *(u32x4*)(p.PQ + ((size_t)grp * 4096 + idx) * 1024 + n) = w;
                    } else if (MODE == 3) {
                        const int t = u.pn - 82; const size_t row = (size_t)u.pm * BM + r;
                        bf16_t* dst = (t < 4 ? p.SGA : p.SGF) + row * 1024 + (t & 3) * 256 + c;
                        float s[8];
#pragma unroll
                        for (int e = 0; e < 4; ++e) { s[e] = 1.f / (1.f + __expf(-v0[e])); s[4 + e] = 1.f / (1.f + __expf(-v1[e])); }
                        u32x4 w; w.x = cvt_pk_bf16(s[0], s[1]); w.y = cvt_pk_bf16(s[2], s[3]); w.z = cvt_pk_bf16(s[4], s[5]); w.w = cvt_pk_bf16(s[6], s[7]);
                        *(u32x4*)dst = w;
                    } else if (MODE == 4) {
                        const int t = u.pn - 78; const size_t off = ((size_t)u.pm * BM + r) * 1024 + t * 256 + c;
                        const u32x4 o = *(const u32x4*)(p.ON + off);
                        float s[8];
#pragma unroll
                        for (int e = 0; e < 4; ++e) { s[e] = v0[e] / (1.f + __expf(-v0[e])); s[4 + e] = v1[e] / (1.f + __expf(-v1[e])); }
                        u32x4 w; w.x = cvt_pk_bf16(s[0] * bflo(o.x), s[1] * bfhi(o.x)); w.y = cvt_pk_bf16(s[2] * bflo(o.y), s[3] * bfhi(o.y));
                        w.z = cvt_pk_bf16(s[4] * bflo(o.z), s[5] * bfhi(o.z)); w.w = cvt_pk_bf16(s[6] * bflo(o.w), s[7] * bfhi(o.w));
                        *(u32x4*)(p.OG + off) = w;
                    } else if (MODE == 5 || MODE == 6) {
                        const size_t off = ((size_t)u.pm * BM + r) * 1024 + u.pn * BM + c;
                        const u32x4 gt = *(const u32x4*)((MODE == 5 ? p.SGF : p.SGA) + off);
                        float s[8] = {v0[0] * bflo(gt.x), v0[1] * bfhi(gt.x), v0[2] * bflo(gt.y), v0[3] * bfhi(gt.y), v1[0] * bflo(gt.z), v1[1] * bfhi(gt.z), v1[2] * bflo(gt.w), v1[3] * bfhi(gt.w)};
                        if (MODE == 6) { const u32x4 mg = *(const u32x4*)(p.MG + off);
                            s[0] += bflo(mg.x); s[1] += bfhi(mg.x); s[2] += bflo(mg.y); s[3] += bfhi(mg.y); s[4] += bflo(mg.z); s[5] += bfhi(mg.z); s[6] += bflo(mg.w); s[7] += bfhi(mg.w); }
                        u32x4 w; w.x = cvt_pk_bf16(s[0], s[1]); w.y = cvt_pk_bf16(s[2], s[3]); w.z = cvt_pk_bf16(s[4], s[5]); w.w = cvt_pk_bf16(s[6], s[7]);
                        *(u32x4*)(p.MG + off) = w;
                    } else if (MODE == 7) {
                        const size_t off = ((size_t)u.pm * BM + r) * 1024 + u.pn * BM + c;
                        const f32x4 x0 = *(const f32x4*)(p.x + off), x1 = *(const f32x4*)(p.x + off + 4);
                        v0 = v0 + x0; v1 = v1 + x1;
                        u32x4 w; w.x = cvt_pk_bf16(v0[0], v0[1]); w.y = cvt_pk_bf16(v0[2], v0[3]); w.z = cvt_pk_bf16(v1[0], v1[1]); w.w = cvt_pk_bf16(v1[2], v1[3]);
                        *(u32x4*)(p.H1B + off) = w;
                        ss += (v0[0] * v0[0] + v0[1] * v0[1]) + (v0[2] * v0[2] + v0[3] * v0[3]) + (v1[0] * v1[0] + v1[1] * v1[1]) + (v1[2] * v1[2] + v1[3] * v1[3]);
                    } else if (MODE == 8) {
                        const size_t off = ((size_t)u.pm * BM + r) * 4224 + u.pn * BM + c;
                        float s[8];
#pragma unroll
                        for (int e = 0; e < 4; ++e) { float a = fmaxf(v0[e] * rstd, 0.f), b = fmaxf(v1[e] * rstd, 0.f); s[e] = a * a; s[4 + e] = b * b; }
                        u32x4 w; w.x = cvt_pk_bf16(s[0], s[1]); w.y = cvt_pk_bf16(s[2], s[3]); w.z = cvt_pk_bf16(s[4], s[5]); w.w = cvt_pk_bf16(s[6], s[7]);
                        __builtin_nontemporal_store(w, (u32x4*)(p.HF + off));
                    } else if (MODE == 10) {
                        const size_t off = ((size_t)u.pm * BM + r) * 1024 + u.pn * BM + c;
                        const f32x4 x0 = *(const f32x4*)(p.H + off), x1 = *(const f32x4*)(p.H + off + 4);
                        if (v0[0] + x0[0] + x1[1] + v1[2] == 123456.789f) { *(f32x4*)(p.H + off) = v0 + x0; }
                    } else if (MODE == 9) {
                        const size_t off = ((size_t)u.pm * BM + r) * 1024 + u.pn * BM + c;
                        const u32x4 hb = *(const u32x4*)(p.H1B + off);
                        const f32x4 x0 = {bflo(hb.x), bfhi(hb.x), bflo(hb.y), bfhi(hb.y)}, x1 = {bflo(hb.z), bfhi(hb.z), bflo(hb.w), bfhi(hb.w)};
                        v0 = v0 + x0; v1 = v1 + x1;
                        u32x4 w; w.x = cvt_pk_bf16(v0[0], v0[1]); w.y = cvt_pk_bf16(v0[2], v0[3]); w.z = cvt_pk_bf16(v1[0], v1[1]); w.w = cvt_pk_bf16(v1[2], v1[3]);
                        *(u32x4*)(p.H2B + off) = w;
                        ss += (v0[0] * v0[0] + v0[1] * v0[1]) + (v0[2] * v0[2] + v0[3] * v0[3]) + (v1[0] * v1[0] + v1[1] * v1[1]) + (v1[2] * v1[2] + v1[3] * v1[3]);
                    }
                }
                if (MODE == 7 || MODE == 9) { ss += __shfl_xor(ss, 16); ss += __shfl_xor(ss, 32);
                    if (fq == 0) p.PART1[(size_t)(u.pm * BM + r) * 16 + u.pn * 4 + wc] = ss; }
            }
    }
};
template <class Epi, class Sched, bool ALIGN_EPI = false, bool SP2 = false>
__device__ __forceinline__ void gemm_phase(PG8_LAS unsigned char* lds, const Gemm g, const Sched& S, const Epi& E) {
    const int tid = threadIdx.x, wid = __builtin_amdgcn_readfirstlane(tid >> 6), lane = tid & 63, wr = wid >> 2, wc = wid & 3, fr = lane & 15, fq = lane >> 4;
    const int K = g.K, nt = K / BK;
    const int lda = g.M > 0 ? g.M : K, ldb = g.N > 0 ? g.N : K;
    unsigned voffA[2], voffB[2];
#pragma unroll
    for (int i = 0; i < 2; ++i) { int R, C; stage_rc(tid * 16 + i * 8192, R, C); const int Rb = Epi::PERM ? ((R & ~31) + perm32(R & 31)) : R;
        voffA[i] = (unsigned)(R * lda + C) * 2u; voffB[i] = (unsigned)(Rb * ldb + C) * 2u; }
    const size_t kstep = (size_t)(BK * 2);
    const size_t hstepA = (size_t)HALF * lda * 2, hstepB = (size_t)HALF * ldb * 2;
    const size_t tstepA = 2 * hstepA, tstepB = 2 * hstepB;
    const unsigned ldsw = (unsigned)wid * 1024u;
    const int aoff = lds_byte(wr * 64 + fr, fq * 8), boff = lds_byte(wc * 32 + fr, fq * 8);
#define PG8_SA(b, h) (((b) * 2 + (h)) * HTB)
#define PG8_SB(b, h) ((4 + (b) * 2 + (h)) * HTB)
#define PG8_STAGE(bufoff, gbase, voff) do { _Pragma("unroll") for (int _i = 0; _i < 2; ++_i) \
        __builtin_amdgcn_global_load_lds((const unsigned*)((const char*)(gbase) + (voff)[_i]), (PG8_LAS unsigned*)(lds + (bufoff) + ldsw + _i * 8192), 16, 0, 0); } while (0)
#define PG8_LDA(dst, b, h) do { _Pragma("unroll") for (int m = 0; m < 4; ++m) _Pragma("unroll") for (int k = 0; k < 2; ++k) dst[m][k] = *(const PG8_LAS bf16x8*)(lds + PG8_SA(b, h) + aoff + m * 2048 + k * 1024); } while (0)
#define PG8_LDB(dst, b, h) do { _Pragma("unroll") for (int n = 0; n < 2; ++n) _Pragma("unroll") for (int k = 0; k < 2; ++k) dst[n][k] = *(const PG8_LAS bf16x8*)(lds + PG8_SB(b, h) + boff + n * 2048 + k * 1024); } while (0)
#define PG8_MMA(ai, bj, At, Bt) do { __builtin_amdgcn_s_setprio(1); _Pragma("unroll") for (int m = 0; m < 4; ++m) _Pragma("unroll") for (int n = 0; n < 2; ++n) _Pragma("unroll") for (int k = 0; k < 2; ++k) \
        acc[ai][bj][m][n] = __builtin_amdgcn_mfma_f32_16x16x32_bf16(Bt[n][k], At[m][k], acc[ai][bj][m][n], 0, 0, 0); __builtin_amdgcn_s_setprio(0); } while (0)
#define PG8_WAIT_V(n) asm volatile("s_waitcnt vmcnt(" #n ")" ::: "memory")
#define PG8_WAIT_L(n) asm volatile("s_waitcnt lgkmcnt(" #n ")" ::: "memory")
#define PG8_BAR __builtin_amdgcn_s_barrier()
#define PG8_SCHED __builtin_amdgcn_sched_barrier(0)
    Unit cur, nxt; int ui = 0;
    if (!S.next(0, cur)) return;
    f32x4 acc[2][2][4][2];
#pragma unroll
    for (int a = 0; a < 2; ++a)
#pragma unroll
        for (int b = 0; b < 2; ++b)
#pragma unroll
            for (int m = 0; m < 4; ++m)
#pragma unroll
                for (int n = 0; n < 2; ++n) acc[a][b][m][n] = (f32x4){0.f, 0.f, 0.f, 0.f};
    bf16x8 At[4][2], B0[2][2], B1[2][2];
    const char* cA = (const char*)g.A + (size_t)cur.pm * tstepA; const char* cB = (const char*)g.Bt + (size_t)cur.pn * tstepB;
    S.a_ready(cur);
    if constexpr (SP2) {
        PG8_STAGE(PG8_SB(0, 0), cB, voffB); PG8_STAGE(PG8_SB(0, 1), cB + hstepB, voffB); PG8_STAGE(PG8_SA(0, 0), cA, voffA); PG8_STAGE(PG8_SA(0, 1), cA + hstepA, voffA);
        if (wr == 1) PG8_BAR;
        PG8_WAIT_V(2); PG8_BAR;
        PG8_STAGE(PG8_SB(1, 0), cB + kstep, voffB); PG8_STAGE(PG8_SA(1, 0), cA + kstep, voffA); PG8_STAGE(PG8_SB(1, 1), cB + hstepB + kstep, voffB);
        PG8_WAIT_V(6); PG8_BAR;
    } else {
        PG8_STAGE(PG8_SB(0, 0), cB, voffB); PG8_STAGE(PG8_SA(0, 0), cA, voffA); PG8_STAGE(PG8_SB(0, 1), cB + hstepB, voffB); PG8_STAGE(PG8_SA(0, 1), cA + hstepA, voffA);
        if (wr == 1) PG8_BAR;
        PG8_WAIT_V(4); PG8_BAR;
        PG8_STAGE(PG8_SB(1, 0), cB + kstep, voffB); PG8_STAGE(PG8_SA(1, 0), cA + kstep, voffA); PG8_STAGE(PG8_SB(1, 1), cB + hstepB + kstep, voffB);
        PG8_WAIT_V(6); PG8_BAR;
    }
    for (;;) {
        const bool has_next = S.next(ui + 1, nxt);
        const char* nA = has_next ? (const char*)g.A + (size_t)nxt.pm * tstepA : cA; const char* nB = has_next ? (const char*)g.Bt + (size_t)nxt.pn * tstepB : cB;
        for (int t = 0; t < nt; t += 2) {
            const bool last = (t == nt - 2);
            const char* a1 = cA + (size_t)(t + 1) * kstep;
            const char* a2 = last ? nA : cA + (size_t)(t + 2) * kstep; const char* b2 = last ? nB : cB + (size_t)(t + 2) * kstep;
            const char* a3 = a2 + kstep; const char* b3 = b2 + kstep;
            if (last && has_next) S.a_ready(nxt);
            if constexpr (SP2) {
            PG8_LDB(B0, 0, 0); PG8_LDB(B1, 0, 1); PG8_SCHED; PG8_LDA(At, 0, 0); PG8_STAGE(PG8_SA(1, 1), a1 + hstepA, voffA);
            PG8_WAIT_V(8); PG8_WAIT_L(0); PG8_BAR; PG8_MMA(0, 0, At, B0); PG8_MMA(0, 1, At, B1); PG8_BAR; PG8_SCHED;
            PG8_LDA(At, 0, 1); PG8_STAGE(PG8_SB(0, 0), b2, voffB); PG8_STAGE(PG8_SB(0, 1), b2 + hstepB, voffB); PG8_STAGE(PG8_SA(0, 0), a2, voffA);
            PG8_WAIT_V(8); PG8_WAIT_L(0); PG8_BAR; PG8_MMA(1, 0, At, B0); PG8_MMA(1, 1, At, B1); PG8_BAR; PG8_SCHED;
            PG8_LDB(B0, 1, 0); PG8_LDB(B1, 1, 1); PG8_SCHED; PG8_LDA(At, 1, 0); PG8_STAGE(PG8_SA(0, 1), a2 + hstepA, voffA);
            PG8_WAIT_V(8); PG8_WAIT_L(0); PG8_BAR; PG8_MMA(0, 0, At, B0); PG8_MMA(0, 1, At, B1); PG8_BAR; PG8_SCHED;
            PG8_LDA(At, 1, 1); PG8_STAGE(PG8_SB(1, 0), b3, voffB); PG8_STAGE(PG8_SB(1, 1), b3 + hstepB, voffB); PG8_STAGE(PG8_SA(1, 0), a3, voffA);
            PG8_WAIT_V(8); PG8_WAIT_L(0); PG8_BAR; PG8_MMA(1, 0, At, B0); PG8_MMA(1, 1, At, B1); PG8_BAR; PG8_SCHED;
            } else {
            PG8_LDB(B0, 0, 0); PG8_SCHED; PG8_LDA(At, 0, 0); PG8_STAGE(PG8_SA(1, 1), a1 + hstepA, voffA);
            PG8_WAIT_L(8); PG8_BAR; PG8_WAIT_L(0); PG8_MMA(0, 0, At, B0); PG8_BAR; PG8_SCHED;
            PG8_LDB(B1, 0, 1); PG8_STAGE(PG8_SB(0, 0), b2, voffB);
            PG8_BAR; PG8_WAIT_L(0); PG8_MMA(0, 1, At, B1); PG8_BAR;
            PG8_LDA(At, 0, 1); PG8_STAGE(PG8_SA(0, 0), a2, voffA);
            PG8_BAR; PG8_WAIT_L(0); PG8_MMA(1, 0, At, B0); PG8_BAR; PG8_SCHED;
            PG8_STAGE(PG8_SB(0, 1), b2 + hstepB, voffB);
            PG8_WAIT_V(6); PG8_BAR; PG8_MMA(1, 1, At, B1); PG8_BAR;
            PG8_LDB(B0, 1, 0); PG8_SCHED; PG8_LDA(At, 1, 0); PG8_STAGE(PG8_SA(0, 1), a2 + hstepA, voffA);
            PG8_WAIT_L(8); PG8_BAR; PG8_WAIT_L(0); PG8_MMA(0, 0, At, B0); PG8_BAR; PG8_SCHED;
            PG8_LDB(B1, 1, 1); PG8_STAGE(PG8_SB(1, 0), b3, voffB);
            PG8_BAR; PG8_WAIT_L(0); PG8_MMA(0, 1, At, B1); PG8_BAR;
            PG8_LDA(At, 1, 1); PG8_STAGE(PG8_SA(1, 0), a3, voffA);
            PG8_BAR; PG8_WAIT_L(0); PG8_MMA(1, 0, At, B0); PG8_BAR; PG8_SCHED;
            PG8_STAGE(PG8_SB(1, 1), b3 + hstepB, voffB);
            PG8_WAIT_V(6); PG8_BAR; PG8_MMA(1, 1, At, B1); PG8_BAR;
            }
        }
        if constexpr (ALIGN_EPI) { if (wr == 0) PG8_BAR; }
        if constexpr (!Epi::AFTER_DRAIN) { E(acc, cur, wr, wc, fr, fq); S.done(cur); }
        if (!has_next) break;
#pragma unroll
        for (int a = 0; a < 2; ++a)
#pragma unroll
            for (int b = 0; b < 2; ++b)
#pragma unroll
                for (int m = 0; m < 4; ++m)
#pragma unroll
                    for (int n = 0; n < 2; ++n) acc[a][b][m][n] = (f32x4){0.f, 0.f, 0.f, 0.f};
        cur = nxt; cA = nA; cB = nB; ++ui;
        if constexpr (ALIGN_EPI) { if (wr == 1) PG8_BAR; }
    }
    PG8_WAIT_V(0);
    if constexpr (!ALIGN_EPI) { if (wr == 0) PG8_BAR; }
    PG8_BAR;
    if constexpr (Epi::AFTER_DRAIN) { E.fused(acc, cur, wr, wc, fr, fq, lds, wid, lane); S.done(cur); }
#undef PG8_SA
#undef PG8_SB
#undef PG8_STAGE
#undef PG8_LDA
#undef PG8_LDB
#undef PG8_MMA
#undef PG8_WAIT_V
#undef PG8_WAIT_L
#undef PG8_BAR
#undef PG8_SCHED
}
}
#define LAS __attribute__((address_space(3)))
#define DI __device__ __forceinline__
typedef unsigned short bf16;
typedef unsigned v4u __attribute__((ext_vector_type(4)));
typedef unsigned v2u __attribute__((ext_vector_type(2)));
typedef float f32x4 __attribute__((ext_vector_type(4)));
typedef short bf16x8 __attribute__((ext_vector_type(8)));
constexpr int NTHREADS = 512, NWAVES = 8;
constexpr int D = 1024, NREAL = 16384, MROWS = 16640, LSEQ = 8208, FF = 4096, DIN = 5664, NCHUNK = 129;
constexpr int LDG = 8320, KH = 2176;
constexpr size_t MiB = 1u << 20;
constexpr size_t WS_PART1 = 0;
constexpr size_t WS_ALL = 1 * MiB;
constexpr size_t WS_WOT = 46 * MiB, WS_WFT = 48 * MiB, WS_WOUTT = 49 * MiB, WS_W1T = 51 * MiB, WS_W2T = 59 * MiB;
constexpr size_t WS_TAB = 67 * MiB + 512 * 1024;
constexpr size_t WS_CS = 69 * MiB;
constexpr size_t WS_GT2 = 137 * MiB;
constexpr size_t WS_EOT = 169 * MiB + 512 * 1024;
constexpr size_t WS_REMP = 186 * MiB + 512 * 1024;
constexpr size_t WS_PQ = 189 * MiB;
constexpr size_t WS_K = 221 * MiB;
constexpr size_t WS_R = 237 * MiB + 512 * 1024;
constexpr size_t WS_FN = 240 * MiB;
constexpr size_t DO_V = 0, DO_Q = 33 * MiB, DO_OB = 0;
constexpr size_t WS_REC = 69 * MiB;
constexpr size_t REC_BYTES = 43008, REC_KDT = 16384, REC_PM = 32768, REC_DEC = 40960;
constexpr size_t WS_QI_UNUSED = 69 * MiB;
constexpr size_t WS_KDT = 102 * MiB;
constexpr size_t WS_VT = 153 * MiB + 768 * 1024;
constexpr size_t WS_PM = 168 * MiB;
constexpr size_t WS_DEC = 184 * MiB + 512 * 1024;
constexpr size_t WS_OF = 189 * MiB;
constexpr size_t WS_ON = 69 * MiB, WS_SGA = 101 * MiB, WS_SGF = 133 * MiB, WS_OG = 165 * MiB, WS_MG = 197 * MiB;
constexpr size_t WS_H1B = 69 * MiB, WS_HF = 101 * MiB;
constexpr size_t WS_H2B = 1 * MiB;
constexpr size_t WS_BAR_OFF = 239 * MiB + 768 * 1024;
constexpr int LDS_BYTES = 155648;
struct Args {
    const float *x, *meta, *norm_mix, *w_in, *wdf, *bdf, *wdb, *bdb, *gla_norm, *w_o, *w_fnet, *w_out, *norm_ffn, *w_ff1, *w_ff2, *norm_final;
    float* out; unsigned char* ws; int ph_lo, ph_hi;
};
DI unsigned f2bf(float f) { unsigned u = __builtin_bit_cast(unsigned, f); return (u + 0x7fffu + ((u >> 16) & 1u)) >> 16; }
DI unsigned pk2(float lo, float hi) { return f2bf(lo) | (f2bf(hi) << 16); }
typedef float f32x2_t __attribute__((ext_vector_type(2)));
typedef __bf16 bf16x2_t __attribute__((ext_vector_type(2)));
DI unsigned cvtpk(float lo, float hi) { f32x2_t v = {lo, hi}; bf16x2_t b = __builtin_convertvector(v, bf16x2_t); return __builtin_bit_cast(unsigned, b); }
DI float bf2f(unsigned h) { return __uint_as_float(h << 16); }
DI float wave_sum(float v) {
#pragma unroll
    for (int o = 1; o < 64; o <<= 1) v += __shfl_xor(v, o);
    return v;
}
DI void transpose_item(const float* W, int pitch, int K, int ncols, bf16* WT, int row_off, LAS float* scr, int item, int lane, const float* kscale, int ldo = 0) {
    if (ldo == 0) ldo = K;
    const int nblk = ncols / 32, kb = item / nblk, nb = item % nblk, k0 = 64 * kb, n0 = 32 * nb;
#pragma unroll 8
    for (int i = 0; i < 32; ++i) { const int kk = 2 * i + (lane >> 5); float v = W[(size_t)(k0 + kk) * pitch + n0 + (lane & 31)]; if (kscale) v *= kscale[k0 + kk]; scr[kk * 33 + (lane & 31)] = v; }
    asm volatile("s_waitcnt lgkmcnt(0)" ::: "memory");
    const int c = lane & 7;
#pragma unroll
    for (int j = 0; j < 4; ++j) { const int n = (lane >> 3) + 8 * j; const LAS float* s = scr + (8 * c) * 33 + n;
        v4u o; o.x = pk2(s[0 * 33], s[1 * 33]); o.y = pk2(s[2 * 33], s[3 * 33]); o.z = pk2(s[4 * 33], s[5 * 33]); o.w = pk2(s[6 * 33], s[7 * 33]);
        *(v4u*)(WT + (size_t)(row_off + n0 + n) * ldo + k0 + 8 * c) = o; }
    asm volatile("s_waitcnt lgkmcnt(0)" ::: "memory");
}
DI void rms_row_to_bf16(const float* xrow, const float* gain, bf16* orow, int lane) {
    const f32x4* xr = (const f32x4*)xrow + lane; const f32x4* gr = (const f32x4*)gain + lane;
    f32x4 v[4]; float s = 0.f;
#pragma unroll
    for (int j = 0; j < 4; ++j) { v[j] = xr[64 * j]; s += (v[j].x * v[j].x + v[j].y * v[j].y) + (v[j].z * v[j].z + v[j].w * v[j].w); }
    const float rstd = 1.f / sqrtf(wave_sum(s) * (1.f / 1024.f) + 1e-6f);
    unsigned long long* o8 = (unsigned long long*)orow + lane;
#pragma unroll
    for (int j = 0; j < 4; ++j) { const f32x4 g = gr[64 * j];
        o8[64 * j] = (unsigned long long)pk2(v[j].x * rstd * g.x, v[j].y * rstd * g.y) | ((unsigned long long)pk2(v[j].z * rstd * g.z, v[j].w * rstd * g.w) << 32); }
}

DI void gen_cs_tab(const Args& a, LAS unsigned char* lds, int tid, int vbi, int nb) {
    unsigned char* ws = a.ws;
    const int gt = vbi * NTHREADS + tid, NGT = nb * NTHREADS;
    LAS float* tabc = (LAS float*)lds; LAS float* tabs = tabc + LSEQ;
    __syncthreads();
    for (int j = tid; j < LSEQ; j += NTHREADS) { const float ang = 6.283185307179586f * (float)j / (float)LSEQ; tabc[j] = __cosf(ang); tabs[j] = __sinf(ang); }
    __syncthreads();
    {
        bf16* CS = (bf16*)(ws + WS_CS);
        const int nchunk = 4 * 4096 * (KH / 8);
        for (int ch = gt; ch < nchunk; ch += NGT) {
            const int k8 = ch % (KH / 8); const int rest = ch / (KH / 8); const int idx = rest & 4095, grp = rest >> 12, cs = grp >> 1, kh = grp & 1;
            const int m = idx + 9, l0 = kh * KH + k8 * 8;
            unsigned j = ((unsigned)l0 * (unsigned)m) % (unsigned)LSEQ;
            float v[8];
#pragma unroll
            for (int e = 0; e < 8; ++e) { v[e] = (l0 + e <= 4104) ? (cs ? tabs[j] : tabc[j]) : 0.f; j += m; if (j >= (unsigned)LSEQ) j -= LSEQ; }
            v4u o; o.x = pk2(v[0], v[1]); o.y = pk2(v[2], v[3]); o.z = pk2(v[4], v[5]); o.w = pk2(v[6], v[7]);
            *(v4u*)(CS + (size_t)ch * 8) = o;
        }
        bf16* TAB = (bf16*)(ws + WS_TAB);
        const int nch2 = 32 * 2 * (LDG / 8);
        for (int ch = gt; ch < nch2; ch += NGT) {
            const int l8 = ch % (LDG / 8); const int rest = ch / (LDG / 8); const int cs = rest & 1, rho = rest >> 1;
            const int lp = 8200 + rho, l0 = l8 * 8;
            unsigned j = ((unsigned)l0 * (unsigned)lp) % (unsigned)LSEQ;
            float v[8];
#pragma unroll
            for (int e = 0; e < 8; ++e) { v[e] = (rho < 8 && l0 + e < LSEQ) ? (cs ? -tabs[j] : tabc[j]) : 0.f; j += lp; while (j >= (unsigned)LSEQ) j -= LSEQ; }
            v4u o; o.x = pk2(v[0], v[1]); o.y = pk2(v[2], v[3]); o.z = pk2(v[4], v[5]); o.w = pk2(v[6], v[7]);
            *(v4u*)(TAB + (size_t)ch * 8) = o;
        }
    }
    __syncthreads();
}

DI void p0_prologue(const Args& a, LAS unsigned char* lds, int tid, int lane, int wave, int bid, int G) {
    unsigned char* ws = a.ws;
    bf16* ALL = (bf16*)(ws + WS_ALL);
    const int gw = bid * NWAVES + wave, NGW = G * NWAVES;
    const int gt = bid * NTHREADS + tid, NGT = G * NTHREADS;
    {
        LAS float* Wl = (LAS float*)lds;
        LAS float* c128 = Wl + 64 * 128; LAS float* s128 = c128 + 128;
        if (tid < 128) { const float ang = 6.283185307179586f * (float)tid / 128.f; c128[tid] = __cosf(ang); s128[tid] = __sinf(ang); }
        for (int item = bid; item < 256; item += G) {
            const int kb = item >> 4, g = (item >> 2) & 3, nq = item & 3;
            __syncthreads();
            for (int idx = tid; idx < 64 * 128; idx += NTHREADS) { const int kk = idx >> 7, c = idx & 127; Wl[idx] = a.w_in[(size_t)(kb * 64 + kk) * DIN + 3104 + g * 128 + c]; }
            __syncthreads();
            const int n = nq * 32 + (tid & 31), kg = tid >> 5;
            float ac[4] = {0.f, 0.f, 0.f, 0.f}, as[4] = {0.f, 0.f, 0.f, 0.f};
            const LAS float* w0 = Wl + (kg * 4) * 128;
#pragma unroll 4
            for (int c = 0; c < 128; ++c) { const int j = (c * n) & 127; const float cc = c128[j], ss = s128[j];
#pragma unroll
                for (int q = 0; q < 4; ++q) { const float w = w0[q * 128 + c]; ac[q] += w * cc; as[q] += w * ss; } }
            bf16* dc = ALL + (size_t)(74 * 256 + g * 128 + n) * D + kb * 64 + kg * 4;
            bf16* ds = ALL + (size_t)(76 * 256 + g * 128 + n) * D + kb * 64 + kg * 4;
            *(v2u*)dc = (v2u){pk2(ac[0], ac[1]), pk2(ac[2], ac[3])}; *(v2u*)ds = (v2u){pk2(as[0], as[1]), pk2(as[2], as[3])};
        }
        __syncthreads();
    }
    {
        LAS float* scr = (LAS float*)(lds + wave * 16384);
        bf16* WT = ALL + (size_t)65 * 256 * D;
        const int I_Q = 16 * 16, I_V = 16 * 32, I_R = 16 * 1, I_G = 16 * 32;
        const int I_O = 16 * 32, I_F = 8 * 32, I_1 = 16 * 128, I_2 = 64 * 32;
        const int NIT = 2 * I_Q + I_V + I_R + 3 * I_G + 2 * I_O + I_F + I_1 + I_2;
        for (int it = gw; it < NIT; it += NGW) {
            int r = it;
            if (r < I_Q) { transpose_item(a.w_in + 0, DIN, D, 512, WT, 0, scr, r, lane, nullptr); continue; } r -= I_Q;
            if (r < I_Q) { transpose_item(a.w_in + 512, DIN, D, 512, WT, 512, scr, r, lane, nullptr); continue; } r -= I_Q;
            if (r < I_V) { transpose_item(a.w_in + 1024, DIN, D, 1024, WT, 1024, scr, r, lane, nullptr); continue; } r -= I_V;
            if (r < I_R) { transpose_item(a.w_in + 3072, DIN, D, 32, WT, 2048, scr, r, lane, nullptr); continue; } r -= I_R;
            if (r < I_G) { transpose_item(a.w_in + 2048, DIN, D, 1024, WT, 13 * 256, scr, r, lane, nullptr); continue; } r -= I_G;
            if (r < I_G) { transpose_item(a.w_in + 3616, DIN, D, 1024, WT, 17 * 256, scr, r, lane, nullptr); continue; } r -= I_G;
            if (r < I_G) { transpose_item(a.w_in + 4640, DIN, D, 1024, WT, 21 * 256, scr, r, lane, nullptr); continue; } r -= I_G;
            if (r < I_O) { transpose_item(a.w_o, D, D, 1024, (bf16*)(ws + WS_WOT), 0, scr, r, lane, nullptr); continue; } r -= I_O;
            if (r < I_O) { transpose_item(a.w_out, D, D, 1024, (bf16*)(ws + WS_WOUTT), 0, scr, r, lane, nullptr); continue; } r -= I_O;
            if (r < I_F) { transpose_item(a.w_fnet, D, 512, 1024, (bf16*)(ws + WS_WFT), 0, scr, r, lane, nullptr); continue; } r -= I_F;
            if (r < I_1) { transpose_item(a.w_ff1, FF, D, FF, (bf16*)(ws + WS_W1T), 0, scr, r, lane, a.norm_ffn); continue; } r -= I_1;
            transpose_item(a.w_ff2, D, FF, 1024, (bf16*)(ws + WS_W2T), 0, scr, r, lane, nullptr, 4224);
        }
    }
    {
        bf16* t8 = ALL + (size_t)(73 * 256 + 32) * D;
        for (int i = gt; i < 224 * D / 8; i += NGT) *(v4u*)(t8 + (size_t)i * 8) = (v4u){0u, 0u, 0u, 0u};
        bf16* x64 = ALL + (size_t)16384 * D;
        for (int i = gt; i < 256 * D / 8; i += NGT) { const int row = i / (D / 8); if (row < 48 || row >= 64) *(v4u*)(x64 + (size_t)i * 8) = (v4u){0u, 0u, 0u, 0u}; }
        bf16* GT2 = (bf16*)(ws + WS_GT2);
        for (int i = gt; i < 2048 * 14; i += NGT) { const int row = i / 14, c = i % 14; *(v4u*)(GT2 + (size_t)row * LDG + LSEQ + c * 8) = (v4u){0u, 0u, 0u, 0u}; }
    }
    for (int m = gw; m < NREAL + 16; m += NGW) {
        if (m < NREAL) rms_row_to_bf16(a.x + (size_t)m * D, a.norm_mix, ALL + (size_t)m * D, lane);
        else rms_row_to_bf16(a.meta + (size_t)(m - NREAL) * D, a.norm_mix, ALL + (size_t)(NREAL + 48 + (m - NREAL)) * D, lane);
    }
}
DI void p2_sym_rem(const Args& a, int tid, int lane, int wave, int bid, int G) {
    unsigned char* ws = a.ws;
    const bf16* GT2 = (const bf16*)(ws + WS_GT2);
    bf16* EOT = (bf16*)(ws + WS_EOT);
    const int gt = bid * NTHREADS + tid, NGT = G * NTHREADS;
    const int nchunk = 4 * 1024 * (KH / 8);
    for (int ch = gt; ch < nchunk; ch += NGT) {
        const int k8 = ch % (KH / 8); const int rest = ch / (KH / 8); const int n = rest & 1023, grp = rest >> 10, cs = grp >> 1, kh = grp & 1;
        const int l0 = kh * KH + k8 * 8;
        const bf16* src = GT2 + ((size_t)n * 2 + cs) * LDG;
        float v[8];
        if (l0 > 4104) {
#pragma unroll
            for (int e = 0; e < 8; ++e) v[e] = 0.f;
        } else {
            const v4u f = *(const v4u*)(src + l0);
            const float fw[8] = {bf2f(f.x & 0xffffu), bf2f(f.x >> 16), bf2f(f.y & 0xffffu), bf2f(f.y >> 16), bf2f(f.z & 0xffffu), bf2f(f.z >> 16), bf2f(f.w & 0xffffu), bf2f(f.w >> 16)};
            const v4u mch = *(const v4u*)(src + (LSEQ - 8 - l0));
            const float mw[8] = {bf2f(mch.x & 0xffffu), bf2f(mch.x >> 16), bf2f(mch.y & 0xffffu), bf2f(mch.y >> 16), bf2f(mch.z & 0xffffu), bf2f(mch.z >> 16), bf2f(mch.w & 0xffffu), bf2f(mch.w >> 16)};
            const float m0 = (l0 == 0) ? 0.f : bf2f((unsigned)src[LSEQ - l0]);
#pragma unroll
            for (int e = 0; e < 8; ++e) { const int l = l0 + e;
                if (l > 4104) v[e] = 0.f;
                else if (l == 0 || l == 4104) v[e] = cs ? 0.f : fw[e];
                else { const float mir = (e == 0) ? m0 : mw[8 - e]; v[e] = cs ? fw[e] - mir : fw[e] + mir; } }
        }
        v4u o; o.x = pk2(v[0], v[1]); o.y = pk2(v[2], v[3]); o.z = pk2(v[4], v[5]); o.w = pk2(v[6], v[7]);
        *(v4u*)(EOT + (size_t)ch * 8) = o;
    }
    typedef float f32x16 __attribute__((ext_vector_type(16)));
    const bf16* TAB = (const bf16*)(ws + WS_TAB);
    float* REMP = (float*)(ws + WS_REMP);
    const int gw = bid * NWAVES + wave, NGW = G * NWAVES;
    for (int task = gw; task < 32 * 65; task += NGW) {
        const int nt = task & 31, ks = task >> 5; const int r = lane & 31, h = lane >> 5;
        f32x16 acc; for (int i = 0; i < 16; ++i) acc[i] = 0.f;
        const bf16* ap = TAB + (size_t)r * (2 * LDG) + ks * 256 + 8 * h;
        const bf16* bp = GT2 + (size_t)(nt * 32 + r) * (2 * LDG) + ks * 256 + 8 * h;
#pragma unroll 4
        for (int kk = 0; kk < 16; ++kk) { const bf16x8 af = *(const bf16x8*)(ap + kk * 16), bfr = *(const bf16x8*)(bp + kk * 16);
            acc = __builtin_amdgcn_mfma_f32_32x32x16_bf16(af, bfr, acc, 0, 0, 0); }
#pragma unroll
        for (int i = 0; i < 4; ++i) REMP[((size_t)ks * 8 + i + 4 * h) * 1024 + nt * 32 + r] = acc[i];
    }
}

DI void p4_combine(const Args& a, int tid, int bid, int G) {
    unsigned char* ws = a.ws;
    const bf16* PQ = (const bf16*)(ws + WS_PQ); const float* REMP = (const float*)(ws + WS_REMP); bf16* FN = (bf16*)(ws + WS_FN);
    const float scale = 0.0009756003f;
    const int nb5 = (G == 256) ? 8 : 0;
    if (bid < nb5) return;
    const int gt = (bid - nb5) * NTHREADS + tid, NGT = (G - nb5) * NTHREADS;
    for (int ch = gt; ch < NREAL * 64; ch += NGT) {
        const int c8 = ch & 63, row = ch >> 6, b = row >> 13, s = row & 8191, l = s + 16, n = b * 512 + c8 * 8;
        float v[8];
        if (l >= 8200) { const int rho = l - 8200;
#pragma unroll
            for (int e = 0; e < 8; ++e) v[e] = 0.f;
            for (int ks = 0; ks < 65; ++ks) { const f32x4 p0 = *(const f32x4*)(REMP + ((size_t)ks * 8 + rho) * 1024 + n), p1 = *(const f32x4*)(REMP + ((size_t)ks * 8 + rho) * 1024 + n + 4);
                v[0] += p0[0]; v[1] += p0[1]; v[2] += p0[2]; v[3] += p0[3]; v[4] += p1[0]; v[5] += p1[1]; v[6] += p1[2]; v[7] += p1[3]; }
        } else {
            const bool mir = l > 4104; const int idx = (mir ? LSEQ - l : l) - 9; const float sg = mir ? 1.f : -1.f;
            const size_t off = (size_t)idx * 1024 + n;
            const v4u p0 = *(const v4u*)(PQ + off), p1 = *(const v4u*)(PQ + (size_t)4096 * 1024 + off), q0 = *(const v4u*)(PQ + (size_t)2 * 4096 * 1024 + off), q1 = *(const v4u*)(PQ + (size_t)3 * 4096 * 1024 + off);
            const unsigned pp0[4] = {p0.x, p0.y, p0.z, p0.w}, pp1[4] = {p1.x, p1.y, p1.z, p1.w}, qq0[4] = {q0.x, q0.y, q0.z, q0.w}, qq1[4] = {q1.x, q1.y, q1.z, q1.w};
#pragma unroll
            for (int e = 0; e < 4; ++e) {
                v[2 * e] = (bf2f(pp0[e] & 0xffffu) + bf2f(pp1[e] & 0xffffu)) + sg * (bf2f(qq0[e] & 0xffffu) + bf2f(qq1[e] & 0xffffu));
                v[2 * e + 1] = (bf2f(pp0[e] >> 16) + bf2f(pp1[e] >> 16)) + sg * (bf2f(qq0[e] >> 16) + bf2f(qq1[e] >> 16)); }
        }
        v4u o; o.x = pk2(v[0] * scale, v[1] * scale); o.y = pk2(v[2] * scale, v[3] * scale); o.z = pk2(v[4] * scale, v[5] * scale); o.w = pk2(v[6] * scale, v[7] * scale);
        *(v4u*)(FN + (size_t)row * 512 + c8 * 8) = o;
    }
}

DI void p6_post(const Args& a, int lane, int wave, int bid, int G) {
    unsigned char* ws = a.ws;
    const bf16* OF = (const bf16*)(ws + WS_OF); const bf16* OB = (const bf16*)((unsigned char*)a.out + DO_OB); bf16* ON = (bf16*)(ws + WS_ON);
    const int gw = bid * NWAVES + wave, NGW = G * NWAVES;
    const int c0 = lane * 16;
    float gn[16];
#pragma unroll
    for (int e = 0; e < 16; ++e) gn[e] = a.gla_norm[(c0 & 255) + e];
    for (int row = gw; row < NREAL; row += NGW) {
        const size_t off = (size_t)row * 1024 + c0;
        const v4u f0 = *(const v4u*)(OF + off), f1 = *(const v4u*)(OF + off + 8), b0 = *(const v4u*)(OB + off), b1 = *(const v4u*)(OB + off + 8);
        const unsigned fw[8] = {f0.x, f0.y, f0.z, f0.w, f1.x, f1.y, f1.z, f1.w}, bw[8] = {b0.x, b0.y, b0.z, b0.w, b1.x, b1.y, b1.z, b1.w};
        float v[16]; float ss = 0.f;
#pragma unroll
        for (int e = 0; e < 8; ++e) { v[2 * e] = bf2f(fw[e] & 0xffffu) + bf2f(bw[e] & 0xffffu); v[2 * e + 1] = bf2f(fw[e] >> 16) + bf2f(bw[e] >> 16); ss += v[2 * e] * v[2 * e] + v[2 * e + 1] * v[2 * e + 1]; }
        ss += __shfl_xor(ss, 1); ss += __shfl_xor(ss, 2); ss += __shfl_xor(ss, 4); ss += __shfl_xor(ss, 8);
        const float rstd = 1.f / sqrtf(ss * (1.f / 256.f) + 1e-6f);
        unsigned w[8];
#pragma unroll
        for (int e = 0; e < 8; ++e) w[e] = pk2(v[2 * e] * rstd * gn[2 * e], v[2 * e + 1] * rstd * gn[2 * e + 1]);
        *(v4u*)(ON + off) = (v4u){w[0], w[1], w[2], w[3]}; *(v4u*)(ON + off + 8) = (v4u){w[4], w[5], w[6], w[7]};
    }
}

DI void p11_final(const Args& a, int lane, int wave, int bid, int G) {
    const int gw = bid * NWAVES + wave, NGW = G * NWAVES;
    const bf16* H2B = (const bf16*)(a.ws + WS_H2B); const float* PART = (const float*)(a.ws + WS_PART1);
    f32x4 gn[2][2];
#pragma unroll
    for (int j = 0; j < 2; ++j) { gn[j][0] = *(const f32x4*)(a.norm_final + j * 512 + lane * 8); gn[j][1] = *(const f32x4*)(a.norm_final + j * 512 + lane * 8 + 4); }
    for (int row = gw; row < NREAL; row += NGW) {
        const float* pp = PART + (size_t)row * 16; float s = 0.f;
#pragma unroll
        for (int t = 0; t < 4; ++t) { const f32x4 q4 = *(const f32x4*)(pp + 4 * t); s += (q4[0] + q4[1]) + (q4[2] + q4[3]); }
        const float rstd = 1.f / sqrtf(s * (1.f / 1024.f) + 1e-6f);
#pragma unroll
        for (int j = 0; j < 2; ++j) { const v4u w = *(const v4u*)(H2B + (size_t)row * D + j * 512 + lane * 8);
            float* o = a.out + (size_t)row * D + j * 512 + lane * 8;
            *(f32x4*)o = (f32x4){bf2f(w.x & 0xffffu) * rstd * gn[j][0][0], bf2f(w.x >> 16) * rstd * gn[j][0][1], bf2f(w.y & 0xffffu) * rstd * gn[j][0][2], bf2f(w.y >> 16) * rstd * gn[j][0][3]};
            *(f32x4*)(o + 4) = (f32x4){bf2f(w.z & 0xffffu) * rstd * gn[j][1][0], bf2f(w.z >> 16) * rstd * gn[j][1][1], bf2f(w.w & 0xffffu) * rstd * gn[j][1][2], bf2f(w.w >> 16) * rstd * gn[j][1][3]}; }
    }
}
DI float logsig(float x) { return fminf(x, 0.f) - __logf(1.f + __expf(-fabsf(x))); }
DI size_t tile_idx(int dir, int b, int h, int c) { return (size_t)((dir * 2 + b) * 4 + h) * NCHUNK + c; }
DI void p4_gla_prep(const Args& a, LAS unsigned char* lds, int tid, int lane, int wave, int bid, int G) {
    unsigned char* ws = a.ws;
    const bf16* Qg = (const bf16*)((unsigned char*)a.out + DO_Q); const bf16* Kg = (const bf16*)(ws + WS_K); const bf16* Vg = (const bf16*)((unsigned char*)a.out + DO_V);
    const float* Rg = (const float*)(ws + WS_R);
    unsigned char* REC = ws + WS_REC; bf16* VT = (bf16*)(ws + WS_VT);
    LAS float* BF = (LAS float*)lds; LAS float* BB = BF + 64 * 128;
    LAS unsigned char* QF = lds + 65536; LAS unsigned char* KF = QF + 17408; LAS unsigned char* QB = KF + 17408; LAS unsigned char* KB = QB + 17408;
    LAS unsigned char* KRAW = lds + 135168;
    LAS float* RS = (LAS float*)QF; LAS float* WD = RS + 64 * 32;
    LAS unsigned char* VS = lds;
    f32x4 rq; v4u q8p[2], k8p[2], v8p[4];
#define PREP_ROW0(t) ((((t) >> 2) % NCHUNK == 0) ? NREAL : ((t) >> 2) / NCHUNK * 8192 + 64 * ((((t) >> 2) % NCHUNK) - 1))
#define PREP_LOAD_QKR(t) do { const int r0_ = PREP_ROW0(t), h_ = (t) & 3; rq = *(const f32x4*)(Rg + (size_t)r0_ * 32 + tid * 4); \
        _Pragma("unroll") for (int rep = 0; rep < 2; ++rep) { const int g_ = tid + NTHREADS * rep, i_ = g_ >> 4, d0_ = (g_ & 15) * 8; \
            q8p[rep] = *(const v4u*)(Qg + (size_t)(r0_ + i_) * 512 + h_ * 128 + d0_); k8p[rep] = *(const v4u*)(Kg + (size_t)(r0_ + i_) * 512 + h_ * 128 + d0_); } } while (0)
#define PREP_LOAD_V(t) do { const int r0_ = PREP_ROW0(t), h_ = (t) & 3; \
        _Pragma("unroll") for (int rep = 0; rep < 4; ++rep) { const int idx_ = tid + NTHREADS * rep, i_ = idx_ >> 5, u_ = idx_ & 31; v8p[rep] = *(const v4u*)(Vg + (size_t)(r0_ + i_) * 1024 + h_ * 256 + u_ * 8); } } while (0)
    bf16x8 wfh = {}, wbh = {}; float bfw = 0.f, bbw = 0.f; int hload = -1;
    if (bid < 2 * NCHUNK * 4) { PREP_LOAD_QKR(bid); PREP_LOAD_V(bid); }
    for (int task = bid; task < 2 * NCHUNK * 4; task += G) {
        const int h = task & 3, c = (task >> 2) % NCHUNK, b = (task >> 2) / NCHUNK;
        const int row0 = (c == 0) ? NREAL : b * 8192 + 64 * (c - 1);
        const bool has_next = task + G < 2 * NCHUNK * 4;
        {
            const int fr = lane & 15, g = lane >> 4, dcol = 16 * wave + fr;
            if (h != hload) {
                float wv[8];
#pragma unroll
                for (int e = 0; e < 8; ++e) wv[e] = (g < 2) ? a.wdf[(8 * g + e) * 512 + h * 128 + dcol] : a.wdb[(8 * (g - 2) + e) * 512 + h * 128 + dcol];
                const v4u z4 = {0u, 0u, 0u, 0u}, vh = {pk2(wv[0], wv[1]), pk2(wv[2], wv[3]), pk2(wv[4], wv[5]), pk2(wv[6], wv[7])};
                wfh = __builtin_bit_cast(bf16x8, g < 2 ? vh : z4); wbh = __builtin_bit_cast(bf16x8, g < 2 ? z4 : vh);
                bfw = a.bdf[h * 128 + dcol]; bbw = a.bdb[h * 128 + dcol]; hload = h; }
            *(LAS f32x4*)(RS + tid * 4) = rq;
            __syncthreads();
#pragma unroll 1
            for (int dirp = 0; dirp < 2; ++dirp) {
                const bf16x8 wh = dirp ? wbh : wfh; const float bias = dirp ? bbw : bfw;
                LAS float* BX = dirp ? BB : BF;
                float offs = 0.f;
#pragma unroll 1
                for (int tt = 0; tt < 4; ++tt) {
                    const int t = dirp ? 3 - tt : tt;
                    const LAS float* rp = RS + (16 * t + fr) * 32 + 8 * g;
                    const f32x4 r0 = *(const LAS f32x4*)rp, r1 = *(const LAS f32x4*)(rp + 4);
                    const float rv[8] = {r0[0], r0[1], r0[2], r0[3], r1[0], r1[1], r1[2], r1[3]};
                    unsigned hi[4], lo[4];
#pragma unroll
                    for (int e2 = 0; e2 < 4; ++e2) { const float h0 = bf2f(f2bf(rv[2 * e2])), h1 = bf2f(f2bf(rv[2 * e2 + 1])); hi[e2] = pk2(h0, h1); lo[e2] = pk2(rv[2 * e2] - h0, rv[2 * e2 + 1] - h1); }
                    f32x4 acc = {0.f, 0.f, 0.f, 0.f};
                    acc = __builtin_amdgcn_mfma_f32_16x16x32_bf16(__builtin_bit_cast(bf16x8, (v4u){hi[0], hi[1], hi[2], hi[3]}), wh, acc, 0, 0, 0);
                    acc = __builtin_amdgcn_mfma_f32_16x16x32_bf16(__builtin_bit_cast(bf16x8, (v4u){lo[0], lo[1], lo[2], lo[3]}), wh, acc, 0, 0, 0);
                    float la[4];
#pragma unroll
                    for (int i = 0; i < 4; ++i) { const bool padrow = (c == 0) && (16 * t + 4 * g + i < 48); la[i] = padrow ? 0.f : logsig(acc[i] + bias) * 0.0625f; }
                    float T, inc;
                    if (dirp == 0) {
                        la[1] += la[0]; la[2] += la[1]; la[3] += la[2]; T = la[3];
                        const float u1 = __shfl_up(T, 16); const float s1 = T + (g >= 1 ? u1 : 0.f);
                        const float u2 = __shfl_up(s1, 32); inc = s1 + (g >= 2 ? u2 : 0.f);
                    } else {
                        la[2] += la[3]; la[1] += la[2]; la[0] += la[1]; T = la[0];
                        const float u1 = __shfl_down(T, 16); const float s1 = T + (g <= 2 ? u1 : 0.f);
                        const float u2 = __shfl_down(s1, 32); inc = s1 + (g <= 1 ? u2 : 0.f);
                    }
                    const float base = offs + (inc - T);
#pragma unroll
                    for (int i = 0; i < 4; ++i) BX[(16 * t + 4 * g + i) * 128 + dcol] = base + la[i];
                    offs += __shfl(inc, dirp ? fr : fr + 48);
                }
                if (g == 0) ((float*)(REC + tile_idx(dirp, b, h, c) * REC_BYTES + REC_DEC))[dcol] = __expf(offs);
            }
        }
        __syncthreads();
#pragma unroll
        for (int rep = 0; rep < 2; ++rep) {
            const int g = tid + NTHREADS * rep, i = g >> 4, d0 = (g & 15) * 8;
            const v4u q8 = q8p[rep], k8 = k8p[rep];
            *(LAS v4u*)(KRAW + i * 256 + d0 * 2) = k8;
            if (c == 0) continue;
            const unsigned qw[4] = {q8.x, q8.y, q8.z, q8.w}, kw[4] = {k8.x, k8.y, k8.z, k8.w};
            float qf[8], kf[8], qb[8], kb[8], qif[8], qib[8];
#pragma unroll
            for (int e = 0; e < 8; ++e) {
                const int d = d0 + e; const float q = bf2f((e & 1) ? (qw[e >> 1] >> 16) : (qw[e >> 1] & 0xffffu)), k = bf2f((e & 1) ? (kw[e >> 1] >> 16) : (kw[e >> 1] & 0xffffu));
                const float ef = BF[i * 128 + d], eb = BB[i * 128 + d], f31 = BF[31 * 128 + d], b32 = BB[32 * 128 + d];
                qf[e] = q * __expf(ef - f31); kf[e] = k * __expf(f31 - ef); qb[e] = q * __expf(eb - b32); kb[e] = k * __expf(b32 - eb);
                qif[e] = q * __expf(ef); qib[e] = q * __expf(eb);
            }
            *(LAS v4u*)(QF + i * 272 + d0 * 2) = (v4u){pk2(qf[0], qf[1]), pk2(qf[2], qf[3]), pk2(qf[4], qf[5]), pk2(qf[6], qf[7])};
            *(LAS v4u*)(KF + i * 272 + d0 * 2) = (v4u){pk2(kf[0], kf[1]), pk2(kf[2], kf[3]), pk2(kf[4], kf[5]), pk2(kf[6], kf[7])};
            *(LAS v4u*)(QB + i * 272 + d0 * 2) = (v4u){pk2(qb[0], qb[1]), pk2(qb[2], qb[3]), pk2(qb[4], qb[5]), pk2(qb[6], qb[7])};
            *(LAS v4u*)(KB + i * 272 + d0 * 2) = (v4u){pk2(kb[0], kb[1]), pk2(kb[2], kb[3]), pk2(kb[4], kb[5]), pk2(kb[6], kb[7])};
            const int kap = d0 >> 5, u = (d0 & 31) >> 3, g0 = 2 * (u & 1), e0 = 4 * (u >> 1);
            const size_t qoff = ((size_t)(((i >> 4) * 4 + kap) * 64 + g0 * 16 + (i & 15))) * 8 + e0;
            bf16* qi_f = (bf16*)(REC + tile_idx(0, b, h, c) * REC_BYTES) + qoff; bf16* qi_b = (bf16*)(REC + tile_idx(1, b, h, c) * REC_BYTES) + qoff;
            *(v2u*)qi_f = (v2u){pk2(qif[0], qif[1]), pk2(qif[2], qif[3])}; *(v2u*)(qi_f + 128) = (v2u){pk2(qif[4], qif[5]), pk2(qif[6], qif[7])};
            *(v2u*)qi_b = (v2u){pk2(qib[0], qib[1]), pk2(qib[2], qib[3])}; *(v2u*)(qi_b + 128) = (v2u){pk2(qib[4], qib[5]), pk2(qib[6], qib[7])};
        }
        if (has_next) PREP_LOAD_QKR(task + G);
        __syncthreads();
        if (c != 0) {
            const int dir = wave >> 2, tq = wave & 3, fr = lane & 15, g = lane >> 4;
            const LAS unsigned char* QX = dir ? QB : QF; const LAS unsigned char* KX = dir ? KB : KF;
            bf16x8 bq[4];
#pragma unroll
            for (int kap = 0; kap < 4; ++kap) bq[kap] = *(const LAS bf16x8*)(QX + (16 * tq + fr) * 272 + (32 * kap + 8 * g) * 2);
            bf16* pm = (bf16*)(REC + tile_idx(dir, b, h, c) * REC_BYTES + REC_PM);
            const int i = 16 * tq + fr;
#pragma unroll
            for (int tk = 0; tk < 4; ++tk) {
                f32x4 acc = {0.f, 0.f, 0.f, 0.f};
#pragma unroll
                for (int kap = 0; kap < 4; ++kap) { const bf16x8 af = *(const LAS bf16x8*)(KX + (16 * tk + fr) * 272 + (32 * kap + 8 * g) * 2);
                    acc = __builtin_amdgcn_mfma_f32_16x16x32_bf16(af, bq[kap], acc, 0, 0, 0); }
                float s[4];
#pragma unroll
                for (int e = 0; e < 4; ++e) { const int j = 16 * tk + 4 * g + e; const bool keep = dir ? (j >= i) : (j <= i); s[e] = keep ? acc[e] : 0.f; }
                *(v2u*)(pm + (size_t)((tq * 2 + (tk >> 1)) * 64 + (2 * (tk & 1) + (g >> 1)) * 16 + fr) * 8 + 4 * (g & 1)) = (v2u){pk2(s[0], s[1]), pk2(s[2], s[3])};
            }
        }
        {
            const int d = tid & 127, blk = tid >> 7, i0 = blk * 16;
            const float f63 = BF[63 * 128 + d], b0 = BB[d];
            unsigned wf[8], wb[8];
#pragma unroll
            for (int e2 = 0; e2 < 8; ++e2) {
                const int ia = i0 + 2 * e2, ib = ia + 1;
                const float ka = bf2f((unsigned)*(const LAS unsigned short*)(KRAW + ia * 256 + d * 2)), kb2 = bf2f((unsigned)*(const LAS unsigned short*)(KRAW + ib * 256 + d * 2));
                wf[e2] = pk2(ka * __expf(f63 - BF[ia * 128 + d]), kb2 * __expf(f63 - BF[ib * 128 + d]));
                wb[e2] = pk2(ka * __expf(b0 - BB[ia * 128 + d]), kb2 * __expf(b0 - BB[ib * 128 + d]));
            }
            const size_t koff = (size_t)((((d >> 4) * 2 + (blk >> 1)) * 64 + (2 * (blk & 1)) * 16 + (d & 15))) * 8;
            bf16* kf_ = (bf16*)(REC + tile_idx(0, b, h, c) * REC_BYTES + REC_KDT) + koff; bf16* kb_ = (bf16*)(REC + tile_idx(1, b, h, c) * REC_BYTES + REC_KDT) + koff;
            *(v4u*)kf_ = (v4u){wf[0], wf[1], wf[2], wf[3]}; *(v4u*)(kf_ + 128) = (v4u){wf[4], wf[5], wf[6], wf[7]};
            *(v4u*)kb_ = (v4u){wb[0], wb[1], wb[2], wb[3]}; *(v4u*)(kb_ + 128) = (v4u){wb[4], wb[5], wb[6], wb[7]};
        }
        __syncthreads();
#pragma unroll
        for (int rep = 0; rep < 4; ++rep) { const int idx = tid + NTHREADS * rep, i = idx >> 5, u = idx & 31;
            *(LAS v4u*)(VS + i * 528 + u * 16) = v8p[rep]; }
        if (has_next) PREP_LOAD_V(task + G);
        __syncthreads();
        {
            const int dv = tid & 255, half = tid >> 8; unsigned w[16];
#pragma unroll
            for (int e2 = 0; e2 < 16; ++e2) { const int ia = 32 * half + 2 * e2;
                w[e2] = (unsigned)*(const LAS unsigned short*)(VS + ia * 528 + dv * 2) | ((unsigned)*(const LAS unsigned short*)(VS + (ia + 1) * 528 + dv * 2) << 16); }
            bf16* vt = VT + ((size_t)(b * 4 + h) * NCHUNK + c) * 16384 + (size_t)((dv >> 4) * 2 + half) * 512 + (dv & 15) * 8;
#pragma unroll
            for (int q4 = 0; q4 < 4; ++q4) *(v4u*)(vt + q4 * 128) = (v4u){w[4 * q4], w[4 * q4 + 1], w[4 * q4 + 2], w[4 * q4 + 3]};
        }
        __syncthreads();
    }
}

constexpr int SX_SA = 0, SX_VX = 16384;
struct OSet { bf16x8 q[4], p[2]; };
struct SSet { bf16x8 k[4], v; f32x4 dc[2]; };
DI void o_load(OSet& x, const unsigned char* rec, int t, int lane) {
    const unsigned char* qb = rec + (t * 4 * 64 + lane) * 16;
#pragma unroll
    for (int kap = 0; kap < 4; ++kap) x.q[kap] = *(const bf16x8*)(qb + kap * 1024);
    const unsigned char* pb = rec + REC_PM + (t * 2 * 64 + lane) * 16;
    x.p[0] = *(const bf16x8*)pb; x.p[1] = *(const bf16x8*)(pb + 1024);
}
DI void s_load(SSet& x, const unsigned char* rec, const unsigned char* vt, int jj, int lane, int g) {
    const unsigned char* kb = rec + REC_KDT + (jj * 4 * 64 + lane) * 16;
#pragma unroll
    for (int f = 0; f < 4; ++f) x.k[f] = *(const bf16x8*)(kb + f * 1024);
    const unsigned char* db = rec + REC_DEC + (32 * jj + 4 * g) * 4;
    x.dc[0] = *(const f32x4*)db; x.dc[1] = *(const f32x4*)(db + 64);
    x.v = *(const bf16x8*)(vt + jj * 1024 + lane * 16);
}
DI void o_step(const OSet& x, const LAS unsigned char* sab, const LAS unsigned char* vxb, int lane, bf16* optr, bool st) {
    bf16x8 sa[2][4], v[2][2];
#pragma unroll
    for (int q = 0; q < 2; ++q) {
#pragma unroll
        for (int kap = 0; kap < 4; ++kap) sa[q][kap] = *(const LAS bf16x8*)(sab + (q * 4 + kap) * 1024 + lane * 16);
        v[q][0] = *(const LAS bf16x8*)(vxb + (q * 2) * 1024 + lane * 16); v[q][1] = *(const LAS bf16x8*)(vxb + (q * 2 + 1) * 1024 + lane * 16);
    }
    asm volatile("s_waitcnt lgkmcnt(0)" ::: "memory");
    f32x4 o0[2], o1[2];
#pragma unroll
    for (int q = 0; q < 2; ++q) { o0[q] = (f32x4){0.f, 0.f, 0.f, 0.f}; o1[q] = (f32x4){0.f, 0.f, 0.f, 0.f}; }
#pragma unroll
    for (int q = 0; q < 2; ++q) { o0[q] = __builtin_amdgcn_mfma_f32_16x16x32_bf16(v[q][0], x.p[0], o0[q], 0, 0, 0); o1[q] = __builtin_amdgcn_mfma_f32_16x16x32_bf16(v[q][1], x.p[1], o1[q], 0, 0, 0); }
#pragma unroll
    for (int kk = 0; kk < 2; ++kk)
#pragma unroll
        for (int q = 0; q < 2; ++q) { o0[q] = __builtin_amdgcn_mfma_f32_16x16x32_bf16(sa[q][2 * kk], x.q[2 * kk], o0[q], 0, 0, 0); o1[q] = __builtin_amdgcn_mfma_f32_16x16x32_bf16(sa[q][2 * kk + 1], x.q[2 * kk + 1], o1[q], 0, 0, 0); }
    if (st) {
#pragma unroll
        for (int q = 0; q < 2; ++q) { const f32x4 o = o0[q] + o1[q]; *(v2u*)(optr + 16 * q) = (v2u){cvtpk(o[0], o[1]), cvtpk(o[2], o[3])}; }
    }
}
DI void s_step(f32x4 (&S)[2][2], const SSet& x, const LAS unsigned char* vxb, LAS unsigned char* sab, int jj, int lane) {
    bf16x8 v[2][2];
#pragma unroll
    for (int q = 0; q < 2; ++q) { v[q][0] = *(const LAS bf16x8*)(vxb + (q * 2) * 1024 + lane * 16); v[q][1] = *(const LAS bf16x8*)(vxb + (q * 2 + 1) * 1024 + lane * 16); }
#pragma unroll
    for (int q = 0; q < 2; ++q) { S[q][0] = S[q][0] * x.dc[0]; S[q][1] = S[q][1] * x.dc[1]; }
    asm volatile("s_waitcnt lgkmcnt(0)" ::: "memory");
#pragma unroll
    for (int q = 0; q < 2; ++q) { S[q][0] = __builtin_amdgcn_mfma_f32_16x16x32_bf16(x.k[0], v[q][0], S[q][0], 0, 0, 0); S[q][1] = __builtin_amdgcn_mfma_f32_16x16x32_bf16(x.k[2], v[q][0], S[q][1], 0, 0, 0); }
#pragma unroll
    for (int q = 0; q < 2; ++q) { S[q][0] = __builtin_amdgcn_mfma_f32_16x16x32_bf16(x.k[1], v[q][1], S[q][0], 0, 0, 0); S[q][1] = __builtin_amdgcn_mfma_f32_16x16x32_bf16(x.k[3], v[q][1], S[q][1], 0, 0, 0); }
#pragma unroll
    for (int q = 0; q < 2; ++q)
        *(LAS v4u*)(sab + (q * 4 + jj) * 1024 + lane * 16) = (v4u){cvtpk(S[q][0][0], S[q][0][1]), cvtpk(S[q][0][2], S[q][0][3]), cvtpk(S[q][1][0], S[q][1][1]), cvtpk(S[q][1][2], S[q][1][3])};
}
DI void p5_scan_item(const Args& a, LAS unsigned char* lds, int lane, int wave, int item) {
    unsigned char* ws = a.ws;
    const unsigned char* REC = ws + WS_REC; const unsigned char* VT = ws + WS_VT;
    const int sl32 = item & 7, dir = (item >> 3) & 1, h = (item >> 4) & 3, b = item >> 6;
    bf16* O = dir ? (bf16*)((unsigned char*)a.out + DO_OB) : (bf16*)(ws + WS_OF);
    const size_t t0 = tile_idx(dir, b, h, 0); const size_t v0i = (size_t)(b * 4 + h) * NCHUNK;
    const int fr = lane & 15, g = lane >> 4;
#define SC_CS(step) (dir ? 128 - (step) : (step))
#define SC_REC(step) (REC + (t0 + SC_CS(step)) * REC_BYTES)
#define SC_VT(step) (VT + (v0i + SC_CS(step)) * 32768 + sl32 * 4096)
    __syncthreads();
    if (wave < 4) { *(LAS v4u*)(lds + SX_SA + 8192 + wave * 1024 + lane * 16) = (v4u){0u, 0u, 0u, 0u}; *(LAS v4u*)(lds + SX_SA + 8192 + (4 + wave) * 1024 + lane * 16) = (v4u){0u, 0u, 0u, 0u}; }
    if (wave < 4) {
        const int t = wave;
        OSet A, B, C;
        o_load(A, SC_REC(0), t, lane); o_load(B, SC_REC(1), t, lane); o_load(C, SC_REC(2), t, lane);
        bf16* obase = O + ((size_t)b * 8192 + 16 * t + fr) * 1024 + h * 256 + 32 * sl32 + 4 * g;
        __syncthreads();
#ifdef PROBE_SCAN
#define O_ITER(X, s) do { const unsigned long long q0_ = __builtin_amdgcn_s_memrealtime(); const int cs_ = SC_CS(s); o_step(X, lds + SX_SA + (((s) + 1) & 1) * 8192, lds + SX_VX + ((s) & 1) * 4096, lane, obase + (ptrdiff_t)(cs_ - 1) * 65536, cs_ != 0); \
                          const unsigned long long q1_ = __builtin_amdgcn_s_memrealtime(); if ((s) + 3 < NCHUNK) o_load(X, SC_REC((s) + 3), t, lane); const unsigned long long q2_ = __builtin_amdgcn_s_memrealtime(); __syncthreads(); \
                          const unsigned long long q3_ = __builtin_amdgcn_s_memrealtime(); pa0 += q1_ - q0_; pa1 += q2_ - q1_; pa2 += q3_ - q2_; } while (0)
#else
#define O_ITER(X, s) do { const int cs_ = SC_CS(s); o_step(X, lds + SX_SA + (((s) + 1) & 1) * 8192, lds + SX_VX + ((s) & 1) * 4096, lane, obase + (ptrdiff_t)(cs_ - 1) * 65536, cs_ != 0); \
                          if ((s) + 3 < NCHUNK) o_load(X, SC_REC((s) + 3), t, lane); __syncthreads(); } while (0)
#endif
#ifdef PROBE_SCAN
        unsigned long long pa0 = 0, pa1 = 0, pa2 = 0;
#endif
#pragma unroll 1
        for (int s0 = 0; s0 < NCHUNK; s0 += 3) { O_ITER(A, s0); O_ITER(B, s0 + 1); O_ITER(C, s0 + 2); }
#ifdef PROBE_SCAN
        if (item == 0 && wave == 0 && lane == 0) { unsigned long long* TSW = (unsigned long long*)(a.ws + WS_BAR_OFF + 8192); TSW[20] = pa0; TSW[21] = pa1; TSW[22] = pa2; }
#endif
#undef O_ITER
    } else {
        const int jj = wave - 4;
        SSet A, B, C;
        s_load(A, SC_REC(0), SC_VT(0), jj, lane, g); s_load(B, SC_REC(1), SC_VT(1), jj, lane, g); s_load(C, SC_REC(2), SC_VT(2), jj, lane, g);
        *(LAS bf16x8*)(lds + SX_VX + jj * 1024 + lane * 16) = A.v;
        f32x4 S[2][2] = {{{0.f, 0.f, 0.f, 0.f}, {0.f, 0.f, 0.f, 0.f}}, {{0.f, 0.f, 0.f, 0.f}, {0.f, 0.f, 0.f, 0.f}}};
        __syncthreads();
#ifdef PROBE_SCAN
#define S_ITER(X, Y, s) do { const unsigned long long q0_ = __builtin_amdgcn_s_memrealtime(); s_step(S, X, lds + SX_VX + ((s) & 1) * 4096, lds + SX_SA + ((s) & 1) * 8192, jj, lane); \
                          if ((s) + 1 < NCHUNK) *(LAS bf16x8*)(lds + SX_VX + (((s) + 1) & 1) * 4096 + jj * 1024 + lane * 16) = Y.v; asm volatile("s_waitcnt lgkmcnt(0)" ::: "memory"); \
                          const unsigned long long q1_ = __builtin_amdgcn_s_memrealtime(); if ((s) + 3 < NCHUNK) s_load(X, SC_REC((s) + 3), SC_VT((s) + 3), jj, lane, g); const unsigned long long q2_ = __builtin_amdgcn_s_memrealtime(); __syncthreads(); \
                          const unsigned long long q3_ = __builtin_amdgcn_s_memrealtime(); pa0 += q1_ - q0_; pa1 += q2_ - q1_; pa2 += q3_ - q2_; } while (0)
#else
#define S_ITER(X, Y, s) do { s_step(S, X, lds + SX_VX + ((s) & 1) * 4096, lds + SX_SA + ((s) & 1) * 8192, jj, lane); \
                          if ((s) + 1 < NCHUNK) *(LAS bf16x8*)(lds + SX_VX + (((s) + 1) & 1) * 4096 + jj * 1024 + lane * 16) = Y.v; \
                          if ((s) + 3 < NCHUNK) s_load(X, SC_REC((s) + 3), SC_VT((s) + 3), jj, lane, g); __syncthreads(); } while (0)
#endif
#ifdef PROBE_SCAN
        unsigned long long pa0 = 0, pa1 = 0, pa2 = 0;
#endif
#pragma unroll 1
        for (int s0 = 0; s0 < NCHUNK; s0 += 3) { S_ITER(A, B, s0); S_ITER(B, C, s0 + 1); S_ITER(C, A, s0 + 2); }
#ifdef PROBE_SCAN
        if (item == 0 && wave == 4 && lane == 0) { unsigned long long* TSW = (unsigned long long*)(a.ws + WS_BAR_OFF + 8192); TSW[23] = pa0; TSW[24] = pa1; TSW[25] = pa2; }
#endif
#undef S_ITER
    }
#undef SC_CS
#undef SC_REC
#undef SC_VT
}
DI void o_step1(const OSet& x, const LAS unsigned char* sab, const LAS unsigned char* vxb, int lane, bf16* optr, bool st) {
    bf16x8 sa[4], v[2];
#pragma unroll
    for (int kap = 0; kap < 4; ++kap) sa[kap] = *(const LAS bf16x8*)(sab + kap * 1024 + lane * 16);
    v[0] = *(const LAS bf16x8*)(vxb + lane * 16); v[1] = *(const LAS bf16x8*)(vxb + 1024 + lane * 16);
    asm volatile("s_waitcnt lgkmcnt(0)" ::: "memory");
    f32x4 o0 = {0.f, 0.f, 0.f, 0.f}, o1 = {0.f, 0.f, 0.f, 0.f};
    o0 = __builtin_amdgcn_mfma_f32_16x16x32_bf16(v[0], x.p[0], o0, 0, 0, 0);
    o1 = __builtin_amdgcn_mfma_f32_16x16x32_bf16(v[1], x.p[1], o1, 0, 0, 0);
    o0 = __builtin_amdgcn_mfma_f32_16x16x32_bf16(sa[0], x.q[0], o0, 0, 0, 0);
    o1 = __builtin_amdgcn_mfma_f32_16x16x32_bf16(sa[1], x.q[1], o1, 0, 0, 0);
    o0 = __builtin_amdgcn_mfma_f32_16x16x32_bf16(sa[2], x.q[2], o0, 0, 0, 0);
    o1 = __builtin_amdgcn_mfma_f32_16x16x32_bf16(sa[3], x.q[3], o1, 0, 0, 0);
    if (st) { const f32x4 o = o0 + o1; *(v2u*)optr = (v2u){cvtpk(o[0], o[1]), cvtpk(o[2], o[3])}; }
}
DI void s_step1(f32x4 (&S)[2], const SSet& x, const LAS unsigned char* vxb, LAS unsigned char* sab, int jj, int lane) {
    const bf16x8 v0 = *(const LAS bf16x8*)(vxb + lane * 16), v1 = *(const LAS bf16x8*)(vxb + 1024 + lane * 16);
    S[0] = S[0] * x.dc[0]; S[1] = S[1] * x.dc[1];
    asm volatile("s_waitcnt lgkmcnt(0)" ::: "memory");
    S[0] = __builtin_amdgcn_mfma_f32_16x16x32_bf16(x.k[0], v0, S[0], 0, 0, 0);
    S[1] = __builtin_amdgcn_mfma_f32_16x16x32_bf16(x.k[2], v0, S[1], 0, 0, 0);
    S[0] = __builtin_amdgcn_mfma_f32_16x16x32_bf16(x.k[1], v1, S[0], 0, 0, 0);
    S[1] = __builtin_amdgcn_mfma_f32_16x16x32_bf16(x.k[3], v1, S[1], 0, 0, 0);
    *(LAS v4u*)(sab + jj * 1024 + lane * 16) = (v4u){cvtpk(S[0][0], S[0][1]), cvtpk(S[0][2], S[0][3]), cvtpk(S[1][0], S[1][1]), cvtpk(S[1][2], S[1][3])};
}
DI void s_load1(SSet& x, const unsigned char* rec, const unsigned char* vt, int jj, int lane, int g) {
    const unsigned char* kb = rec + REC_KDT + (jj * 4 * 64 + lane) * 16;
#pragma unroll
    for (int f = 0; f < 4; ++f) x.k[f] = *(const bf16x8*)(kb + f * 1024);
    const unsigned char* db = rec + REC_DEC + (32 * jj + 4 * g) * 4;
    x.dc[0] = *(const f32x4*)db; x.dc[1] = *(const f32x4*)(db + 64);
    if (jj < 2) x.v = *(const bf16x8*)(vt + jj * 1024 + lane * 16);
}
DI void o_load1(OSet& x, const unsigned char* rec, int t, int lane, bool p0, bool p1) {
    const unsigned char* qb = rec + (t * 4 * 64 + lane) * 16;
#pragma unroll
    for (int kap = 0; kap < 4; ++kap) x.q[kap] = *(const bf16x8*)(qb + kap * 1024);
    const unsigned char* pb = rec + REC_PM + (t * 2 * 64 + lane) * 16;
    if (p0) x.p[0] = *(const bf16x8*)pb;
    if (p1) x.p[1] = *(const bf16x8*)(pb + 1024);
}
DI void p5_scan_item1(const Args& a, LAS unsigned char* lds, int lane, int wave, int item) {
    unsigned char* ws = a.ws;
    const unsigned char* REC = ws + WS_REC; const unsigned char* VT = ws + WS_VT;
    const int sl = item & 15, dir = (item >> 4) & 1, h = (item >> 5) & 3, b = item >> 7;
    bf16* O = dir ? (bf16*)((unsigned char*)a.out + DO_OB) : (bf16*)(ws + WS_OF);
    const size_t t0 = tile_idx(dir, b, h, 0); const size_t v0i = (size_t)(b * 4 + h) * NCHUNK;
    const int fr = lane & 15, g = lane >> 4;
#define SC_CS(step) (dir ? 128 - (step) : (step))
#define SC_REC(step) (REC + (t0 + SC_CS(step)) * REC_BYTES)
#define SC_VT(step) (VT + (v0i + SC_CS(step)) * 32768 + sl * 2048)
    __syncthreads();
    if (wave < 4) *(LAS v4u*)(lds + 4096 + wave * 1024 + lane * 16) = (v4u){0u, 0u, 0u, 0u};
    if (wave < 4) {
        const int t = wave;
        OSet A, B, C;
        const bool pk0 = dir ? (t < 2) : true, pk1 = dir ? true : (t >= 2);
        { const bf16x8 z = {0, 0, 0, 0, 0, 0, 0, 0}; A.p[0] = z; A.p[1] = z; B.p[0] = z; B.p[1] = z; C.p[0] = z; C.p[1] = z; }
        o_load1(A, SC_REC(0), t, lane, pk0, pk1); o_load1(B, SC_REC(1), t, lane, pk0, pk1); o_load1(C, SC_REC(2), t, lane, pk0, pk1);
        bf16* obase = O + ((size_t)b * 8192 + 16 * t + fr) * 1024 + h * 256 + 16 * sl + 4 * g;
        __syncthreads();
#define O_ITER(X, s) do { const int cs_ = SC_CS(s); o_step1(X, lds + (((s) + 1) & 1) * 4096, lds + 16384 + ((s) & 1) * 2048, lane, obase + (ptrdiff_t)(cs_ - 1) * 65536, cs_ != 0); \
                          if ((s) + 3 < NCHUNK) o_load1(X, SC_REC((s) + 3), t, lane, pk0, pk1); __syncthreads(); } while (0)
#pragma unroll 1
        for (int s0 = 0; s0 < NCHUNK; s0 += 3) { O_ITER(A, s0); O_ITER(B, s0 + 1); O_ITER(C, s0 + 2); }
#undef O_ITER
    } else {
        const int jj = wave - 4;
        SSet A, B, C;
        s_load1(A, SC_REC(0), SC_VT(0), jj, lane, g); s_load1(B, SC_REC(1), SC_VT(1), jj, lane, g); s_load1(C, SC_REC(2), SC_VT(2), jj, lane, g);
        if (jj < 2) *(LAS bf16x8*)(lds + 16384 + jj * 1024 + lane * 16) = A.v;
        f32x4 S[2] = {{0.f, 0.f, 0.f, 0.f}, {0.f, 0.f, 0.f, 0.f}};
        __syncthreads();
#define S_ITER(X, Y, s) do { s_step1(S, X, lds + 16384 + ((s) & 1) * 2048, lds + ((s) & 1) * 4096, jj, lane); \
                          if (jj < 2 && (s) + 1 < NCHUNK) *(LAS bf16x8*)(lds + 16384 + (((s) + 1) & 1) * 2048 + jj * 1024 + lane * 16) = Y.v; \
                          if ((s) + 3 < NCHUNK) s_load1(X, SC_REC((s) + 3), SC_VT((s) + 3), jj, lane, g); __syncthreads(); } while (0)
#pragma unroll 1
        for (int s0 = 0; s0 < NCHUNK; s0 += 3) { S_ITER(A, B, s0); S_ITER(B, C, s0 + 1); S_ITER(C, A, s0 + 2); }
#undef S_ITER
    }
#undef SC_CS
#undef SC_REC
#undef SC_VT
}
constexpr size_t WS_BAR = 239 * MiB + 768 * 1024;
#define XB_TMO      128
#define XB_XCNT(j)  (256  + 64 * (j))
#define XB_XSUB(j)  (1280 + 64 * (j))
#define XB_XGEN(j)  (2304 + 64 * (j))
#define XB_TOP      3328
#define XB_TOPGEN   3392
#define XCD_BAR_WORDS 3456
#define XB_SPIN_CAP (1u << 18)

__device__ __forceinline__ unsigned xb_ld(unsigned* p)              { return __hip_atomic_load(p, __ATOMIC_RELAXED, __HIP_MEMORY_SCOPE_AGENT); }
__device__ __forceinline__ unsigned xb_add(unsigned* p, unsigned v) { return __hip_atomic_fetch_add(p, v, __ATOMIC_RELAXED, __HIP_MEMORY_SCOPE_AGENT); }
__device__ __forceinline__ unsigned xb_xcc_id() { return (unsigned)__builtin_amdgcn_s_getreg((3 << 11) | 20) & 0xFu; }
#define XB_SPIN(cond, bar) do { unsigned _sp = 0; while (cond) { __builtin_amdgcn_s_sleep(1); \
    if ((++_sp & 255u) == 0u) { if (xb_ld(&(bar)[XB_TMO])) break; if (_sp > XB_SPIN_CAP) { atomicAdd(&(bar)[XB_TMO], 1u); break; } } } } while (0)

struct XcdBarrier {
    unsigned* bar; unsigned x;
    volatile LAS unsigned* st;
};

__device__ __forceinline__ XcdBarrier xcd_barrier_post(unsigned* bar, volatile LAS unsigned* st) {
    XcdBarrier b; b.bar = bar; b.x = xb_xcc_id(); b.st = st;
    if (threadIdx.x == 0) (void)xb_add(&bar[XB_XCNT(b.x)], 1u);
    return b;
}
__device__ __forceinline__ void xcd_barrier_complete(unsigned* bar, unsigned x, unsigned& nloc, unsigned& nx) {
    const unsigned G = gridDim.x * gridDim.y * gridDim.z;
    unsigned sum, cnt, mine, sp = 0u;
    for (;;) {
        sum = 0u; cnt = 0u; mine = 0u;
#pragma unroll
        for (unsigned j = 0; j < 16; ++j) { const unsigned c = xb_ld(&bar[XB_XCNT(j)]); sum += c; cnt += (c > 0u) ? 1u : 0u; mine = (j == x) ? c : mine; }
        if (sum == G) break;
        __builtin_amdgcn_s_sleep(1);
        if ((++sp & 255u) == 0u) { if (xb_ld(&bar[XB_TMO])) break; if (sp > XB_SPIN_CAP) { atomicAdd(&bar[XB_TMO], 1u); break; } }
    }
    nloc = mine > 0u ? mine : 1u; nx = cnt > 0u ? cnt : 1u;
}

__device__ __forceinline__ void xcd_barrier(const XcdBarrier& b) {
    asm volatile("s_waitcnt vmcnt(0)" ::: "memory");
    __syncthreads();
    if (threadIdx.x == 0) {
        unsigned* bar = b.bar;
        __builtin_amdgcn_s_waitcnt(0);
        unsigned nloc = b.st[0], nx = b.st[1];
        if (nloc == 0u) { xcd_barrier_complete(bar, b.x, nloc, nx); b.st[0] = nloc; b.st[1] = nx; }
        const unsigned old = xb_add(&bar[XB_XSUB(b.x)], 1u);
        const unsigned gen = old / nloc;
        if (old + 1u == (gen + 1u) * nloc) {
            __builtin_amdgcn_fence(__ATOMIC_RELEASE, "agent");
            asm volatile("s_waitcnt vmcnt(0)" ::: "memory");
            const unsigned og = xb_add(&bar[XB_TOP], 1u);
            const unsigned tg = og / nx;
            if (og + 1u == (tg + 1u) * nx) xb_add(&bar[XB_TOPGEN], 1u);
            else XB_SPIN(xb_ld(&bar[XB_TOPGEN]) == tg, bar);
            __builtin_amdgcn_fence(__ATOMIC_ACQUIRE, "agent");
            xb_add(&bar[XB_XGEN(b.x)], 1u);
            asm volatile("s_waitcnt vmcnt(0)" ::: "memory");
        } else {
            XB_SPIN(xb_ld(&bar[XB_XGEN(b.x)]) == gen, bar);
            __builtin_amdgcn_fence(__ATOMIC_ACQUIRE, "agent");
            asm volatile("s_waitcnt vmcnt(0)" ::: "memory");
        }
    }
    __syncthreads();
}

#ifndef ONE_LAUNCH
#define ONE_LAUNCH 1
#endif
constexpr int NPH = 13;
__global__ void __launch_bounds__(NTHREADS, 2) fwd_kernel(Args a) {
    extern __shared__ __attribute__((aligned(16))) unsigned char lds_raw[];
    LAS unsigned char* lds = (LAS unsigned char*)lds_raw;
    const int tid = threadIdx.x, lane = tid & 63, wave = __builtin_amdgcn_readfirstlane(tid >> 6), bid = blockIdx.x, G = gridDim.x;
    unsigned char* ws = a.ws;
    const int lo = a.ph_lo, hi = a.ph_hi;
    volatile LAS unsigned* bst = (volatile LAS unsigned*)(lds + LDS_BYTES - 16);
    if (tid < 2) bst[tid] = 0u;
    __syncthreads();
    XcdBarrier xbar = xcd_barrier_post((unsigned*)(a.ws + WS_BAR), bst);
    const int vb = (G == 256) ? (bid & 7) * 32 + (bid >> 3) : bid;
#define IN(k) (lo <= (k) && (k) < hi)
#ifdef PROBE_TS
    unsigned long long* TSW = (unsigned long long*)(a.ws + WS_BAR + 8192);
    if (bid == 0 && tid == 0) TSW[0] = __builtin_amdgcn_s_memrealtime();
#define SEAM(k) do { if (IN(k) && IN((k) + 1)) { xcd_barrier(xbar); if (bid == 0 && tid == 0) TSW[(k) + 1] = __builtin_amdgcn_s_memrealtime(); } } while (0)
#else
#define SEAM(k) do { if (IN(k) && IN((k) + 1)) { if (hi > 1000) cg::this_grid().sync(); else xcd_barrier(xbar); } } while (0)
#endif
    pg8::EP ep;
    ep.Q = (bf16*)((unsigned char*)a.out + DO_Q); ep.K = (bf16*)(ws + WS_K); ep.V = (bf16*)((unsigned char*)a.out + DO_V); ep.R = (float*)(ws + WS_R);
    ep.GT2 = (bf16*)(ws + WS_GT2); ep.PQ = (bf16*)(ws + WS_PQ); ep.SGA = (bf16*)((unsigned char*)a.out + 32 * MiB);     ep.SGF = (bf16*)(ws + WS_SGF); ep.ON = (bf16*)(ws + WS_ON);
    ep.OG = (bf16*)(ws + WS_OG); ep.MG = (bf16*)(ws + WS_MG); ep.H1B = (bf16*)(ws + WS_H1B); ep.HF = (bf16*)(ws + WS_HF);
    ep.H2B = (bf16*)(ws + WS_H2B); ep.x = a.x; ep.H = a.out; ep.PART1 = (float*)(ws + WS_PART1); ep.gnorm = a.gla_norm;
    const bf16* ALL = (const bf16*)(ws + WS_ALL);

    if (IN(0)) { p0_prologue(a, lds, tid, lane, wave, bid, G); }
    SEAM(0);
    if (IN(1)) { pg8::Gemm g{ALL, ALL, 0, 0, 1024}; pg8::Sched S{1, 845, G, vb, 0, 0, 0}; pg8::Epi<1> E{ep};
        pg8::gemm_phase<pg8::Epi<1>, pg8::Sched, true, true>(lds, g, S, E);
        if (G == 256) { if (vb >= 77) gen_cs_tab(a, lds, tid, vb - 77, 256 - 77); }
        else gen_cs_tab(a, lds, tid, bid, G); }
    SEAM(1);
    if (IN(2)) { p2_sym_rem(a, tid, lane, wave, bid, G); }
    SEAM(2);
    if (IN(3)) { pg8::Gemm g{(const bf16*)(ws + WS_CS), (const bf16*)(ws + WS_EOT), 0, 0, KH}; pg8::Sched S{2, 256, G, vb, 0, 0, 0}; pg8::Epi<2> E{ep};
        pg8::gemm_phase<pg8::Epi<2>, pg8::Sched, true, true>(lds, g, S, E); }
    SEAM(3);
    if (IN(4)) { p4_gla_prep(a, lds, tid, lane, wave, bid, G); p4_combine(a, tid, bid, G); }
    SEAM(4);
    if (IN(5)) {
        for (int item = vb; item < 256; item += G) p5_scan_item1(a, lds, lane, wave, item);
    }
    SEAM(5);
    if (IN(6)) { p6_post(a, lane, wave, bid, G);
        pg8::Gemm g{ALL, ALL, 0, 0, 1024}; pg8::Sched S{3, 512, G, vb, 8, 0, 82}; pg8::Epi<3> E{ep};
        pg8::gemm_phase<pg8::Epi<3>, pg8::Sched, true, true>(lds, g, S, E); }
    SEAM(6);
    if (IN(7)) {
        { pg8::Gemm g{ALL, ALL, 0, 0, 1024}; pg8::Sched S{3, 256, G, vb, 4, 0, 78}; pg8::Epi<4> E{ep};
          pg8::gemm_phase<pg8::Epi<4>, pg8::Sched, true, true>(lds, g, S, E); }
        { pg8::Gemm g{(const bf16*)(ws + WS_FN), (const bf16*)(ws + WS_WFT), 0, 0, 512}; pg8::Sched S{3, 256, G, vb, 4, 0, 0}; pg8::Epi<5> E{ep};
          pg8::gemm_phase<pg8::Epi<5>, pg8::Sched, true, true>(lds, g, S, E); }
    }
    SEAM(7);
    if (IN(8)) { pg8::Gemm g{(const bf16*)(ws + WS_OG), (const bf16*)(ws + WS_WOT), 0, 0, 1024}; pg8::Sched S{3, 256, G, vb, 4, 0, 0}; pg8::Epi<6> E{ep};
        pg8::gemm_phase<pg8::Epi<6>, pg8::Sched, true, true>(lds, g, S, E); }
    SEAM(8);
    if (IN(9)) { pg8::Gemm g{(const bf16*)(ws + WS_MG), (const bf16*)(ws + WS_WOUTT), 0, 0, 1024}; pg8::Sched S{3, 256, G, vb, 4, 0, 0}; pg8::Epi<7> E{ep};
        pg8::gemm_phase<pg8::Epi<7>, pg8::Sched, true, true>(lds, g, S, E); }
    SEAM(9);
    if (IN(10)) { pg8::Gemm g{(const bf16*)(ws + WS_H1B), (const bf16*)(ws + WS_W1T), 0, 0, 1024}; pg8::Sched S{3, 1024, G, vb, 16, 0, 0}; pg8::Epi<8> E{ep};
        pg8::gemm_phase<pg8::Epi<8>, pg8::Sched, true, true>(lds, g, S, E); }
    SEAM(10);
    if (IN(11)) { pg8::Gemm g{(const bf16*)(ws + WS_HF), (const bf16*)(ws + WS_W2T), 4224, 4224, 4096}; pg8::Sched S{3, 256, G, vb, 4, 0, 0}; pg8::Epi<9> E{ep};
        pg8::gemm_phase<pg8::Epi<9>, pg8::Sched, true, true>(lds, g, S, E); }
    SEAM(11);
    if (IN(12)) { p11_final(a, lane, wave, bid, G); }
#ifdef PROBE_TS
    if (bid == 0) {
        if (tid == 0) TSW[13] = __builtin_amdgcn_s_memrealtime();
        __syncthreads();
#ifdef PROBE_IDX
        const float t_us = (float)TSW[PROBE_IDX] * 0.01f;
#else
        const float t_us = (float)(TSW[PROBE_TS + 1] - TSW[PROBE_TS]) * 0.01f;
#endif
        const float delta = sqrtf(t_us * 2.048e-5f);
        float* row = a.out + (size_t)wave * D;
        for (int c = lane; c < D; c += 64) row[c] += delta;
    }
#endif
#ifdef PROBE_REP
    if (IN(13)) { pg8::Gemm g{(const bf16*)(ws + WS_HF), (const bf16*)(ws + WS_W2T), 4224, 4224, 4096}; pg8::Sched S{3, 256, G, vb, 4, 0, 0}; pg8::Epi<10> E{ep};
        pg8::gemm_phase<pg8::Epi<10>, pg8::Sched, true, true>(lds, g, S, E); }
    if (IN(14)) { const int gw = bid * NWAVES + wave, NGW = G * NWAVES;
        for (int row = gw; row < NREAL; row += NGW) { f32x4* xr = (f32x4*)(a.out + (size_t)row * D) + lane; float s = 0.f;
            for (int j = 0; j < 4; ++j) { const f32x4 v = xr[64 * j]; s += v.x + v.y + v.z + v.w; }
            if (wave_sum(s) == 123456.789f) xr[0] = (f32x4){s, s, s, s}; } }
#endif
#undef IN
#undef SEAM
}

extern "C" void kernel_launch(void* const* d_in, const int* in_sizes, int n_in, void* d_out, int out_size, void* d_ws, size_t ws_size, hipStream_t stream) {
    static int grid = 0;
    if (grid == 0) {
        int dev = 0, cus = 0, per_cu = 0;
        (void)hipGetDevice(&dev); (void)hipDeviceGetAttribute(&cus, hipDeviceAttributeMultiprocessorCount, dev);
        (void)hipFuncSetAttribute((const void*)fwd_kernel, hipFuncAttributeMaxDynamicSharedMemorySize, LDS_BYTES);
        (void)hipOccupancyMaxActiveBlocksPerMultiprocessor(&per_cu, (const void*)fwd_kernel, NTHREADS, LDS_BYTES);
        (void)hipGetLastError();
        if (per_cu < 1) { fprintf(stderr, "kernel_launch: occupancy query says %d blocks/CU\n", per_cu); per_cu = 1; }
        grid = cus * 1;
        if (grid > 256) grid = 256;
    }
    (void)hipMemsetAsync((char*)d_ws + WS_BAR, 0, 16384, stream);
    Args a{};
    const float* const* in = (const float* const*)d_in;
    a.x = in[0]; a.meta = in[1]; a.norm_mix = in[2]; a.w_in = in[3]; a.wdf = in[4]; a.bdf = in[5]; a.wdb = in[6]; a.bdb = in[7]; a.gla_norm = in[8];
    a.w_o = in[9]; a.w_fnet = in[10]; a.w_out = in[11]; a.norm_ffn = in[12]; a.w_ff1 = in[13]; a.w_ff2 = in[14]; a.norm_final = in[15];
    a.out = (float*)d_out; a.ws = (unsigned char*)d_ws;
#if ONE_LAUNCH
    a.ph_lo = 0; a.ph_hi = NPH;
    void* args[] = {&a};
    hipError_t e = hipLaunchCooperativeKernel((const void*)fwd_kernel, dim3(grid), dim3(NTHREADS), args, LDS_BYTES, stream);
    if (e != hipSuccess) fprintf(stderr, "cooperative launch failed: %s (grid %d)\n", hipGetErrorString(e), grid);
#else
    for (int p = 0; p < NPH; ++p) { a.ph_lo = p; a.ph_hi = p + 1; hipLaunchKernelGGL(fwd_kernel, dim3(grid), dim3(NTHREADS), LDS_BYTES, stream, a);
#ifdef PROBE_REP
        if (p == PROBE_REP) for (int q = 0; q < PROBE_N; ++q) hipLaunchKernelGGL(fwd_kernel, dim3(grid), dim3(NTHREADS), LDS_BYTES, stream, a);
#ifdef PROBE_DRY
        if (p == PROBE_AFTER) { Args a2 = a; a2.ph_lo = PROBE_DRY; a2.ph_hi = PROBE_DRY + 1; for (int q = 0; q < PROBE_N; ++q) hipLaunchKernelGGL(fwd_kernel, dim3(grid), dim3(NTHREADS), LDS_BYTES, stream, a2); }
#endif
#endif
    }
#endif
}
```
